# Optimizing an MI355X kernel written in HIP

```python
import math
import jax, jax.numpy as jnp
from jax import lax
import numpy as np

D_MODEL = 1024
BATCH = 32
SEQ = 2048
DEPTH = 1

GRID_W = 64
CTX_LEN = 256
HEAD_DIM = 64
DIFF_HEADS = 4
DIFF_V_DIM = 2 * HEAD_DIM
GQA_HEADS = 8
GQA_KV_HEADS = 2
MIX_WIDTH = DIFF_HEADS * DIFF_V_DIM + GQA_HEADS * HEAD_DIM
IN_SIZES = (DIFF_HEADS * 2 * HEAD_DIM, DIFF_HEADS * 2 * HEAD_DIM, DIFF_HEADS * DIFF_V_DIM,
            GQA_HEADS * HEAD_DIM, GQA_KV_HEADS * HEAD_DIM, GQA_KV_HEADS * HEAD_DIM)
IN_WIDTH = sum(IN_SIZES)
ROPE_THETA = 10000.0
Q_BLOCK = 128
N_EXPERTS = 64
N_GROUPS = 8
TOPK_GROUPS = 4
TOP_K = 8
EXPERT_DIM = 256
SHARED_DIM = 256
ROUTED_SCALE = 2.5
EXPERT_BLOCK = 256
N_MOD = 6
EPS = 1e-6

kernel_name = "hybrid_diffattn_gqa_moe_dit_block"


def rmsnorm(x, g):
    xf = x.astype(jnp.float32)
    y = xf * lax.rsqrt(jnp.mean(xf * xf, axis=-1, keepdims=True) + EPS)
    return (y * g.astype(jnp.float32)).astype(x.dtype)


def modulate(h, shift, scale):
    return h * (1.0 + scale) + shift


def rope_rotate(x, ang):
    q = ang.shape[-1]
    shape = (1, ang.shape[0]) + (1,) * (x.ndim - 3) + (q,)
    cos = jnp.cos(ang).reshape(shape).astype(x.dtype)
    sin = jnp.sin(ang).reshape(shape).astype(x.dtype)
    a, b = x[..., :q], x[..., q:]
    return jnp.concatenate([a * cos - b * sin, a * sin + b * cos], axis=-1)


def rope_2d(x, ang_row, ang_col):
    half = x.shape[-1] // 2
    return jnp.concatenate([rope_rotate(x[..., :half], ang_row),
                            rope_rotate(x[..., half:], ang_col)], axis=-1)


def attend(q, k, v, scale):
    b, s, hq, d = q.shape
    hk, dv = k.shape[2], v.shape[-1]
    g = hq // hk
    nblk = s // Q_BLOCK
    qb = q.reshape(b, nblk, Q_BLOCK, hk, g, d).swapaxes(0, 1)

    def one_block(qi):
        sc = jnp.einsum("bqhgd,bkhd->bhgqk", qi, k, preferred_element_type=jnp.float32) * scale
        p = jax.nn.softmax(sc, axis=-1).astype(v.dtype)
        return jnp.einsum("bhgqk,bkhe->bqhge", p, v)

    o = lax.map(one_block, qb)
    return o.swapaxes(0, 1).reshape(b, s, hq, dv)


def project(h, w_in, q_g, k_g):
    b, L, _ = h.shape
    p = h @ w_in
    offs = [int(o) for o in np.cumsum(IN_SIZES)[:-1]]
    dq, dk, dv, gq, gk, gv = jnp.split(p, offs, axis=-1)
    dq = dq.reshape(b, L, DIFF_HEADS, 2, HEAD_DIM)
    dk = dk.reshape(b, L, DIFF_HEADS, 2, HEAD_DIM)
    dv = dv.reshape(b, L, DIFF_HEADS, DIFF_V_DIM)
    gq = rmsnorm(gq.reshape(b, L, GQA_HEADS, HEAD_DIM), q_g)
    gk = rmsnorm(gk.reshape(b, L, GQA_KV_HEADS, HEAD_DIM), k_g)
    gv = gv.reshape(b, L, GQA_KV_HEADS, HEAD_DIM)
    return dq, dk, dv, gq, gk, gv


def mix_groups(dq, dk, dv, gq, gk, gv, lam, lam_init, subln_g):
    b, L = dq.shape[:2]
    sc = HEAD_DIM ** -0.5
    o1 = attend(dq[:, :, :, 0], dk[:, :, :, 0], dv, sc)
    o2 = attend(dq[:, :, :, 1], dk[:, :, :, 1], dv, sc)
    o_diff = rmsnorm(o1 - lam.astype(o2.dtype) * o2, subln_g) * (1.0 - lam_init)
    o_gqa = attend(gq, gk, gv, sc)
    return jnp.concatenate([o_diff.reshape(b, L, -1), o_gqa.reshape(b, L, -1)], axis=-1)


def swiglu(h, wg, wu, wd):
    return (jax.nn.silu(h @ wg) * (h @ wu)) @ wd


def moe(h, w_router, router_bias, w_eg, w_eu, w_ed, w_sg, w_su, w_sd):
    t, d = h.shape
    s = jax.nn.sigmoid(jnp.dot(h, w_router, preferred_element_type=jnp.float32))
    s_sel = s + router_bias.astype(jnp.float32)
    grp = s_sel.reshape(t, N_GROUPS, N_EXPERTS // N_GROUPS)
    grp_score = lax.top_k(grp, 2)[0].sum(-1)
    _, top_groups = lax.top_k(grp_score, TOPK_GROUPS)
    group_mask = jnp.any(top_groups[..., None] == jnp.arange(N_GROUPS), axis=1)
    expert_mask = jnp.repeat(group_mask, N_EXPERTS // N_GROUPS, axis=1)
    _, idx = lax.top_k(jnp.where(expert_mask, s_sel, -jnp.inf), TOP_K)
    w = jnp.take_along_axis(s, idx, axis=1)
    w = w / jnp.sum(w, axis=-1, keepdims=True) * ROUTED_SCALE

    n = t * TOP_K
    flat_e = idx.reshape(-1)
    flat_tok = jnp.repeat(jnp.arange(t, dtype=jnp.int32), TOP_K)
    flat_w = w.reshape(-1)
    order = jnp.argsort(flat_e)
    se, stok, sw = flat_e[order], flat_tok[order], flat_w[order]
    counts = jnp.bincount(flat_e, length=N_EXPERTS)
    start = jnp.cumsum(counts) - counts
    padded = (counts + EXPERT_BLOCK - 1) // EXPERT_BLOCK * EXPERT_BLOCK
    block_end = jnp.cumsum(padded)
    pstart = block_end - padded
    dest = pstart[se] + (jnp.arange(n) - start[se])
    n_blocks = (n + EXPERT_BLOCK - 1) // EXPERT_BLOCK + N_EXPERTS
    n_pad = n_blocks * EXPERT_BLOCK
    tok_buf = jnp.full((n_pad,), t, jnp.int32).at[dest].set(stok)
    w_buf = jnp.zeros((n_pad,), jnp.float32).at[dest].set(sw)
    block_expert = jnp.minimum(
        jnp.searchsorted(block_end, jnp.arange(n_blocks) * EXPERT_BLOCK, side="right"), N_EXPERTS - 1)
    h_pad = jnp.concatenate([h, jnp.zeros((1, d), h.dtype)], axis=0)

    def run_block(args):
        tok, wt, e = args
        y = swiglu(h_pad[tok], w_eg[e], w_eu[e], w_ed[e])
        return y * wt[:, None].astype(y.dtype)

    y_blocks = lax.map(run_block, (tok_buf.reshape(n_blocks, EXPERT_BLOCK),
                                   w_buf.reshape(n_blocks, EXPERT_BLOCK), block_expert))
    routed = jax.ops.segment_sum(y_blocks.reshape(n_pad, d), tok_buf, num_segments=t + 1)[:t]
    return routed + swiglu(h, w_sg, w_su, w_sd)


def setup_inputs(seed: int = 0) -> dict:
    key = jax.random.key(seed)
    ks = jax.random.split(key, 32)
    f32 = jnp.float32

    def nrm(k, shape, scale):
        return jax.random.normal(k, shape, f32) * scale

    def gain(k, shape):
        return 1.0 + 0.1 * jax.random.normal(k, shape, f32)

    L, D = DEPTH, D_MODEL
    return {
        "x": nrm(ks[0], (BATCH, SEQ, D), 1.0),
        "c": nrm(ks[1], (BATCH, D), 1.0),
        "ctx": nrm(ks[2], (BATCH, CTX_LEN, D), 1.0),
        "c_ctx": nrm(ks[3], (D,), 1.0),
        "w_mod": nrm(ks[4], (L, D, N_MOD * D), D ** -0.5),
        "b_mod": nrm(ks[5], (L, N_MOD * D), 0.02),
        "g_pre_mix": gain(ks[6], (L, D)),
        "g_post_mix": gain(ks[7], (L, D)),
        "w_in": nrm(ks[8], (L, D, IN_WIDTH), D ** -0.5),
        "q_norm_g": gain(ks[9], (L, HEAD_DIM)),
        "k_norm_g": gain(ks[10], (L, HEAD_DIM)),
        "lambda_q1": nrm(ks[11], (L, HEAD_DIM), 0.1),
        "lambda_k1": nrm(ks[12], (L, HEAD_DIM), 0.1),
        "lambda_q2": nrm(ks[13], (L, HEAD_DIM), 0.1),
        "lambda_k2": nrm(ks[14], (L, HEAD_DIM), 0.1),
        "subln_g": gain(ks[15], (L, DIFF_V_DIM)),
        "w_out": nrm(ks[16], (L, MIX_WIDTH, D), MIX_WIDTH ** -0.5),
        "g_pre_ffn": gain(ks[17], (L, D)),
        "g_post_ffn": gain(ks[18], (L, D)),
        "w_router": nrm(ks[19], (L, D, N_EXPERTS), D ** -0.5),
        "router_bias": nrm(ks[20], (L, N_EXPERTS), 0.01),
        "w_exp_gate": nrm(ks[21], (L, N_EXPERTS, D, EXPERT_DIM), D ** -0.5),
        "w_exp_up": nrm(ks[22], (L, N_EXPERTS, D, EXPERT_DIM), D ** -0.5),
        "w_exp_down": nrm(ks[23], (L, N_EXPERTS, EXPERT_DIM, D), EXPERT_DIM ** -0.5),
        "w_sh_gate": nrm(ks[24], (L, D, SHARED_DIM), D ** -0.5),
        "w_sh_up": nrm(ks[25], (L, D, SHARED_DIM), D ** -0.5),
        "w_sh_down": nrm(ks[26], (L, SHARED_DIM, D), SHARED_DIM ** -0.5),
    }


def reference(x, c, ctx, c_ctx, w_mod, b_mod, g_pre_mix, g_post_mix, w_in, q_norm_g, k_norm_g,
              lambda_q1, lambda_k1, lambda_q2, lambda_k2, subln_g, w_out, g_pre_ffn, g_post_ffn,
              w_router, router_bias, w_exp_gate, w_exp_up, w_exp_down, w_sh_gate, w_sh_up, w_sh_down):
    b, s, d = x.shape
    rows = s // GRID_W
    row_ids = jnp.repeat(jnp.arange(rows), GRID_W).astype(jnp.float32)
    col_ids = jnp.tile(jnp.arange(GRID_W), rows).astype(jnp.float32)
    n_freq = HEAD_DIM // 4
    inv_freq = ROPE_THETA ** (-jnp.arange(n_freq, dtype=jnp.float32) / n_freq)
    ang_row = row_ids[:, None] * inv_freq
    ang_col = col_ids[:, None] * inv_freq

    for l in range(DEPTH):
        lam_init = 0.8 - 0.6 * math.exp(-0.3 * l)
        lam = (jnp.exp(jnp.sum(lambda_q1[l].astype(jnp.float32) * lambda_k1[l].astype(jnp.float32)))
               - jnp.exp(jnp.sum(lambda_q2[l].astype(jnp.float32) * lambda_k2[l].astype(jnp.float32)))
               + lam_init)
        mod = jax.nn.silu(c) @ w_mod[l] + b_mod[l]
        mod_c = jax.nn.silu(c_ctx) @ w_mod[l] + b_mod[l]
        sh1, sc1, gt1, sh2, sc2, gt2 = jnp.split(mod[:, None, :], N_MOD, axis=-1)
        csh1, csc1, cgt1, csh2, csc2, cgt2 = jnp.split(mod_c, N_MOD)

        h = modulate(rmsnorm(x, g_pre_mix[l]), sh1, sc1)
        hc = modulate(rmsnorm(ctx, g_pre_mix[l]), csh1, csc1)
        dq, dk, dv, gq, gk, gv = project(h, w_in[l], q_norm_g[l], k_norm_g[l])
        dqc, dkc, dvc, gqc, gkc, gvc = project(hc, w_in[l], q_norm_g[l], k_norm_g[l])
        dq, dk = rope_2d(dq, ang_row, ang_col), rope_2d(dk, ang_row, ang_col)
        gq, gk = rope_2d(gq, ang_row, ang_col), rope_2d(gk, ang_row, ang_col)
        mixed = mix_groups(dq, jnp.concatenate([dkc, dk], axis=1), jnp.concatenate([dvc, dv], axis=1),
                           gq, jnp.concatenate([gkc, gk], axis=1), jnp.concatenate([gvc, gv], axis=1),
                           lam, lam_init, subln_g[l])
        x = x + gt1 * rmsnorm(mixed @ w_out[l], g_post_mix[l])

        h2 = modulate(rmsnorm(x, g_pre_ffn[l]), sh2, sc2)
        y = moe(h2.reshape(b * s, d), w_router[l], router_bias[l], w_exp_gate[l], w_exp_up[l],
                w_exp_down[l], w_sh_gate[l], w_sh_up[l], w_sh_down[l]).reshape(b, s, d)
        x = x + gt2 * rmsnorm(y, g_post_ffn[l])

        if l + 1 < DEPTH:
            mixed_c = mix_groups(dqc, dkc, dvc, gqc, gkc, gvc, lam, lam_init, subln_g[l])
            ctx = ctx + cgt1 * rmsnorm(mixed_c @ w_out[l], g_post_mix[l])
            h2c = modulate(rmsnorm(ctx, g_pre_ffn[l]), csh2, csc2)
            yc = moe(h2c.reshape(-1, d), w_router[l], router_bias[l], w_exp_gate[l], w_exp_up[l],
                     w_exp_down[l], w_sh_gate[l], w_sh_up[l], w_sh_down[l]).reshape(ctx.shape)
            ctx = ctx + cgt2 * rmsnorm(yc, g_post_ffn[l])
    return x
```

```cpp
#include <hip/hip_runtime.h>
#include <stdint.h>
#include <math.h>

typedef _Float16 f16;
typedef _Float16 f16x8 __attribute__((ext_vector_type(8)));
typedef _Float16 f16x4 __attribute__((ext_vector_type(4)));
typedef float f32x4 __attribute__((ext_vector_type(4)));
typedef float f32x2 __attribute__((ext_vector_type(2)));
#define DEV __device__ __forceinline__

constexpr int NB = 32, SEQ = 2048, DM = 1024, NT = NB * SEQ, CL = 256, RB = SEQ + CL, RALL = NB * RB;
constexpr int NIN = 2304, NMOD = 6144, NE = 64, EH = 256, TOPK = 8, NSLOTK = 9;
constexpr int SH_BLKS = NT / 256;
constexpr int MAX_BLKS = SH_BLKS + (NT * TOPK) / 256 + NE;
constexpr int MAX_SLOTS = MAX_BLKS * 256;
constexpr float EPS = 1e-6f;
constexpr float QSCALE = 0.125f * 1.4426950408889634f;
constexpr float YSCALE = 16.0f;

constexpr size_t MiB = 1ull << 20;
constexpr size_t WS_CTL = 0;
constexpr size_t WS_MOD = 64 * 1024;
constexpr size_t WS_ROPE = 1 * MiB;
constexpr size_t WS_MISC = 1 * MiB + 64 * 1024;
constexpr size_t WS_BLKE = 1 * MiB + 128 * 1024;
constexpr size_t WS_WIN = 4 * MiB;
constexpr size_t WS_WOUT = WS_WIN + (size_t)NIN * DM * 2;
constexpr size_t WS_WGU = WS_WOUT + (size_t)DM * DM * 2;
constexpr size_t WS_WD = WS_WGU + (size_t)65 * 512 * DM * 2;
constexpr size_t WS_WEND = WS_WD + (size_t)65 * DM * EH * 2;
static_assert(WS_WEND <= 108 * MiB, "weights");
constexpr size_t WS_HALL = 108 * MiB;
constexpr size_t WS_MIXED = 108 * MiB;
constexpr size_t WS_QKV = 252 * MiB;
constexpr size_t WS_SDIFF = 576 * MiB;
constexpr size_t WS_Y1 = 704 * MiB;
constexpr size_t WS_H = 108 * MiB;
constexpr size_t WS_YP = 404 * MiB;
constexpr size_t WS_H2 = 404 * MiB;
constexpr size_t WS_G = 532 * MiB;
constexpr size_t WS_TAB = 980 * MiB;
constexpr size_t WS_IDX = WS_TAB;
constexpr size_t WS_RANK = WS_IDX + (size_t)NT * 8 * 4;
constexpr size_t WS_GW = WS_RANK + (size_t)NT * 8 * 4;
constexpr size_t WS_TOK = WS_GW + (size_t)NT * 8 * 4;
constexpr size_t WS_PAIR = WS_TOK + (size_t)MAX_SLOTS * 4;
constexpr size_t WS_WSL = WS_PAIR + (size_t)MAX_SLOTS * 4;
constexpr size_t WS_END = WS_WSL + (size_t)MAX_SLOTS * 4;
static_assert(WS_END <= 1024 * MiB, "ws");

DEV float wave_sum(float v) {
#pragma unroll
    for (int o = 32; o > 0; o >>= 1) v += __shfl_xor(v, o);
    return v;
}
DEV float silu(float v) { return v / (1.f + __expf(-v)); }

__global__ void __launch_bounds__(256) k_mod(const float* c, const float* c_ctx, const float* w_mod, const float* b_mod, float* mod,
                                             const float* lq1, const float* lk1, const float* lq2, const float* lk2, float* misc, float* rope) {
    __shared__ float sc[33][128];
    const int tid = threadIdx.x, n = blockIdx.x * 256 + tid;
    float acc[33];
#pragma unroll
    for (int r = 0; r < 33; ++r) acc[r] = 0.f;
    for (int k0 = 0; k0 < DM; k0 += 128) {
        __syncthreads();
        for (int i = tid; i < 33 * 128; i += 256) { const int r = i >> 7, kk = i & 127; const float v = r < 32 ? c[r * DM + k0 + kk] : c_ctx[k0 + kk]; sc[r][kk] = silu(v); }
        __syncthreads();
        for (int kk = 0; kk < 128; ++kk) {
            const float w = w_mod[(size_t)(k0 + kk) * NMOD + n];
#pragma unroll
            for (int r = 0; r < 33; ++r) acc[r] += sc[r][kk] * w;
        }
    }
    const float bm = b_mod[n];
#pragma unroll
    for (int r = 0; r < 33; ++r) mod[(size_t)r * NMOD + n] = acc[r] + bm;
    if (blockIdx.x == 0) {
        if (tid < 64) {
            float a = lq1[tid] * lk1[tid], b = lq2[tid] * lk2[tid];
            a = wave_sum(a); b = wave_sum(b);
            if (tid == 0) misc[0] = expf(a) - expf(b) + 0.2f;
        }
        for (int i = tid; i < 64 * 16; i += 256) {
            const int pos = i >> 4, j = i & 15;
            const float inv = powf(10000.0f, -(float)j / 16.0f);
            const float ang = (float)pos * inv;
            rope[i * 2] = cosf(ang); rope[i * 2 + 1] = sinf(ang);
        }
    }
}

__global__ void __launch_bounds__(256) k_prenorm(const float* x, const float* ctx, const float* g, const float* mod, f16* hall) {
    const int wave = threadIdx.x >> 6, lane = threadIdx.x & 63;
    const int row = blockIdx.x * 4 + wave;
    const int b = row / RB, p = row % RB;
    const float* src = p < CL ? ctx + ((size_t)b * CL + p) * DM : x + ((size_t)b * SEQ + (p - CL)) * DM;
    const float* m = mod + (size_t)(p < CL ? 32 : b) * NMOD;
    f32x4 v[4]; float ss = 0.f;
#pragma unroll
    for (int j = 0; j < 4; ++j) { v[j] = *(const f32x4*)(src + j * 256 + lane * 4); ss += v[j].x * v[j].x + v[j].y * v[j].y + v[j].z * v[j].z + v[j].w * v[j].w; }
    const float rstd = rsqrtf(wave_sum(ss) * (1.f / DM) + EPS);
#pragma unroll
    for (int j = 0; j < 4; ++j) {
        const int c0 = j * 256 + lane * 4;
        const f32x4 gg = *(const f32x4*)(g + c0), sh = *(const f32x4*)(m + c0), sc = *(const f32x4*)(m + 1024 + c0);
        f16x4 o;
        o.x = (f16)(v[j].x * rstd * gg.x * (1.f + sc.x) + sh.x); o.y = (f16)(v[j].y * rstd * gg.y * (1.f + sc.y) + sh.y);
        o.z = (f16)(v[j].z * rstd * gg.z * (1.f + sc.z) + sh.z); o.w = (f16)(v[j].w * rstd * gg.w * (1.f + sc.w) + sh.w);
        *(f16x4*)(hall + (size_t)row * DM + c0) = o;
    }
}

__global__ void __launch_bounds__(256) k_transpose(const float* src, f16* dst, int K, int N, size_t sstride, size_t dstride, int rowmode) {
    __shared__ float t[32][33];
    const int n0 = blockIdx.x * 32, k0 = blockIdx.y * 32;
    src += (size_t)blockIdx.z * sstride; dst += (size_t)blockIdx.z * dstride;
    const int tx = threadIdx.x & 31, ty = threadIdx.x >> 5;
#pragma unroll
    for (int i = 0; i < 4; ++i) t[ty + 8 * i][tx] = src[(size_t)(k0 + ty + 8 * i) * N + n0 + tx];
    __syncthreads();
#pragma unroll
    for (int i = 0; i < 4; ++i) {
        const int n = n0 + ty + 8 * i;
        const int row = rowmode == 0 ? n : ((n >> 7) * 256 + (n & 127) + (rowmode == 2 ? 128 : 0));
        dst[(size_t)row * K + k0 + tx] = (f16)t[tx][ty + 8 * i];
    }
}

DEV unsigned char f2fp8(float v) { const int r = __builtin_amdgcn_cvt_pk_fp8_f32(v, v, 0, false); return (unsigned char)(r & 0xff); }
struct GemmP {
    const f16* A; const f16* Bt; void* out; int K, N;
    const int* tok; const int* pair; const float* wsl; const int* blke; const int* nblk; const f16* G;
};
template <int MODE> __global__ void __launch_bounds__(256) k_gemm(GemmP p) {
    const int tid = threadIdx.x, wave = tid >> 6, lane = tid & 63, wr = wave >> 1, wc = wave & 1, fr = lane & 15, fq = lane >> 4;
    const int r0 = blockIdx.y * 64, c0 = blockIdx.x * 64;
    int e = 0;
    if (MODE >= 2) { if ((r0 >> 8) >= *p.nblk) return; e = p.blke[r0 >> 8]; }
    const int K = p.K;
    const f16* ap[2]; const f16* bp[2];
#pragma unroll
    for (int m = 0; m < 2; ++m) {
        const int r = r0 + wr * 32 + m * 16 + fr;
        if (MODE == 2 || MODE == 3) ap[m] = p.A + (size_t)p.tok[r] * DM; else ap[m] = p.A + (size_t)r * K;
        ap[m] += fq * 8;
    }
#pragma unroll
    for (int n = 0; n < 2; ++n) {
        const int c = c0 + wc * 32 + n * 16 + fr;
        if (MODE == 2) bp[n] = p.Bt + ((size_t)e * 512 + (c >> 7) * 256 + (c & 127)) * DM;
        else if (MODE == 3) bp[n] = p.Bt + ((size_t)e * 512 + (c >> 7) * 256 + (c & 127) + 128) * DM;
        else if (MODE == 4) bp[n] = p.Bt + ((size_t)e * DM + c) * EH;
        else bp[n] = p.Bt + (size_t)c * K;
        bp[n] += fq * 8;
    }
    f32x4 acc[2][2];
#pragma unroll
    for (int m = 0; m < 2; ++m)
#pragma unroll
        for (int n = 0; n < 2; ++n) acc[m][n] = (f32x4){0.f, 0.f, 0.f, 0.f};
    for (int k = 0; k < K; k += 32) {
        f16x8 a[2], b[2];
#pragma unroll
        for (int m = 0; m < 2; ++m) a[m] = *(const f16x8*)(ap[m] + k);
#pragma unroll
        for (int n = 0; n < 2; ++n) b[n] = *(const f16x8*)(bp[n] + k);
#pragma unroll
        for (int m = 0; m < 2; ++m)
#pragma unroll
            for (int n = 0; n < 2; ++n) acc[m][n] = __builtin_amdgcn_mfma_f32_16x16x32_f16(a[m], b[n], acc[m][n], 0, 0, 0);
    }
#pragma unroll
    for (int m = 0; m < 2; ++m)
#pragma unroll
        for (int n = 0; n < 2; ++n)
#pragma unroll
            for (int j = 0; j < 4; ++j) {
                const int r = r0 + wr * 32 + m * 16 + 4 * fq + j, c = c0 + wc * 32 + n * 16 + fr;
                const float v = acc[m][n][j];
                if (MODE == 0 || MODE == 1) ((f16*)p.out)[(size_t)r * p.N + c] = (f16)v;
                else if (MODE == 2) ((f16*)p.out)[(size_t)r * EH + c] = (f16)v;
                else if (MODE == 3) { const float g = (float)p.G[(size_t)r * EH + c]; ((f16*)p.out)[(size_t)r * EH + c] = (f16)(silu(g) * v * p.wsl[r]); }
                else { const int pr = p.pair[r]; if (pr >= 0) ((unsigned char*)p.out)[(size_t)pr * DM + c] = f2fp8(v * YSCALE); }
            }
}

__global__ void __launch_bounds__(256) k_qkpost(f16* qkv, const float* qg, const float* kg, const float* rope) {
    const int gid = blockIdx.x * 256 + threadIdx.x;
    const int row = gid / 26, u = gid % 26;
    if (row >= RALL) return;
    const int p = row % RB; const bool latent = p >= CL;
    int col0; bool isq, norm;
    if (u < 8) { col0 = u * 64; isq = true; norm = false; }
    else if (u < 16) { col0 = 512 + (u - 8) * 64; isq = false; norm = false; }
    else if (u < 24) { col0 = 1536 + (u - 16) * 64; isq = true; norm = true; }
    else { col0 = 2048 + (u - 24) * 64; isq = false; norm = true; }
    if (isq && !latent) return;
    f16* ptr = qkv + (size_t)row * NIN + col0;
    float v[64];
#pragma unroll
    for (int i = 0; i < 8; ++i) { const f16x8 t = *(const f16x8*)(ptr + i * 8);
#pragma unroll
        for (int j = 0; j < 8; ++j) v[i * 8 + j] = (float)t[j]; }
    if (norm) {
        float ss = 0.f;
#pragma unroll
        for (int i = 0; i < 64; ++i) ss += v[i] * v[i];
        const float rstd = rsqrtf(ss * (1.f / 64.f) + EPS);
        const float* g = isq ? qg : kg;
#pragma unroll
        for (int i = 0; i < 64; ++i) v[i] = v[i] * rstd * g[i];
    }
    if (latent) {
        const int s = p - CL, prow = s >> 6, pcol = s & 63;
#pragma unroll
        for (int j = 0; j < 16; ++j) {
            const float cr = rope[(prow * 16 + j) * 2], sr = rope[(prow * 16 + j) * 2 + 1];
            const float cc = rope[(pcol * 16 + j) * 2], sn = rope[(pcol * 16 + j) * 2 + 1];
            const float a = v[j], b = v[16 + j]; v[j] = a * cr - b * sr; v[16 + j] = a * sr + b * cr;
            const float a2 = v[32 + j], b2 = v[48 + j]; v[32 + j] = a2 * cc - b2 * sn; v[48 + j] = a2 * sn + b2 * cc;
        }
    }
    const float sc = isq ? QSCALE : 1.f;
#pragma unroll
    for (int i = 0; i < 8; ++i) { f16x8 t;
#pragma unroll
        for (int j = 0; j < 8; ++j) t[j] = (f16)(v[i * 8 + j] * sc);
        *(f16x8*)(ptr + i * 8) = t; }
}

__global__ void __launch_bounds__(256) k_attn_naive(const f16* qkv, f16* sdiff, f16* mixed) {
    __shared__ float Ks[64][64];
    __shared__ float Vs[64][64];
    const int tid = threadIdx.x, qb = blockIdx.x, vh = blockIdx.y, b = blockIdx.z;
    int qcol, kcol, vcol; f16* outp; int opitch;
    const int s = qb * 256 + tid;
    const size_t trow = (size_t)b * SEQ + s;
    if (vh < 16) { const int h = vh >> 2, i = (vh >> 1) & 1, half = vh & 1; qcol = h * 128 + i * 64; kcol = 512 + h * 128 + i * 64; vcol = 1024 + h * 128 + half * 64;
        outp = sdiff + (size_t)i * NT * 512 + trow * 512 + h * 128 + half * 64; opitch = 512; }
    else { const int g = vh - 16; qcol = 1536 + g * 64; kcol = 2048 + (g >> 2) * 64; vcol = 2176 + (g >> 2) * 64; outp = mixed + trow * DM + 512 + g * 64; opitch = DM; }
    (void)opitch;
    const f16* base = qkv + (size_t)b * RB * NIN;
    float q[64], o[64];
    { const f16* qp = base + (size_t)(CL + s) * NIN + qcol;
#pragma unroll
      for (int i = 0; i < 8; ++i) { const f16x8 t = *(const f16x8*)(qp + i * 8);
#pragma unroll
          for (int j = 0; j < 8; ++j) q[i * 8 + j] = (float)t[j]; } }
#pragma unroll
    for (int i = 0; i < 64; ++i) o[i] = 0.f;
    float m = -1e30f, l = 0.f;
    for (int t = 0; t < RB / 64; ++t) {
        __syncthreads();
        { const int kr = tid >> 2, c8 = (tid & 3) * 16;
          const f16* kp = base + (size_t)(t * 64 + kr) * NIN + kcol + c8; const f16* vp = base + (size_t)(t * 64 + kr) * NIN + vcol + c8;
#pragma unroll
          for (int i = 0; i < 2; ++i) { const f16x8 a = *(const f16x8*)(kp + i * 8), bb = *(const f16x8*)(vp + i * 8);
#pragma unroll
              for (int j = 0; j < 8; ++j) { Ks[kr][c8 + i * 8 + j] = (float)a[j]; Vs[kr][c8 + i * 8 + j] = (float)bb[j]; } } }
        __syncthreads();
        for (int j = 0; j < 64; ++j) {
            float sc = 0.f;
#pragma unroll
            for (int d = 0; d < 64; d += 4) { const f32x4 kk = *(const f32x4*)&Ks[j][d]; sc += q[d] * kk.x + q[d + 1] * kk.y + q[d + 2] * kk.z + q[d + 3] * kk.w; }
            if (sc > m) { const float al = exp2f(m - sc); l *= al;
#pragma unroll
                for (int d = 0; d < 64; ++d) o[d] *= al;
                m = sc; }
            const float pp = exp2f(sc - m); l += pp;
#pragma unroll
            for (int d = 0; d < 64; d += 4) { const f32x4 vv = *(const f32x4*)&Vs[j][d]; o[d] += pp * vv.x; o[d + 1] += pp * vv.y; o[d + 2] += pp * vv.z; o[d + 3] += pp * vv.w; }
        }
    }
    const float il = 1.f / l;
#pragma unroll
    for (int i = 0; i < 8; ++i) { f16x8 t;
#pragma unroll
        for (int j = 0; j < 8; ++j) t[j] = (f16)(o[i * 8 + j] * il);
        *(f16x8*)(outp + i * 8) = t; }
}

__global__ void __launch_bounds__(256) k_diffcombine(const f16* sdiff, const float* misc, const float* subg, f16* mixed) {
    const int wave = threadIdx.x >> 6, lane = threadIdx.x & 63;
    const size_t row = (size_t)blockIdx.x * 4 + wave;
    const float lam = misc[0];
    const f16x8 a = *(const f16x8*)(sdiff + row * 512 + lane * 8), b = *(const f16x8*)(sdiff + (size_t)NT * 512 + row * 512 + lane * 8);
    float d[8]; float ss = 0.f;
#pragma unroll
    for (int j = 0; j < 8; ++j) { d[j] = (float)a[j] - lam * (float)b[j]; ss += d[j] * d[j]; }
    ss += __shfl_xor(ss, 1); ss += __shfl_xor(ss, 2); ss += __shfl_xor(ss, 4); ss += __shfl_xor(ss, 8);
    const float rstd = rsqrtf(ss * (1.f / 128.f) + EPS) * 0.8f;
    f16x8 o;
#pragma unroll
    for (int j = 0; j < 8; ++j) o[j] = (f16)(d[j] * rstd * subg[(lane & 15) * 8 + j]);
    *(f16x8*)(mixed + row * DM + lane * 8) = o;
}

__global__ void __launch_bounds__(256) k_rowpass(const float* x, const f16* y1, const float* mod, const float* gpost, const float* gpre,
                                                 const float* wr, const float* rbias, float* x1out, f16* h2, int* idx, int* rank, float* gw, int* cnt) {
    __shared__ float hs[8][1024];
    __shared__ float lg[8][64];
    const int tid = threadIdx.x, wave = tid >> 6, lane = tid & 63;
    const int t0 = blockIdx.x * 8;
    for (int rr = 0; rr < 2; ++rr) {
        const int r = wave * 2 + rr; const size_t t = (size_t)t0 + r; const int b = (int)(t / SEQ);
        const float* m = mod + (size_t)b * NMOD;
        float yv[16], xv[16]; float ss = 0.f;
#pragma unroll
        for (int j = 0; j < 4; ++j) { const int c0 = j * 256 + lane * 4; const f16x4 yy = *(const f16x4*)(y1 + t * DM + c0); const f32x4 xx = *(const f32x4*)(x + t * DM + c0);
#pragma unroll
            for (int i = 0; i < 4; ++i) { yv[j * 4 + i] = (float)yy[i]; xv[j * 4 + i] = xx[i]; ss += yv[j * 4 + i] * yv[j * 4 + i]; } }
        const float rstd1 = rsqrtf(wave_sum(ss) * (1.f / DM) + EPS);
        float s2 = 0.f;
#pragma unroll
        for (int j = 0; j < 4; ++j) { const int c0 = j * 256 + lane * 4; const f32x4 gp = *(const f32x4*)(gpost + c0), gt = *(const f32x4*)(m + 2048 + c0); f32x4 o;
#pragma unroll
            for (int i = 0; i < 4; ++i) { const float v = xv[j * 4 + i] + gt[i] * (yv[j * 4 + i] * rstd1 * gp[i]); xv[j * 4 + i] = v; o[i] = v; s2 += v * v; }
            *(f32x4*)(x1out + t * DM + c0) = o; }
        const float rstd2 = rsqrtf(wave_sum(s2) * (1.f / DM) + EPS);
#pragma unroll
        for (int j = 0; j < 4; ++j) { const int c0 = j * 256 + lane * 4; const f32x4 gp = *(const f32x4*)(gpre + c0), sh = *(const f32x4*)(m + 3072 + c0), sc = *(const f32x4*)(m + 4096 + c0); f16x4 o;
#pragma unroll
            for (int i = 0; i < 4; ++i) { const float v = xv[j * 4 + i] * rstd2 * gp[i] * (1.f + sc[i]) + sh[i]; hs[r][c0 + i] = v; o[i] = (f16)v; }
            *(f16x4*)(h2 + t * DM + c0) = o; }
    }
    __syncthreads();
    { const int e = tid & 63, rg = tid >> 6; float a0 = 0.f, a1 = 0.f;
      for (int k = 0; k < DM; ++k) { const float w = wr[k * NE + e]; a0 += hs[rg * 2][k] * w; a1 += hs[rg * 2 + 1][k] * w; }
      lg[rg * 2][e] = a0; lg[rg * 2 + 1][e] = a1; }
    __syncthreads();
    if (tid < 8) {
        const int r = tid; const size_t t = (size_t)t0 + r;
        float* L = lg[r];
        float* SS = hs[r];
        for (int e = 0; e < 64; ++e) { const float s = 1.f / (1.f + expf(-L[e])); SS[e] = s; SS[64 + e] = s + rbias[e]; }
        float* gs = SS + 128;
        for (int g = 0; g < 8; ++g) { float m1 = -INFINITY, m2 = -INFINITY; for (int j = 0; j < 8; ++j) { const float v = SS[64 + g * 8 + j]; if (v > m1) { m2 = m1; m1 = v; } else if (v > m2) m2 = v; } gs[g] = m1 + m2; }
        unsigned gmask = 0;
        for (int it = 0; it < 4; ++it) { int best = 0; float bv = -INFINITY; for (int g = 0; g < 8; ++g) if (!((gmask >> g) & 1) && gs[g] > bv) { bv = gs[g]; best = g; } gmask |= 1u << best; }
        for (int e = 0; e < 64; ++e) if (!((gmask >> (e >> 3)) & 1)) SS[64 + e] = -INFINITY;
        float tot = 0.f;
        for (int k = 0; k < 8; ++k) { int best = 0; float bv = -INFINITY; for (int e = 0; e < 64; ++e) { const float v = SS[64 + e]; if (v > bv) { bv = v; best = e; } } SS[136 + k] = (float)best; SS[144 + k] = SS[best]; tot += SS[best]; SS[64 + best] = -INFINITY; }
        for (int k = 0; k < 8; ++k) { const int e = (int)SS[136 + k]; idx[t * 8 + k] = e; gw[t * 8 + k] = SS[144 + k] / tot * 2.5f; rank[t * 8 + k] = atomicAdd(&cnt[e], 1); }
    }
}

__global__ void __launch_bounds__(256) k_dispatch(const int* idx, const int* rank, const float* gw, const int* cnt, int* tok, int* pair, float* wsl, int* blke, int* nblk) {
    __shared__ int pst[65];
    const int tid = threadIdx.x;
    if (tid == 0) { int a = 0; for (int e = 0; e < 64; ++e) { pst[e] = a; a += ((cnt[e] + 255) >> 8) << 8; } pst[64] = a; }
    __syncthreads();
    const int gid = blockIdx.x * 256 + tid;
    if (gid < NT * 8) { const int e = idx[gid]; const int slot = NT + pst[e] + rank[gid]; const int t = gid >> 3, k = gid & 7; tok[slot] = t; pair[slot] = t * NSLOTK + k; wsl[slot] = gw[gid]; }
    if (gid < NT) { tok[gid] = gid; pair[gid] = gid * NSLOTK + 8; wsl[gid] = 1.f; }
    if (blockIdx.x == 0) {
        const int nb = SH_BLKS + (pst[64] >> 8);
        if (tid == 0) *nblk = nb;
        for (int bk = tid; bk < MAX_BLKS; bk += 256) {
            int e = 64;
            if (bk >= SH_BLKS) { const int off = (bk - SH_BLKS) << 8; e = -1; for (int q = 0; q < 64; ++q) if (off >= pst[q] && off < pst[q + 1]) e = q; }
            blke[bk] = e < 0 ? 0 : e;
        }
    }
}

__global__ void __launch_bounds__(256) k_combine(const unsigned char* yp, const float* mod, const float* gpf, float* out) {
    const int wave = threadIdx.x >> 6, lane = threadIdx.x & 63;
    const size_t t = (size_t)blockIdx.x * 4 + wave; const int b = (int)(t / SEQ);
    float acc[16];
#pragma unroll
    for (int i = 0; i < 16; ++i) acc[i] = 0.f;
    for (int k = 0; k < NSLOTK; ++k) {
        const uint4 w = *(const uint4*)(yp + (t * NSLOTK + k) * DM + lane * 16);
        const unsigned ww[4] = {w.x, w.y, w.z, w.w};
#pragma unroll
        for (int i = 0; i < 4; ++i) { const f32x2 lo = __builtin_amdgcn_cvt_pk_f32_fp8((int)ww[i], false), hi = __builtin_amdgcn_cvt_pk_f32_fp8((int)ww[i], true);
            acc[i * 4] += lo.x; acc[i * 4 + 1] += lo.y; acc[i * 4 + 2] += hi.x; acc[i * 4 + 3] += hi.y; }
    }
    float ss = 0.f;
#pragma unroll
    for (int i = 0; i < 16; ++i) { acc[i] *= (1.f / YSCALE); ss += acc[i] * acc[i]; }
    const float rstd = rsqrtf(wave_sum(ss) * (1.f / DM) + EPS);
    const float* m = mod + (size_t)b * NMOD + 5120;
#pragma unroll
    for (int i = 0; i < 4; ++i) { const int c0 = lane * 16 + i * 4; const f32x4 g = *(const f32x4*)(gpf + c0), gt = *(const f32x4*)(m + c0); f32x4 o = *(f32x4*)(out + t * DM + c0);
#pragma unroll
        for (int j = 0; j < 4; ++j) o[j] += gt[j] * (acc[i * 4 + j] * rstd * g[j]);
        *(f32x4*)(out + t * DM + c0) = o; }
}

extern "C" void kernel_launch(void* const* d_in, const int* in_sizes, int n_in, void* d_out, int out_size, void* d_ws, size_t ws_size, hipStream_t stream) {
    (void)in_sizes; (void)n_in; (void)out_size; (void)ws_size;
    const float* x = (const float*)d_in[0]; const float* c = (const float*)d_in[1]; const float* ctx = (const float*)d_in[2]; const float* c_ctx = (const float*)d_in[3];
    const float* w_mod = (const float*)d_in[4]; const float* b_mod = (const float*)d_in[5]; const float* g_pre_mix = (const float*)d_in[6]; const float* g_post_mix = (const float*)d_in[7];
    const float* w_in = (const float*)d_in[8]; const float* qg = (const float*)d_in[9]; const float* kg = (const float*)d_in[10];
    const float* lq1 = (const float*)d_in[11]; const float* lk1 = (const float*)d_in[12]; const float* lq2 = (const float*)d_in[13]; const float* lk2 = (const float*)d_in[14];
    const float* subg = (const float*)d_in[15]; const float* w_out = (const float*)d_in[16]; const float* g_pre_ffn = (const float*)d_in[17]; const float* g_post_ffn = (const float*)d_in[18];
    const float* w_router = (const float*)d_in[19]; const float* rbias = (const float*)d_in[20];
    const float* weg = (const float*)d_in[21]; const float* weu = (const float*)d_in[22]; const float* wed = (const float*)d_in[23];
    const float* wsg = (const float*)d_in[24]; const float* wsu = (const float*)d_in[25]; const float* wsd = (const float*)d_in[26];
    unsigned char* ws = (unsigned char*)d_ws; float* out = (float*)d_out;
    int* cnt = (int*)(ws + WS_CTL); int* nblk = (int*)(ws + WS_CTL + 256);
    float* mod = (float*)(ws + WS_MOD); float* rope = (float*)(ws + WS_ROPE); float* misc = (float*)(ws + WS_MISC); int* blke = (int*)(ws + WS_BLKE);
    f16* WinT = (f16*)(ws + WS_WIN); f16* WoutT = (f16*)(ws + WS_WOUT); f16* WguT = (f16*)(ws + WS_WGU); f16* WdT = (f16*)(ws + WS_WD);
    f16* hall = (f16*)(ws + WS_HALL); f16* mixed = (f16*)(ws + WS_MIXED); f16* qkv = (f16*)(ws + WS_QKV); f16* sdiff = (f16*)(ws + WS_SDIFF); f16* y1 = (f16*)(ws + WS_Y1);
    f16* H = (f16*)(ws + WS_H); unsigned char* yp = ws + WS_YP; f16* h2 = (f16*)(ws + WS_H2); f16* G = (f16*)(ws + WS_G);
    int* idx = (int*)(ws + WS_IDX); int* rank = (int*)(ws + WS_RANK); float* gw = (float*)(ws + WS_GW); int* tok = (int*)(ws + WS_TOK); int* pair = (int*)(ws + WS_PAIR); float* wsl = (float*)(ws + WS_WSL);

    hipMemsetAsync(ws + WS_CTL, 0, 4096, stream);
    hipMemsetAsync(tok, 0, (size_t)MAX_SLOTS * 4, stream);
    hipMemsetAsync(pair, 0xFF, (size_t)MAX_SLOTS * 4, stream);
    hipMemsetAsync(wsl, 0, (size_t)MAX_SLOTS * 4, stream);

    k_mod<<<NMOD / 256, 256, 0, stream>>>(c, c_ctx, w_mod, b_mod, mod, lq1, lk1, lq2, lk2, misc, rope);
    k_transpose<<<dim3(NIN / 32, DM / 32, 1), 256, 0, stream>>>(w_in, WinT, DM, NIN, 0, 0, 0);
    k_transpose<<<dim3(DM / 32, DM / 32, 1), 256, 0, stream>>>(w_out, WoutT, DM, DM, 0, 0, 0);
    k_transpose<<<dim3(EH / 32, DM / 32, 64), 256, 0, stream>>>(weg, WguT, DM, EH, (size_t)DM * EH, (size_t)512 * DM, 1);
    k_transpose<<<dim3(EH / 32, DM / 32, 64), 256, 0, stream>>>(weu, WguT, DM, EH, (size_t)DM * EH, (size_t)512 * DM, 2);
    k_transpose<<<dim3(DM / 32, EH / 32, 64), 256, 0, stream>>>(wed, WdT, EH, DM, (size_t)DM * EH, (size_t)DM * EH, 0);
    k_transpose<<<dim3(EH / 32, DM / 32, 1), 256, 0, stream>>>(wsg, WguT + (size_t)64 * 512 * DM, DM, EH, 0, 0, 1);
    k_transpose<<<dim3(EH / 32, DM / 32, 1), 256, 0, stream>>>(wsu, WguT + (size_t)64 * 512 * DM, DM, EH, 0, 0, 2);
    k_transpose<<<dim3(DM / 32, EH / 32, 1), 256, 0, stream>>>(wsd, WdT + (size_t)64 * DM * EH, EH, DM, 0, 0, 0);
    k_prenorm<<<RALL / 4, 256, 0, stream>>>(x, ctx, g_pre_mix, mod, hall);
    { GemmP p{}; p.A = hall; p.Bt = WinT; p.out = qkv; p.K = DM; p.N = NIN; k_gemm<0><<<dim3(NIN / 64, RALL / 64), 256, 0, stream>>>(p); }
    k_qkpost<<<(RALL * 26 + 255) / 256, 256, 0, stream>>>(qkv, qg, kg, rope);
    k_attn_naive<<<dim3(SEQ / 256, 24, NB), 256, 0, stream>>>(qkv, sdiff, mixed);
    k_diffcombine<<<NT / 4, 256, 0, stream>>>(sdiff, misc, subg, mixed);
    { GemmP p{}; p.A = mixed; p.Bt = WoutT; p.out = y1; p.K = DM; p.N = DM; k_gemm<1><<<dim3(DM / 64, NT / 64), 256, 0, stream>>>(p); }
    k_rowpass<<<NT / 8, 256, 0, stream>>>(x, y1, mod, g_post_mix, g_pre_ffn, w_router, rbias, out, h2, idx, rank, gw, cnt);
    k_dispatch<<<NT * 8 / 256, 256, 0, stream>>>(idx, rank, gw, cnt, tok, pair, wsl, blke, nblk);
    { GemmP p{}; p.A = h2; p.Bt = WguT; p.out = G; p.K = DM; p.N = EH; p.tok = tok; p.pair = pair; p.wsl = wsl; p.blke = blke; p.nblk = nblk; p.G = G;
      k_gemm<2><<<dim3(EH / 64, MAX_SLOTS / 64), 256, 0, stream>>>(p);
      p.out = H; k_gemm<3><<<dim3(EH / 64, MAX_SLOTS / 64), 256, 0, stream>>>(p);
      p.A = H; p.Bt = WdT; p.out = yp; p.K = EH; p.N = DM; k_gemm<4><<<dim3(DM / 64, MAX_SLOTS / 64), 256, 0, stream>>>(p); }
    k_combine<<<NT / 4, 256, 0, stream>>>(yp, mod, g_post_ffn, out);
}
```

```cpp
#include <hip/hip_runtime.h>
#include <hip/hip_cooperative_groups.h>
#include <stdint.h>
#include <math.h>
#include <cstdio>
namespace cg = cooperative_groups;

typedef _Float16 f16;
typedef _Float16 f16x8 __attribute__((ext_vector_type(8)));
typedef _Float16 f16x4 __attribute__((ext_vector_type(4)));
typedef float f32x4 __attribute__((ext_vector_type(4)));
typedef float f32x2 __attribute__((ext_vector_type(2)));
#define DEV __device__ __forceinline__
#define LAS __attribute__((address_space(3)))

constexpr int NB = 32, SEQ = 2048, DM = 1024, NT = NB * SEQ, CL = 256, RB = SEQ + CL, RALL = NB * RB;
constexpr int NIN = 2304, NMOD = 6144, NE = 64, EH = 256, TOPK = 8, NSLOTK = 9;
constexpr int SH_BLKS = NT / 256;
constexpr int MAX_BLKS = SH_BLKS + (NT * TOPK) / 256 + NE;
constexpr int MAX_SLOTS = MAX_BLKS * 256;
constexpr float EPS = 1e-6f;
constexpr float QSCALE = 0.125f * 1.4426950408889634f;
constexpr float YSCALE = 8.0f;
constexpr int NTHR = 512, NWAVE = 8;
constexpr int LDS_BYTES = 147456;

constexpr size_t MiB = 1ull << 20;
constexpr size_t WS_CTL = 0;
constexpr size_t WS_CNT = 32768;
constexpr size_t WS_BAR = 4096;
constexpr size_t WS_MOD = 64 * 1024;
constexpr size_t WS_ROPE = 1 * MiB;
constexpr size_t WS_MISC = 1 * MiB + 64 * 1024;
constexpr size_t WS_BLKE = 1 * MiB + 128 * 1024;
constexpr size_t WS_WIN = 4 * MiB;
constexpr size_t WS_WOUT = WS_WIN + (size_t)NIN * DM * 2;
constexpr size_t WS_WGU = WS_WOUT + (size_t)DM * DM * 2;
constexpr size_t WS_WD = WS_WGU + (size_t)65 * 512 * DM * 2;
constexpr size_t WS_WEND = WS_WD + (size_t)65 * DM * EH * 2;
static_assert(WS_WEND <= 108 * MiB, "weights");
constexpr size_t WS_HALL = 108 * MiB;
constexpr size_t WS_MIXED = 108 * MiB;
constexpr size_t WS_QKV = 252 * MiB;
constexpr size_t WS_SDIFF = 576 * MiB;
constexpr size_t WS_Y1 = 704 * MiB;
constexpr size_t WS_H = 108 * MiB;
constexpr size_t WS_YP = 404 * MiB;
constexpr size_t WS_H2 = 404 * MiB;
constexpr size_t WS_TAB = 980 * MiB;
constexpr size_t WS_IDX = WS_TAB;
constexpr size_t WS_RANK = WS_IDX + (size_t)NT * 8 * 4;
constexpr size_t WS_GW = WS_RANK + (size_t)NT * 8 * 4;
constexpr size_t WS_TOK = WS_GW + (size_t)NT * 8 * 4;
constexpr size_t WS_PAIR = WS_TOK + (size_t)MAX_SLOTS * 4;
constexpr size_t WS_WSL = WS_PAIR + (size_t)MAX_SLOTS * 4;
constexpr size_t WS_WGB = WS_WSL + (size_t)MAX_SLOTS * 4;
constexpr size_t WS_END = WS_WGB + (size_t)1024 * 64 * 4;
static_assert(WS_END <= 1024 * MiB, "ws");

DEV float wave_sum(float v) {
#pragma unroll
    for (int o = 32; o > 0; o >>= 1) v += __shfl_xor(v, o);
    return v;
}
DEV float silu(float v) { return v / (1.f + __expf(-v)); }
DEV float silu_f(float v) { return v * __builtin_amdgcn_rcpf(1.f + __builtin_amdgcn_exp2f(v * -1.44269504f)); }
DEV float c8(float v) { return __builtin_amdgcn_fmed3f(v, -448.f, 448.f); }
DEV unsigned char f2fp8(float v) { const int r = __builtin_amdgcn_cvt_pk_fp8_f32(v, v, 0, false); return (unsigned char)(r & 0xff); }

struct Args { const float* in[27]; float* out; unsigned char* ws; int ph_lo, ph_hi; };
struct Frame {
    unsigned char* lds; int tid, lane, wave, bid, G, gw, NGW;
    const float* const* in; float* out; unsigned char* ws;
};
#define WSP(T, off) ((T*)(F.ws + (off)))

DEV void ph_mod(const Frame& F) {
    const float* c = F.in[1]; const float* c_ctx = F.in[3]; const float* w_mod = F.in[4]; const float* b_mod = F.in[5];
    float* mod = WSP(float, WS_MOD);
    if (F.bid == 0) {
        if (F.tid < 64) { float a = F.in[11][F.tid] * F.in[12][F.tid], b = F.in[13][F.tid] * F.in[14][F.tid]; a = wave_sum(a); b = wave_sum(b); if (F.tid == 0) WSP(float, WS_MISC)[0] = expf(a) - expf(b) + 0.2f; }
        float* rope = WSP(float, WS_ROPE);
        for (int i = F.tid; i < 64 * 16; i += NTHR) { const int pos = i >> 4, j = i & 15; const float ang = (float)pos * powf(10000.0f, -(float)j / 16.0f); rope[i * 2] = cosf(ang); rope[i * 2 + 1] = sinf(ang); }
    }
    constexpr int MC = 24;
    if (F.bid >= NMOD / MC) return;
    float* sc = (float*)F.lds;
    const int c0 = F.bid * MC, kh = F.lane / MC, col = F.lane - kh * MC;
    const float* wp = w_mod + (size_t)(F.wave * 128 + kh) * NMOD + c0 + col;
    float wa[8], wb[8];
#define MOD_LOAD(W, IT0) do { if (kh < 2) { _Pragma("unroll") for (int u = 0; u < 8; ++u) W[u] = wp[(size_t)((IT0) + u) * 2 * NMOD]; } } while (0)
#define MOD_FMA(W, IT0) do { if (kh < 2) { _Pragma("unroll") for (int u = 0; u < 8; ++u) { const int k = F.wave * 128 + ((IT0) + u) * 2 + kh; _Pragma("unroll") for (int r = 0; r < 33; ++r) acc[r] += sc[r * DM + k] * W[u]; } } } while (0)
    MOD_LOAD(wa, 0);
    for (int i = F.tid; i < 33 * DM; i += NTHR) { const int r = i >> 10, k = i & 1023; sc[i] = silu_f(r < 32 ? c[r * DM + k] : c_ctx[k]); }
    __syncthreads();
    float acc[33];
#pragma unroll
    for (int r = 0; r < 33; ++r) acc[r] = 0.f;
#pragma unroll 1
    for (int it0 = 0; it0 < 64; it0 += 16) {
        MOD_LOAD(wb, it0 + 8); MOD_FMA(wa, it0);
        if (it0 + 16 < 64) MOD_LOAD(wa, it0 + 16);
        MOD_FMA(wb, it0 + 8);
    }
#undef MOD_LOAD
#undef MOD_FMA
#pragma unroll
    for (int r = 0; r < 33; ++r) acc[r] += __shfl_down(acc[r], MC);
    __syncthreads();
    float* red = (float*)F.lds;
    if (F.lane < MC) {
#pragma unroll
        for (int r = 0; r < 33; ++r) red[(F.wave * 33 + r) * MC + col] = acc[r];
    }
    __syncthreads();
    for (int i = F.tid; i < 33 * MC; i += NTHR) { const int r = i / MC, cc = i - r * MC; float s = b_mod[c0 + cc];
#pragma unroll
        for (int w = 0; w < 8; ++w) s += red[(w * 33 + r) * MC + cc];
        mod[(size_t)r * NMOD + c0 + cc] = s; }
    __syncthreads();
}

struct WItem { const float* W; unsigned char* WT; int K, N, rowmode, f8, item; };
DEV void wconv_load(const WItem& d, int lane, f32x4 (&t)[8]) {
    const int nblk = d.N / 32, kb = d.item / nblk, nb = d.item % nblk, k0 = 64 * kb, n0 = 32 * nb;
#pragma unroll
    for (int i = 0; i < 8; ++i) t[i] = *(const f32x4*)(d.W + (size_t)(k0 + i * 8 + (lane >> 3)) * d.N + n0 + (lane & 7) * 4);
}
DEV void wconv_put(const WItem& d, int lane, const f32x4 (&t)[8], float* scr) {
    const int K = d.K, nblk = d.N / 32, kb = d.item / nblk, nb = d.item % nblk, k0 = 64 * kb, n0 = 32 * nb;
#pragma unroll
    for (int i = 0; i < 8; ++i) { float* q = scr + (i * 8 + (lane >> 3)) * 33 + (lane & 7) * 4; q[0] = t[i].x; q[1] = t[i].y; q[2] = t[i].z; q[3] = t[i].w; }
    __builtin_amdgcn_s_waitcnt(0xC07F); asm volatile("" ::: "memory");
    const int c = lane & 7;
#pragma unroll
    for (int j = 0; j < 4; ++j) {
        const int n = (lane >> 3) + 8 * j; const float* sp = scr + (8 * c) * 33 + n;
        const int nn = n0 + n;
        int row;
        if (d.rowmode == 0) row = nn;
        else if (d.rowmode == 3) { const int cc = nn & 255; row = (nn & ~255) + ((cc >> 5) & 1) * 128 + (cc >> 6) * 32 + (cc & 31); }
        else row = (nn >> 7) * 256 + (nn & 127) + (d.rowmode == 2 ? 128 : 0);
        if (d.f8) {
            int lo = __builtin_amdgcn_cvt_pk_fp8_f32(c8(sp[0] * 64.f), c8(sp[33] * 64.f), 0, false); lo = __builtin_amdgcn_cvt_pk_fp8_f32(c8(sp[66] * 64.f), c8(sp[99] * 64.f), lo, true);
            int hi = __builtin_amdgcn_cvt_pk_fp8_f32(c8(sp[132] * 64.f), c8(sp[165] * 64.f), 0, false); hi = __builtin_amdgcn_cvt_pk_fp8_f32(c8(sp[198] * 64.f), c8(sp[231] * 64.f), hi, true);
            *(uint2*)(d.WT + (size_t)row * K + k0 + 8 * c) = make_uint2((unsigned)lo, (unsigned)hi);
        } else {
            f16x8 o;
#pragma unroll
            for (int q = 0; q < 8; ++q) o[q] = (f16)sp[q * 33];
            *(f16x8*)(d.WT + ((size_t)row * K + k0 + 8 * c) * 2) = o;
        }
    }
    __builtin_amdgcn_s_waitcnt(0xC07F); asm volatile("" ::: "memory");
}
DEV void ph_wconv(const Frame& F) {
    float* scr = (float*)(F.lds + F.wave * 16384);
    constexpr int I_IN = (DM / 64) * (NIN / 32), I_OUT = (DM / 64) * (DM / 32), I_E = (DM / 64) * (EH / 32);
    constexpr int NITEMS = I_IN + I_OUT + 65 * 3 * I_E;
    auto decode = [&](int it, WItem& d) {
        int r = it;
        if (r < I_IN) { d = WItem{F.in[8], F.ws + WS_WIN, DM, NIN, 3, 0, r}; return; } r -= I_IN;
        if (r < I_OUT) { d = WItem{F.in[16], F.ws + WS_WOUT, DM, DM, 0, 0, r}; return; } r -= I_OUT;
        const int e = r / (3 * I_E), q = (r % (3 * I_E)) / I_E, ii = r % I_E;
        if (q == 0) d = WItem{e < 64 ? F.in[21] + (size_t)e * DM * EH : F.in[24], F.ws + WS_WGU + (size_t)e * 512 * DM, DM, EH, 1, 1, ii};
        else if (q == 1) d = WItem{e < 64 ? F.in[22] + (size_t)e * DM * EH : F.in[25], F.ws + WS_WGU + (size_t)e * 512 * DM, DM, EH, 2, 1, ii};
        else d = WItem{e < 64 ? F.in[23] + (size_t)e * DM * EH : F.in[26], F.ws + WS_WD + (size_t)e * DM * EH, EH, DM, 3, 1, ii};
    };
    int it = F.gw; if (it >= NITEMS) return;
    WItem cur, nxt; f32x4 ta[8], tb[8];
    decode(it, cur); wconv_load(cur, F.lane, ta);
#pragma unroll 1
    for (;;) {
        const int i1 = it + F.NGW; const bool h1 = i1 < NITEMS;
        if (h1) { decode(i1, nxt); wconv_load(nxt, F.lane, tb); }
        wconv_put(cur, F.lane, ta, scr);
        if (!h1) break;
        const int i2 = i1 + F.NGW; const bool h2 = i2 < NITEMS;
        if (h2) { decode(i2, cur); wconv_load(cur, F.lane, ta); }
        wconv_put(nxt, F.lane, tb, scr);
        if (!h2) break;
        it = i2;
    }
}

DEV void ph_prenorm(const Frame& F) {
    const float* x = F.in[0]; const float* ctx = F.in[2]; const float* g = F.in[6]; const float* mod = WSP(float, WS_MOD); f16* hall = WSP(f16, WS_HALL);
    const int lane = F.lane;
    for (int row0 = F.gw * 2; row0 < RALL; row0 += F.NGW * 2) {
        f32x4 v[2][4]; float ss[2]; const float* mp[2];
#pragma unroll
        for (int u = 0; u < 2; ++u) { const int row = row0 + u; const int b = row / RB, p = row % RB;
            const float* src = p < CL ? ctx + ((size_t)b * CL + p) * DM : x + ((size_t)b * SEQ + (p - CL)) * DM;
            mp[u] = mod + (size_t)(p < CL ? 32 : b) * NMOD; ss[u] = 0.f;
#pragma unroll
            for (int j = 0; j < 4; ++j) v[u][j] = *(const f32x4*)(src + j * 256 + lane * 4); }
#pragma unroll
        for (int u = 0; u < 2; ++u) {
#pragma unroll
            for (int j = 0; j < 4; ++j) ss[u] += v[u][j].x * v[u][j].x + v[u][j].y * v[u][j].y + v[u][j].z * v[u][j].z + v[u][j].w * v[u][j].w;
            const float rstd = rsqrtf(wave_sum(ss[u]) * (1.f / DM) + EPS);
#pragma unroll
            for (int j = 0; j < 4; ++j) {
                const int c0 = j * 256 + lane * 4;
                const f32x4 gg = *(const f32x4*)(g + c0), sh = *(const f32x4*)(mp[u] + c0), sc = *(const f32x4*)(mp[u] + 1024 + c0);
                f16x4 o;
                o.x = (f16)(v[u][j].x * rstd * gg.x * (1.f + sc.x) + sh.x); o.y = (f16)(v[u][j].y * rstd * gg.y * (1.f + sc.y) + sh.y);
                o.z = (f16)(v[u][j].z * rstd * gg.z * (1.f + sc.z) + sh.z); o.w = (f16)(v[u][j].w * rstd * gg.w * (1.f + sc.w) + sh.w);
                *(f16x4*)(hall + (size_t)(row0 + u) * DM + c0) = o;
            }
        }
    }
}


namespace pg8 {
typedef int v8i __attribute__((ext_vector_type(8)));
typedef unsigned u32x4v __attribute__((ext_vector_type(4)));
constexpr int BM = 256, BK = 64, HALF = 128, HTB = HALF * BK * 2  , STAGE_BYTES = 8 * HTB;
DEV int lds_byte(int r, int c) { const int st = (r >> 4) * 2 + (c >> 5), rr = r & 15, cc = c & 31, ob = rr * 64 + cc * 2; return st * 1024 + (ob ^ (((ob >> 9) & 1) << 5)); }
DEV void stage_rc(int b, int& R, int& C) { const int st = b / 1024, sb = b % 1024, swz = sb ^ (((sb >> 9) & 1) << 5); R = (st >> 1) * 16 + swz / 64; C = (st & 1) * 32 + (swz % 64) / 2; }
struct GUnit { const char* A; const char* B; int pm, pn, aux; };
DEV void glds16s(const char* sbase, unsigned voff, unsigned lds_dst) { unsigned keep;
    asm volatile("s_mov_b32 %0, m0\n\ts_mov_b32 m0, %3\n\ts_nop 0\n\tglobal_load_lds_dwordx4 %1, %2\n\ts_mov_b32 m0, %0" : "=&s"(keep) : "v"(voff), "s"(sbase), "s"(lds_dst) : "memory"); }
DEV void stage2(LAS unsigned char* lds, unsigned bufoff, const char* base, unsigned o0, unsigned o1) {
    const unsigned d = (unsigned)__builtin_amdgcn_readfirstlane((int)((unsigned)(uintptr_t)lds + bufoff));
    glds16s(base, o0, d); glds16s(base, o1, d + 8192u);
}
template <class Epi, class Sched, bool GATHER, bool FP8 = false, bool ARES = false>
DEV void gemm_phase(LAS unsigned char* lds, const int PB, const Sched& S, const Epi& E, const int* tok, const char* Ag, const unsigned* rowarg, const int scaleW = 0x7F7F7F7F, const int scaleA = 0x7F7F7F7F) {
    const int tid = threadIdx.x, wid = __builtin_amdgcn_readfirstlane(tid >> 6), lane = tid & 63, wr = wid >> 2, wc = wid & 3, fr = lane & 15, fq = lane >> 4;
    const int nt = PB / 128;
    unsigned voff[2]; int sR[2]; unsigned sC2[2];
#pragma unroll
    for (int i = 0; i < 2; ++i) { int R, C; stage_rc(tid * 16 + i * 8192, R, C); sR[i] = R; sC2[i] = (unsigned)C * 2u; voff[i] = (unsigned)(R * PB) + (unsigned)C * 2u; }
    const size_t kstep = (size_t)(BK * 2), hstep = (size_t)HALF * PB;
    const unsigned ldsw = (unsigned)wid * 1024u;
    const int aoff = FP8 ? lds_byte(wr * 64 + fr, fq * 16) : lds_byte(wr * 64 + fr, fq * 8), boff = FP8 ? lds_byte(wc * 32 + fr, fq * 16) : lds_byte(wc * 32 + fr, fq * 8);
#define PG8_SA(b, h) (((b) * 2 + (h)) * HTB)
#define PG8_SB(b, h) ((4 + (b) * 2 + (h)) * HTB)
#define PG8_STB(bufoff, gbase) stage2(lds, (bufoff) + ldsw, (gbase), voff[0], voff[1])
#define PG8_STA(bufoff, dbase, gko, g0, g1) do { if (GATHER) stage2(lds, (bufoff) + ldsw, Ag + (gko), (g0), (g1)); else stage2(lds, (bufoff) + ldsw, (dbase), voff[0], voff[1]); } while (0)
#define PG8_LDA(dst, b, h) do { if constexpr (FP8) { _Pragma("unroll") for (int m = 0; m < 4; ++m) { const u32x4v lo_ = *(const LAS u32x4v*)(lds + PG8_SA(b, h) + aoff + m * 2048), hi_ = *(const LAS u32x4v*)(lds + PG8_SA(b, h) + aoff + m * 2048 + 16); \
            dst##8[m] = (v8i){(int)lo_.x, (int)lo_.y, (int)lo_.z, (int)lo_.w, (int)hi_.x, (int)hi_.y, (int)hi_.z, (int)hi_.w}; } } \
        else { _Pragma("unroll") for (int m = 0; m < 4; ++m) _Pragma("unroll") for (int k = 0; k < 2; ++k) dst[m][k] = *(const LAS f16x8*)(lds + PG8_SA(b, h) + aoff + m * 2048 + k * 1024); } } while (0)
#define PG8_LDB(dst, b, h) do { if constexpr (FP8) { _Pragma("unroll") for (int n = 0; n < 2; ++n) { const u32x4v lo_ = *(const LAS u32x4v*)(lds + PG8_SB(b, h) + boff + n * 2048), hi_ = *(const LAS u32x4v*)(lds + PG8_SB(b, h) + boff + n * 2048 + 16); \
            dst##8[n] = (v8i){(int)lo_.x, (int)lo_.y, (int)lo_.z, (int)lo_.w, (int)hi_.x, (int)hi_.y, (int)hi_.z, (int)hi_.w}; } } \
        else { _Pragma("unroll") for (int n = 0; n < 2; ++n) _Pragma("unroll") for (int k = 0; k < 2; ++k) dst[n][k] = *(const LAS f16x8*)(lds + PG8_SB(b, h) + boff + n * 2048 + k * 1024); } } while (0)
#define PG8_MMA(ai, bj, At, Bt, Z) do { __builtin_amdgcn_s_setprio(1); if constexpr (FP8) { _Pragma("unroll") for (int m = 0; m < 4; ++m) _Pragma("unroll") for (int n = 0; n < 2; ++n) { \
            if (Z) asm volatile("v_mfma_scale_f32_16x16x128_f8f6f4 %0, %1, %2, 0, %3, %4 op_sel_hi:[0,0,0]" : "=&v"(acc[ai][bj][m][n]) : "v"(Bt##8[n]), "v"(At##8[m]), "v"(scaleW), "v"(scaleA)); \
            else asm volatile("v_mfma_scale_f32_16x16x128_f8f6f4 %0, %1, %2, %0, %3, %4 op_sel_hi:[0,0,0]" : "+v"(acc[ai][bj][m][n]) : "v"(Bt##8[n]), "v"(At##8[m]), "v"(scaleW), "v"(scaleA)); } } \
        else { _Pragma("unroll") for (int m = 0; m < 4; ++m) _Pragma("unroll") for (int n = 0; n < 2; ++n) { \
            acc[ai][bj][m][n] = __builtin_amdgcn_mfma_f32_16x16x32_f16(Bt[n][0], At[m][0], (Z) ? (f32x4){0.f, 0.f, 0.f, 0.f} : acc[ai][bj][m][n], 0, 0, 0); \
            acc[ai][bj][m][n] = __builtin_amdgcn_mfma_f32_16x16x32_f16(Bt[n][1], At[m][1], acc[ai][bj][m][n], 0, 0, 0); } } __builtin_amdgcn_s_setprio(0); } while (0)
#define PG8_WAIT_V(n) asm volatile("s_waitcnt vmcnt(" #n ")" ::: "memory")
#define PG8_WAIT_L(n) asm volatile("s_waitcnt lgkmcnt(" #n ")" ::: "memory")
#define PG8_BAR __builtin_amdgcn_s_barrier()
#define PG8_SCHED __builtin_amdgcn_sched_barrier(0)
    LAS unsigned* const sideR = (LAS unsigned*)(lds + STAGE_BYTES), * const sideE = (LAS unsigned*)(lds + STAGE_BYTES + 2048), * const sideT = (LAS unsigned*)(lds + STAGE_BYTES + 2560);
    GUnit cur, nxt, nn; int ui = 0; bool sc = false;
    if (!S.next(0, cur)) return;
    if constexpr (Sched::HAS_E) cur.B = S.bptr(cur, __builtin_amdgcn_readfirstlane(*S.eptr(cur)));
    unsigned cg0[2] = {0, 0}, cg1[2] = {0, 0}, ng0[2] = {0, 0}, ng1[2] = {0, 0};
    if (GATHER) {
#pragma unroll
        for (int i = 0; i < 2; ++i) { cg0[i] = (unsigned)tok[cur.pm * 256 + sR[i]] * (unsigned)PB + sC2[i]; cg1[i] = (unsigned)tok[cur.pm * 256 + 128 + sR[i]] * (unsigned)PB + sC2[i]; }
    }
#define PG8_SIDE_NEXT(u_, slot_) do { \
        if (Sched::HAS_E && wid == 4) __builtin_amdgcn_global_load_lds((const unsigned*)S.eptr(u_), sideE + (slot_) * 64, 4, 0, 0); \
        if (GATHER && wid >= 4) __builtin_amdgcn_global_load_lds((const unsigned*)tok + (u_).pm * 256 + (wid - 4) * 64 + lane, sideT + (slot_) * 256 + (wid - 4) * 64, 4, 0, 0); } while (0)
    if ((Sched::HAS_E || GATHER) && S.next(1, nxt)) PG8_SIDE_NEXT(nxt, 1);
    f32x4 acc[2][2][4][2];
    f16x8 At[4][2], B0[2][2], B1[2][2]; v8i At8[4], B08[2], B18[2];
    const char* cA = cur.A; const char* cB = cur.B;
    PG8_STB(PG8_SB(0, 0), cB); PG8_STB(PG8_SB(0, 1), cB + hstep); PG8_STA(PG8_SA(0, 0), cA, 0, cg0[0], cg0[1]); PG8_STA(PG8_SA(0, 1), cA + hstep, 0, cg1[0], cg1[1]);
    if (wr == 1) PG8_BAR;
    PG8_WAIT_V(2); PG8_BAR;
    PG8_STB(PG8_SB(1, 0), cB + kstep); PG8_STA(PG8_SA(1, 0), cA + kstep, kstep, cg0[0], cg0[1]); PG8_STB(PG8_SB(1, 1), cB + hstep + kstep);
    PG8_WAIT_V(0); PG8_BAR;
    for (;;) {
        const bool has_next = S.next(ui + 1, nxt);
        if (has_next) {
            if constexpr (Sched::HAS_E) nxt.B = S.bptr(nxt, __builtin_amdgcn_readfirstlane((int)sideE[((ui + 1) & 1) * 64]));
            if (GATHER) {
#pragma unroll
                for (int i = 0; i < 2; ++i) { ng0[i] = sideT[((ui + 1) & 1) * 256 + sR[i]] * (unsigned)PB + sC2[i]; ng1[i] = sideT[((ui + 1) & 1) * 256 + 128 + sR[i]] * (unsigned)PB + sC2[i]; }
            }
        } else { ng0[0] = cg0[0]; ng0[1] = cg0[1]; ng1[0] = cg1[0]; ng1[1] = cg1[1]; }
        if (rowarg != nullptr && wid < 4) __builtin_amdgcn_global_load_lds(rowarg + cur.pm * 256 + wid * 64 + lane, sideR + (ui & 1) * 256 + wid * 64, 4, 0, 0);
        if ((Sched::HAS_E || GATHER) && has_next && S.next(ui + 2, nn)) PG8_SIDE_NEXT(nn, ui & 1);
        const char* nA = has_next ? nxt.A : cA; const char* nB = has_next ? nxt.B : cB;
        const bool sn = ARES && has_next && nxt.pm == cur.pm;
#define PG8_ITER(FIRST) do { \
            const bool last = (t == nt - 2); \
            const size_t ko1 = (size_t)(t + 1) * kstep, ko2 = last ? 0 : (size_t)(t + 2) * kstep, ko3 = ko2 + kstep; \
            const char* a1 = cA + ko1; \
            const char* a2 = (last ? nA : cA) + ko2; const char* b2 = (last ? nB : cB) + ko2; \
            const char* a3 = a2 + kstep; const char* b3 = b2 + kstep; \
            const unsigned g20 = last ? ng0[0] : cg0[0], g21 = last ? ng0[1] : cg0[1], h20 = last ? ng1[0] : cg1[0], h21 = last ? ng1[1] : cg1[1]; \
              \
            PG8_LDB(B0, 0, 0); PG8_LDB(B1, 0, 1); PG8_SCHED; PG8_LDA(At, 0, 0); if (!(ARES && sc)) PG8_STA(PG8_SA(1, 1), a1 + hstep, ko1, cg1[0], cg1[1]); \
            if (!(FIRST)) PG8_WAIT_V(8); PG8_WAIT_L(0); PG8_BAR; PG8_MMA(0, 0, At, B0, FIRST); PG8_MMA(0, 1, At, B1, FIRST); PG8_BAR; PG8_SCHED; \
              \
            PG8_LDA(At, 0, 1); PG8_STB(PG8_SB(0, 0), b2); PG8_STB(PG8_SB(0, 1), b2 + hstep); if (!(ARES && sn)) PG8_STA(PG8_SA(0, 0), a2, ko2, g20, g21); \
            if (!(FIRST)) PG8_WAIT_V(8); PG8_WAIT_L(0); PG8_BAR; PG8_MMA(1, 0, At, B0, FIRST); PG8_MMA(1, 1, At, B1, FIRST); PG8_BAR; PG8_SCHED; \
              \
            PG8_LDB(B0, 1, 0); PG8_LDB(B1, 1, 1); PG8_SCHED; PG8_LDA(At, 1, 0); if (!(ARES && sn)) PG8_STA(PG8_SA(0, 1), a2 + hstep, ko2, h20, h21); \
            if (ARES && sn) PG8_WAIT_V(4); else PG8_WAIT_V(8); PG8_WAIT_L(0); PG8_BAR; PG8_MMA(0, 0, At, B0, 0); PG8_MMA(0, 1, At, B1, 0); PG8_BAR; PG8_SCHED; \
              \
            PG8_LDA(At, 1, 1); PG8_STB(PG8_SB(1, 0), b3); PG8_STB(PG8_SB(1, 1), b3 + hstep); if (!(ARES && sn)) PG8_STA(PG8_SA(1, 0), a3, ko3, g20, g21); \
            if (ARES && sn) PG8_WAIT_V(4); else PG8_WAIT_V(8); PG8_WAIT_L(0); PG8_BAR; PG8_MMA(1, 0, At, B0, 0); PG8_MMA(1, 1, At, B1, 0); PG8_BAR; PG8_SCHED; \
        } while (0)
        { const int t = 0; PG8_ITER(1); }
#pragma unroll 1
        for (int t = 2; t < nt; t += 2) PG8_ITER(0);
        if constexpr (FP8) {
#pragma unroll
            for (int a_ = 0; a_ < 2; ++a_)
#pragma unroll
                for (int b_ = 0; b_ < 2; ++b_)
                    asm volatile("s_nop 15\n\ts_nop 7" : "+v"(acc[a_][b_][0][0]), "+v"(acc[a_][b_][0][1]), "+v"(acc[a_][b_][1][0]), "+v"(acc[a_][b_][1][1]), "+v"(acc[a_][b_][2][0]), "+v"(acc[a_][b_][2][1]), "+v"(acc[a_][b_][3][0]), "+v"(acc[a_][b_][3][1]));
        }
        PG8_WAIT_V(0);
        if (wr == 0) PG8_BAR;
        { int fr_e = fr, fq_e = fq; asm volatile("" : "+v"(fr_e), "+v"(fq_e));
          E(acc, cur, wr, wc, fr_e, fq_e, (const LAS unsigned*)(sideR + (ui & 1) * 256)); }
        if (!has_next) break;
        cur = nxt; cA = nA; cB = nB; ++ui; sc = sn;
        cg0[0] = ng0[0]; cg0[1] = ng0[1]; cg1[0] = ng1[0]; cg1[1] = ng1[1];
        if (wr == 1) PG8_BAR;
    }
    PG8_WAIT_V(0);
    PG8_BAR;
#undef PG8_SA
#undef PG8_SB
#undef PG8_STB
#undef PG8_STA
#undef PG8_LDA
#undef PG8_LDB
#undef PG8_MMA
#undef PG8_ITER
#undef PG8_SIDE_NEXT
#undef PG8_WAIT_V
#undef PG8_WAIT_L
#undef PG8_BAR
#undef PG8_SCHED
}

DEV void swap16(unsigned& a, unsigned& b) { const auto r = __builtin_amdgcn_permlane16_swap(a, b, false, false); a = r[0]; b = r[1]; }
DEV void swap32(unsigned& a, unsigned& b) { const auto r = __builtin_amdgcn_permlane32_swap(a, b, false, false); a = r[0]; b = r[1]; }
typedef _Float16 f16x2v __attribute__((ext_vector_type(2)));
DEV unsigned pkh(float a, float b) { f16x2v t; t.x = (f16)a; t.y = (f16)b; return __builtin_bit_cast(unsigned, t); }
DEV unsigned pkb(float a, float b) { typedef __bf16 bfx2 __attribute__((ext_vector_type(2))); typedef float fx2 __attribute__((ext_vector_type(2))); const fx2 v = {a, b}; return __builtin_bit_cast(unsigned, __builtin_convertvector(v, bfx2)); }
DEV void store_pair16b(f16* rowbase, const f32x4 v0, const f32x4 v1, int fq) {
    unsigned al = pkb(v0.x, v0.y), ah = pkb(v0.z, v0.w), bl = pkb(v1.x, v1.y), bh = pkb(v1.z, v1.w);
    swap16(al, bl); swap16(ah, bh);
    const int co = (fq & 1) ? 16 + 4 * (fq - 1) : 4 * fq;
    *(uint4*)(rowbase + co) = make_uint4(al, ah, bl, bh);
}
DEV void store_pair16(f16* rowbase, const f32x4 v0, const f32x4 v1, int fq) {
    unsigned al = pkh(v0.x, v0.y), ah = pkh(v0.z, v0.w), bl = pkh(v1.x, v1.y), bh = pkh(v1.z, v1.w);
    swap16(al, bl); swap16(ah, bh);
    const int co = (fq & 1) ? 16 + 4 * (fq - 1) : 4 * fq;
    *(uint4*)(rowbase + co) = make_uint4(al, ah, bl, bh);
}
struct EpiPlain {
    f16* O; int ldc;
    DEV void operator()(const f32x4 (&acc)[2][2][4][2], const GUnit& u, int wr, int wc, int fr, int fq, const LAS unsigned* side) const {
#pragma unroll
        for (int ai = 0; ai < 2; ++ai)
#pragma unroll
            for (int m = 0; m < 4; ++m) { f16* rowp = O + (size_t)(u.pm * BM + ai * HALF + wr * 64 + m * 16 + fr) * ldc + u.pn * BM + wc * 32;
#pragma unroll
                for (int bj = 0; bj < 2; ++bj) store_pair16(rowp + bj * HALF, acc[ai][bj][m][0], acc[ai][bj][m][1], fq); }
    }
};
struct EpiInProj {
    f16* O; const float* qg; const float* kg; const float* rope;
    DEV void operator()(f32x4 (&acc)[2][2][4][2], const GUnit& u, int wr, int wc, int fr, int fq, const LAS unsigned* side) const {
        const int pn = u.pn, seg = u.pm % 9; const bool latent = seg > 0;
        const bool isq = (pn < 2) || (pn == 6) || (pn == 7);
        const bool isk = (pn == 2) || (pn == 3) || (pn == 8 && wc < 2);
        const bool norm = (pn == 6) || (pn == 7) || (pn == 8 && wc < 2);
        const bool isv = (pn == 4) || (pn == 5) || (pn == 8 && wc >= 2);
        if (norm) {
            const float* g = isq ? qg : kg;
            f32x4 gv[2][2];
#pragma unroll
            for (int bj = 0; bj < 2; ++bj)
#pragma unroll
                for (int n = 0; n < 2; ++n) gv[bj][n] = *(const f32x4*)(g + 32 * bj + 16 * n + 4 * fq);
#pragma unroll
            for (int ai = 0; ai < 2; ++ai)
#pragma unroll
                for (int m = 0; m < 4; ++m) {
                    float ss = 0.f;
#pragma unroll
                    for (int bj = 0; bj < 2; ++bj)
#pragma unroll
                        for (int n = 0; n < 2; ++n) { const f32x4 v = acc[ai][bj][m][n]; ss += v.x * v.x + v.y * v.y + v.z * v.z + v.w * v.w; }
                    ss += __shfl_xor(ss, 16); ss += __shfl_xor(ss, 32);
                    const float rstd = rsqrtf(ss * (1.f / 64.f) + EPS);
#pragma unroll
                    for (int bj = 0; bj < 2; ++bj)
#pragma unroll
                        for (int n = 0; n < 2; ++n) acc[ai][bj][m][n] = acc[ai][bj][m][n] * rstd * gv[bj][n];
                }
        }
        if ((isq || isk) && latent) {
            const int s0 = (seg - 1) * 256;
#pragma unroll
            for (int ai = 0; ai < 2; ++ai) {
                const int prow = (s0 + ai * HALF + wr * 64) >> 6;
                const f32x4 r0 = *(const f32x4*)(rope + (prow * 16 + 4 * fq) * 2), r1 = *(const f32x4*)(rope + (prow * 16 + 4 * fq) * 2 + 4);
                const float rc[4] = {r0.x, r0.z, r1.x, r1.z}, rs[4] = {r0.y, r0.w, r1.y, r1.w};
#pragma unroll
                for (int m = 0; m < 4; ++m) {
                    const int pcol = m * 16 + fr;
                    const f32x4 c0 = *(const f32x4*)(rope + (pcol * 16 + 4 * fq) * 2), c1 = *(const f32x4*)(rope + (pcol * 16 + 4 * fq) * 2 + 4);
                    const float cc[4] = {c0.x, c0.z, c1.x, c1.z}, cs[4] = {c0.y, c0.w, c1.y, c1.w};
#pragma unroll
                    for (int q = 0; q < 4; ++q) {
                        const float a = acc[ai][0][m][0][q], b = acc[ai][0][m][1][q]; acc[ai][0][m][0][q] = a * rc[q] - b * rs[q]; acc[ai][0][m][1][q] = a * rs[q] + b * rc[q];
                        const float a2 = acc[ai][1][m][0][q], b2 = acc[ai][1][m][1][q]; acc[ai][1][m][0][q] = a2 * cc[q] - b2 * cs[q]; acc[ai][1][m][1][q] = a2 * cs[q] + b2 * cc[q];
                    }
                }
            }
        }
        const float sc = isq ? QSCALE : 1.f;
#pragma unroll
        for (int ai = 0; ai < 2; ++ai)
#pragma unroll
            for (int m = 0; m < 4; ++m) { f16* rowp = O + (size_t)(u.pm * BM + ai * HALF + wr * 64 + m * 16 + fr) * NIN + pn * BM + wc * 64;
#pragma unroll
                for (int bj = 0; bj < 2; ++bj) { if (isv) store_pair16b(rowp + bj * 32, acc[ai][bj][m][0], acc[ai][bj][m][1], fq); else store_pair16(rowp + bj * 32, acc[ai][bj][m][0] * sc, acc[ai][bj][m][1] * sc, fq); } }
    }
};
struct EpiGU {
    unsigned char* H; const float* wsl;
    DEV void operator()(const f32x4 (&acc)[2][2][4][2], const GUnit& u, int wr, int wc, int fr, int fq, const LAS unsigned* side) const {
#pragma unroll
        for (int ai = 0; ai < 2; ++ai)
#pragma unroll
            for (int m = 0; m < 4; ++m) { const int rl = ai * HALF + wr * 64 + m * 16 + fr, row = u.pm * BM + rl; const float w = __builtin_bit_cast(float, side[rl]) * 4.0f; unsigned char* rowp = H + (size_t)row * EH + u.pn * 128 + wc * 32;
                unsigned d[2];
#pragma unroll
                for (int n = 0; n < 2; ++n) { const f32x4 g = acc[ai][0][m][n], up = acc[ai][1][m][n];
                    int q = __builtin_amdgcn_cvt_pk_fp8_f32(c8(silu_f(g.x) * up.x * w), c8(silu_f(g.y) * up.y * w), 0, false); q = __builtin_amdgcn_cvt_pk_fp8_f32(c8(silu_f(g.z) * up.z * w), c8(silu_f(g.w) * up.w * w), q, true); d[n] = (unsigned)q; }
                swap16(d[0], d[1]);
                const int co = (fq & 1) ? 16 + 4 * (fq - 1) : 4 * fq;
                *(uint2*)(rowp + co) = make_uint2(d[0], d[1]); }
    }
};
struct EpiDown {
    unsigned char* Y; const int* pair;
    DEV void operator()(const f32x4 (&acc)[2][2][4][2], const GUnit& u, int wr, int wc, int fr, int fq, const LAS unsigned* side) const {
#pragma unroll
        for (int ai = 0; ai < 2; ++ai)
#pragma unroll
            for (int m = 0; m < 4; ++m) { const int pr = (int)side[ai * HALF + wr * 64 + m * 16 + fr];
                unsigned d[4];
#pragma unroll
                for (int bj = 0; bj < 2; ++bj)
#pragma unroll
                    for (int n = 0; n < 2; ++n) { const f32x4 v = acc[ai][bj][m][n]; int w = __builtin_amdgcn_cvt_pk_fp8_f32(c8(v.x), c8(v.y), 0, false); w = __builtin_amdgcn_cvt_pk_fp8_f32(c8(v.z), c8(v.w), w, true); d[bj * 2 + n] = (unsigned)w; }
                swap32(d[0], d[2]); swap32(d[1], d[3]); swap16(d[0], d[1]); swap16(d[2], d[3]);
                if (pr >= 0) *(uint4*)(Y + (size_t)pr * DM + u.pn * BM + wc * 64 + 16 * fq) = make_uint4(d[0], d[1], d[2], d[3]); }
    }
};
struct SchedInProj {
    const char* A; const char* B; int v, G;
    static constexpr bool HAS_E = false;
    DEV bool next(int i, GUnit& u) const {
        const int L = i * G + v; if (L >= 2304 + 160) return false;
        if (L < 2304) { const int pl = L / 9; u.pn = L % 9; u.pm = (pl >> 3) * 9 + 1 + (pl & 7); }
        else { const int Lc = L - 2304, q = Lc % 5; u.pm = (Lc / 5) * 9; u.pn = q < 4 ? 2 + q : 8; }
        u.A = A + (size_t)u.pm * 256 * DM * 2; u.B = B + (size_t)u.pn * 256 * DM * 2; u.aux = 0; return true;
    }
    DEV const int* eptr(const GUnit&) const { return nullptr; }
    DEV const char* bptr(const GUnit& u, int) const { return u.B; }
};
struct SchedDense {
    const char* A; const char* B; int v, G, nunits, ntn, K;
    static constexpr bool HAS_E = false;
    DEV bool next(int i, GUnit& u) const {
        const int L = i * G + v; if (L >= nunits) return false;
        u.pm = L / ntn; u.pn = L % ntn; u.A = A + (size_t)u.pm * 256 * K * 2; u.B = B + (size_t)u.pn * 256 * K * 2; u.aux = 0; return true;
    }
    DEV const int* eptr(const GUnit&) const { return nullptr; }
    DEV const char* bptr(const GUnit& u, int) const { return u.B; }
};
struct SchedGrouped {
    const char* A; const char* B; const int* blke; int v, G, nunits, ntn, K; size_t estride; int seq;
    static constexpr bool HAS_E = true;
    DEV bool next(int i, GUnit& u) const {
        if (seq) {
            const int nb = nunits / ntn, rf = nb / G, nf = rf * ntn;
            if (i < nf) { u.pm = (i / ntn) * G + v; u.pn = i % ntn; }
            else { const int L = (i - nf) * G + v; if (L >= (nb - rf * G) * ntn) return false; u.pm = rf * G + L / ntn; u.pn = L % ntn; }
        } else { const int L = i * G + v; if (L >= nunits) return false; u.pm = L / ntn; u.pn = L % ntn; }
        u.aux = 0; u.A = A + (size_t)u.pm * 256 * K * 2; u.B = nullptr; return true;
    }
    DEV const int* eptr(const GUnit& u) const { return blke + u.pm; }
    DEV const char* bptr(const GUnit& u, int e) const { return B + (size_t)e * estride + (size_t)u.pn * 256 * K * 2; }
};
}

namespace attn_body {
using bf16=_Float16;
using bf16x8=__attribute__((ext_vector_type(8)))short;
using s16x4=__attribute__((ext_vector_type(4)))short;
using f32x16=__attribute__((ext_vector_type(16)))float;
using u32x4=__attribute__((ext_vector_type(4)))unsigned;
using h16x8=__attribute__((ext_vector_type(8)))_Float16;
__device__ __forceinline__ f32x16 mf16(bf16x8 a,bf16x8 b,f32x16 c,int,int,int){return __builtin_amdgcn_mfma_f32_32x32x16_f16(__builtin_bit_cast(h16x8,a),__builtin_bit_cast(h16x8,b),c,0,0,0);}
constexpr int D=64,DM=2304;
constexpr int NW=8,QBLK=32,QB=QBLK*NW,KVBLK=64;
__device__ __forceinline__ int crow(int r,int hi){return (r&3)+8*(r>>2)+4*hi;}
#define SBAR() __builtin_amdgcn_sched_barrier(0)
__device__ __forceinline__ void cmask(f32x16&p0,f32x16&p1,int jb,int qrel,int hi){
  const float NEG=-INFINITY; int kb=64*jb+4*hi;
  #pragma unroll
  for(int r=0;r<16;++r){int kv=kb+(r&3)+8*(r>>2); if(kv>qrel)p0[r]=NEG; if(kv+32>qrel)p1[r]=NEG;}
}

constexpr int NSLOT=3, SLOTB=8192;
constexpr int LDS_K=0, LDS_V=NSLOT*SLOTB, LDS_WS=2*NSLOT*SLOTB, LDS_OST=LDS_WS+NW*64*4, LDS_BYTES=LDS_OST+NW*4096;
constexpr float C2=0.125f*1.4426950408889634f;
__device__ __forceinline__ void glds16(const void*gsrc,unsigned lds_dst){unsigned keep;
  asm volatile("s_mov_b32 %0, m0\n\ts_mov_b32 m0, %2\n\ts_nop 0\n\tglobal_load_lds_dwordx4 %1, off\n\ts_mov_b32 m0, %0":"=&s"(keep):"v"(gsrc),"s"(lds_dst):"memory");}
__device__ __forceinline__ float max3f(float a,float b,float c){float r;asm("v_max3_f32 %0, %1, %2, %3":"=v"(r):"v"(a),"v"(b),"v"(c));return r;}
__device__ __forceinline__ float max2f(float a,float b){float r;asm("v_max_f32_e32 %0, %1, %2":"=v"(r):"v"(a),"v"(b));return r;}
__device__ __forceinline__ float fadd_s(float a,float b){float r;asm("v_add_f32_e32 %0, %1, %2":"=v"(r):"v"(a),"v"(b));return r;}
__device__ __forceinline__ float fsub_s(float a,float b){float r;asm("v_sub_f32_e32 %0, %1, %2":"=v"(r):"v"(a),"v"(b));return r;}
typedef float f32x2_t __attribute__((ext_vector_type(2))); typedef _Float16 bf16x2_t __attribute__((ext_vector_type(2)));
__device__ __forceinline__ unsigned cvtpk_s(float lo,float hi){f32x2_t v={lo,hi};bf16x2_t b=__builtin_convertvector(v,bf16x2_t);return __builtin_bit_cast(unsigned,b);}
typedef __bf16 rbf16x2_t __attribute__((ext_vector_type(2))); typedef __bf16 rbf16x8_t __attribute__((ext_vector_type(8)));
__device__ __forceinline__ unsigned cvtpk_b(float lo,float hi){f32x2_t v={lo,hi};rbf16x2_t b=__builtin_convertvector(v,rbf16x2_t);return __builtin_bit_cast(unsigned,b);}
__device__ __forceinline__ f32x16 mfb16(bf16x8 a,bf16x8 b,f32x16 c,int,int,int){return __builtin_amdgcn_mfma_f32_32x32x16_bf16(__builtin_bit_cast(rbf16x8_t,a),__builtin_bit_cast(rbf16x8_t,b),c,0,0,0);}
#define WAIT_BAR(N) asm volatile("s_waitcnt vmcnt(" #N ") lgkmcnt(0)\n\ts_barrier":::"memory")

__device__ __forceinline__ void qkt(f32x16&p0,f32x16&p1,const char*Kslot,const bf16x8*qr,const f32x16&negm,int r32,int hi){
  const char*kb=Kslot+hi*1024+r32*16;
  #pragma unroll
  for(int d0=0;d0<4;++d0){
    const bf16x8 b0=*reinterpret_cast<const bf16x8*>(kb+d0*2048);
    const bf16x8 b1=*reinterpret_cast<const bf16x8*>(kb+d0*2048+512);
    if(d0==0){p0=mf16(b0,qr[0],negm,0,0,0);p1=mf16(b1,qr[0],negm,0,0,0);}
    else{p0=mf16(b0,qr[d0],p0,0,0,0);p1=mf16(b1,qr[d0],p1,0,0,0);}}
}
typedef __attribute__((address_space(3))) const char* lds_cptr;
typedef short v4i16_t __attribute__((ext_vector_type(4)));
__device__ __forceinline__ void kload8(bf16x8*kf,lds_cptr kp){
  kf[0]=*(const __attribute__((address_space(3))) bf16x8*)(kp);      kf[1]=*(const __attribute__((address_space(3))) bf16x8*)(kp+512);
  kf[2]=*(const __attribute__((address_space(3))) bf16x8*)(kp+2048); kf[3]=*(const __attribute__((address_space(3))) bf16x8*)(kp+2560);
  kf[4]=*(const __attribute__((address_space(3))) bf16x8*)(kp+4096); kf[5]=*(const __attribute__((address_space(3))) bf16x8*)(kp+4608);
  kf[6]=*(const __attribute__((address_space(3))) bf16x8*)(kp+6144); kf[7]=*(const __attribute__((address_space(3))) bf16x8*)(kp+6656);
}
__device__ __forceinline__ void kload2(bf16x8*kf,lds_cptr kp,int j){ kf[2*j]=*(const __attribute__((address_space(3))) bf16x8*)(kp+j*2048); kf[2*j+1]=*(const __attribute__((address_space(3))) bf16x8*)(kp+j*2048+512); }
__device__ __forceinline__ s16x4 vtr(lds_cptr p){ return __builtin_bit_cast(s16x4,__builtin_amdgcn_ds_read_tr16_b64_v4i16((__attribute__((address_space(3))) v4i16_t*)p)); }
__device__ __forceinline__ float rowmax(const f32x16&p0,const f32x16&p1){
  float a=max3f(p0[0],p0[1],p1[0]),b=max3f(p0[2],p0[3],p1[1]);a=max3f(a,p1[2],p1[3]);
  #pragma unroll
  for(int r=4;r<16;r+=4){a=max3f(a,p0[r],p0[r+1]);b=max3f(b,p0[r+2],p0[r+3]);a=max3f(a,p1[r],p1[r+1]);b=max3f(b,p1[r+2],p1[r+3]);}
  const float m=max2f(a,b);
  auto rr=__builtin_amdgcn_permlane32_swap(__float_as_uint(m),__float_as_uint(m),false,false);
  return max2f(__uint_as_float(rr[0]),__uint_as_float(rr[1]));
}
__device__ __forceinline__ void pv(f32x16*o,int vb,bf16x8 pa0,bf16x8 pa1,bf16x8 pa2,bf16x8 pa3){
  #pragma unroll
  for(int d0=0;d0<2;++d0){s16x4 lo[4],hi[4];
    #pragma unroll
    for(int ks=0;ks<4;++ks){
      asm volatile("ds_read_b64_tr_b16 %0,%1 offset:%c2":"=&v"(lo[ks]):"v"(vb),"i"(d0*4096+ks*1024):"memory");
      asm volatile("ds_read_b64_tr_b16 %0,%1 offset:%c2":"=&v"(hi[ks]):"v"(vb),"i"(d0*4096+ks*1024+512):"memory");}
    asm volatile("s_waitcnt lgkmcnt(0)":::"memory");SBAR();
    #define PK(k) (bf16x8){lo[k][0],lo[k][1],lo[k][2],lo[k][3],hi[k][0],hi[k][1],hi[k][2],hi[k][3]}
    o[d0]=mfb16(pa0,PK(0),o[d0],0,0,0);
    o[d0]=mfb16(pa1,PK(1),o[d0],0,0,0);
    o[d0]=mfb16(pa2,PK(2),o[d0],0,0,0);
    o[d0]=mfb16(pa3,PK(3),o[d0],0,0,0);
    #undef PK
  }
}

#ifndef ATTN_STORE16
#define ATTN_STORE16(p,v) (*(u32x4*)(p)=(v))
#endif
template<int THRL> __device__ __forceinline__ void attn_unit(const bf16*Qu,const bf16*__restrict__ Kh,const bf16*__restrict__ Vh,bf16*Ou,int opitch,char*shm){
  const int tid=threadIdx.x,lane=tid&63,r32=lane&31,hi=lane>>5; const int wid=__builtin_amdgcn_readfirstlane(tid>>6);
  const bf16*Qw=Qu+(long)(wid*QBLK)*DM;
  const unsigned lds0=(unsigned)(uintptr_t)shm;
  float*wsf=(float*)(shm+LDS_WS)+wid*64;
  const bf16*ksrc=Kh+(long)lane*DM+wid*8;
  const bf16*vsrc=Vh+(long)(16*(wid&3)+(lane>>2))*DM+(wid>>2)*32+(lane&3)*8;
  const unsigned kdst=lds0+LDS_K+wid*1024, vdst=lds0+LDS_V+wid*1024;
  #define DMA_K(t,slot) glds16(ksrc+(long)(t)*KVBLK*DM,(unsigned)__builtin_amdgcn_readfirstlane(kdst+(slot)))
  #define DMA_V(t,slot) glds16(vsrc+(long)(t)*KVBLK*DM,(unsigned)__builtin_amdgcn_readfirstlane(vdst+(slot)))
  const int vb0=(int)(lds0+LDS_V)+((lane>>4)&1)*32+(lane&3)*8+(4*hi+((lane&15)>>2))*64;
  const char*Kbase=shm+LDS_K; bf16x8 kf[8];
  const lds_cptr shm3=(lds_cptr)shm; const lds_cptr kp0=shm3+LDS_K+hi*1024+r32*16; const lds_cptr vp0=shm3+LDS_V+((lane>>4)&1)*32+(lane&3)*8+(4*hi+((lane&15)>>2))*64;
  constexpr int NT=36;
  DMA_K(0,0);DMA_V(0,0);DMA_K(1,SLOTB);
  bf16x8 qr[4];
  #pragma unroll
  for(int d0=0;d0<4;++d0)qr[d0]=*reinterpret_cast<const bf16x8*>(&Qw[(long)r32*DM+d0*16+hi*8]);
  float l_reg=0.f;f32x16 o[2];o[0]=f32x16{};o[1]=f32x16{};
  #define CMASK(P0,P1,t) do{}while(0)
  #define START(P0,P1) do{ _Pragma("unroll") for(int r=0;r<16;++r)P0[r]=__builtin_amdgcn_exp2f(P0[r]); }while(0)
  #define RESC() do{}while(0)
  f32x16 pA0,pA1,pB0,pB1;
  int sl_prev=0,sl_cur=0,sl_next=SLOTB;
  #define ROT() do{sl_prev=sl_cur;sl_cur=sl_next;sl_next=(sl_next==(NSLOT-1)*SLOTB)?0:sl_next+SLOTB;}while(0)
  DMA_K(2,2*SLOTB);
  WAIT_BAR(3);
  qkt(pA0,pA1,Kbase,qr,f32x16{},r32,hi);asm volatile("s_nop 15\n\ts_nop 7":"+v"(pA0),"+v"(pA1));CMASK(pA0,pA1,0);
  START(pA0,pA1);
  _Pragma("unroll") for(int r=0;r<16;++r)pA1[r]=__builtin_amdgcn_exp2f(pA1[r]);
  WAIT_BAR(0);
  DMA_K(3,0);DMA_V(1,SLOTB);
  ROT();
  kload8(kf,kp0+sl_cur);
  WAIT_BAR(2);
  s16x4 vlo[8],vhi[8]; u32x4 pw0,pw1,pw2,pw3;
  #define PKW(P,B) cvtpk_b(P[B],P[B+1])
  #define PAF(k) __builtin_bit_cast(bf16x8,pw##k)
  #define VFR(i) (bf16x8){vlo[i][0],vlo[i][1],vlo[i][2],vlo[i][3],vhi[i][0],vhi[i][1],vhi[i][2],vhi[i][3]}
  #define PIN(x) asm volatile("":"+v"(x))
  #define MX3(a,b,c) __builtin_fmaxf(__builtin_fmaxf((a),(b)),(c))
  #define GAPA(MF,A0,A1,A2,A3,W0,W1,PW) do{ MF; sacc+=A0; sacc+=A1; sacc+=A2; sacc+=A3; PIN(sacc); W0; W1; PIN(PW); SBAR(); }while(0)
  #define EX(v) __builtin_amdgcn_exp2f(v)
  #define GAPB(MF,X,B) do{ MF; X[B]=EX(X[B]); X[B+1]=EX(X[B+1]); X[B+2]=EX(X[B+2]); X[B+3]=EX(X[B+3]); PIN(X); SBAR(); }while(0)
  #define VRD(i) do{ vlo[i]=vtr(vp_+(((i)>>2)*4096+((i)&3)*1024)); vhi[i]=vtr(vp_+(((i)>>2)*4096+((i)&3)*1024+512)); }while(0)
  #define KRD(G,j) do{ if(G){ kload2(kf,kp0+sl_next,j); SBAR(); } }while(0)
  #define STEP(C0,C1,P0,P1,t,GK,GV,GL) do{ SBAR(); \
    const lds_cptr vp_=vp0+sl_prev; \
    VRD(0); SBAR(); float sacc=(P0[0]+P0[1]); \
    GAPA(C0=mf16(kf[0],qr[0],f32x16{},0,0,0), P0[2],P0[3],P0[4],P0[5],     pw0[0]=PKW(P0,0), pw0[1]=PKW(P0,2), pw0); \
    VRD(4); SBAR(); GAPA(C1=mf16(kf[1],qr[0],f32x16{},0,0,0), P0[6],P0[7],P0[8],P0[9],     pw0[2]=PKW(P0,4), pw0[3]=PKW(P0,6), pw0); \
    VRD(1); SBAR(); GAPA(C0=mf16(kf[2],qr[1],C0,0,0,0),   P0[10],P0[11],P0[12],P0[13], pw1[0]=PKW(P0,8), pw1[1]=PKW(P0,10), pw1); \
    VRD(5); SBAR(); GAPA(C1=mf16(kf[3],qr[1],C1,0,0,0),   P0[14],P0[15],P1[0],P1[1],   pw1[2]=PKW(P0,12),pw1[3]=PKW(P0,14), pw1); \
    VRD(2); SBAR(); GAPA(C0=mf16(kf[4],qr[2],C0,0,0,0),   P1[2],P1[3],P1[4],P1[5],     pw2[0]=PKW(P1,0), pw2[1]=PKW(P1,2), pw2); \
    VRD(6); SBAR(); GAPA(C1=mf16(kf[5],qr[2],C1,0,0,0),   P1[6],P1[7],P1[8],P1[9],     pw2[2]=PKW(P1,4), pw2[3]=PKW(P1,6), pw2); \
    VRD(3); SBAR(); GAPA(C0=mf16(kf[6],qr[3],C0,0,0,0),   P1[10],P1[11],P1[12],P1[13], pw3[0]=PKW(P1,8), pw3[1]=PKW(P1,10), pw3); \
    VRD(7); SBAR(); GAPA(C1=mf16(kf[7],qr[3],C1,0,0,0),   P1[14],P1[15],0.f,0.f,       pw3[2]=PKW(P1,12),pw3[3]=PKW(P1,14), pw3); \
    l_reg+=sacc; \
    if(GK){DMA_K((t)+3,sl_cur);} if(GV){DMA_V((t)+1,sl_next);} \
    SBAR(); \
    GAPB(o[0]=mfb16(PAF(0),VFR(0),o[0],0,0,0), C0,0); \
    GAPB(o[1]=mfb16(PAF(0),VFR(4),o[1],0,0,0), C0,4); \
    KRD(GL,0); GAPB(o[0]=mfb16(PAF(1),VFR(1),o[0],0,0,0), C0,8); \
    KRD(GL,1); GAPB(o[1]=mfb16(PAF(1),VFR(5),o[1],0,0,0), C0,12); \
    KRD(GL,2); GAPB(o[0]=mfb16(PAF(2),VFR(2),o[0],0,0,0), C1,0); \
    KRD(GL,3); GAPB(o[1]=mfb16(PAF(2),VFR(6),o[1],0,0,0), C1,4); \
    GAPB(o[0]=mfb16(PAF(3),VFR(3),o[0],0,0,0), C1,8); \
    GAPB(o[1]=mfb16(PAF(3),VFR(7),o[1],0,0,0), C1,12); \
    }while(0)
  int t=1;
  #undef CMASK
  #define CMASK(P0,P1,t) do{}while(0)
  for(;t+5<NT;t+=2){
    STEP(pB0,pB1,pA0,pA1,t,true,true,true);     WAIT_BAR(2); RESC(); ROT();
    STEP(pA0,pA1,pB0,pB1,t+1,true,true,true);   WAIT_BAR(2); RESC(); ROT();
  }
  #undef CMASK
  #define CMASK(P0,P1,t) do{}while(0)
  #define ENDW(tt) do{ if((tt)+3<NT){WAIT_BAR(2);} else if((tt)+2<NT){WAIT_BAR(1);} else {WAIT_BAR(0);} }while(0)
  for(;t+1<NT;t+=2){
    STEP(pB0,pB1,pA0,pA1,t,(t+3<NT),(t+1<NT),(t+1<NT));       ENDW(t);   RESC(); ROT();
    STEP(pA0,pA1,pB0,pB1,t+1,(t+4<NT),(t+2<NT),(t+2<NT));     ENDW(t+1); RESC(); ROT();
  }
  STEP(pB0,pB1,pA0,pA1,NT-1,false,false,false); RESC();
  { float sacc=pB0[0]+pB0[1]; _Pragma("unroll") for(int r=2;r<16;++r)sacc+=pB0[r]; _Pragma("unroll") for(int r=0;r<16;++r)sacc+=pB1[r]; l_reg+=sacc;
    pw0=(u32x4){PKW(pB0,0),PKW(pB0,2),PKW(pB0,4),PKW(pB0,6)};pw1=(u32x4){PKW(pB0,8),PKW(pB0,10),PKW(pB0,12),PKW(pB0,14)};pw2=(u32x4){PKW(pB1,0),PKW(pB1,2),PKW(pB1,4),PKW(pB1,6)};pw3=(u32x4){PKW(pB1,8),PKW(pB1,10),PKW(pB1,12),PKW(pB1,14)};
    SBAR(); pv(o,vb0+sl_cur,PAF(0),PAF(1),PAF(2),PAF(3)); }
  #undef PKW
  #undef PAF
  #undef VFR
  #undef PIN
  #undef MX3
  #undef GAPA
  #undef GAPB
  #undef EX
  #undef VRD
  #undef KRD
  #undef STEP
  #undef ENDW
  {auto rr=__builtin_amdgcn_permlane32_swap(__float_as_uint(l_reg),__float_as_uint(l_reg),false,false);l_reg=__uint_as_float(rr[0])+__uint_as_float(rr[1]);}
  if(hi==0)wsf[32+r32]=l_reg;asm volatile("s_waitcnt lgkmcnt(0)":::"memory");
  float rli[16];
  #pragma unroll
  for(int r=0;r<16;++r)rli[r]=__builtin_amdgcn_rcpf(wsf[32+crow(r,hi)]);
  bf16*Ow=Ou+(long)(wid*QBLK)*opitch;
  { bf16*stg=(bf16*)(shm+LDS_OST)+wid*2048;
    #pragma unroll
    for(int r=0;r<16;++r){const int orow=crow(r,hi);
      #pragma unroll
      for(int d0=0;d0<2;++d0)stg[orow*64+d0*32+r32]=(bf16)(o[d0][r]*rli[r]);}
    asm volatile("s_waitcnt lgkmcnt(0)":::"memory");
    #pragma unroll
    for(int i=0;i<4;++i){const int row=i*8+(lane>>3),ch=lane&7; const u32x4 v=*(const u32x4*)(stg+row*64+ch*8); ATTN_STORE16(Ow+(long)row*opitch+ch*8,v);} }
  asm volatile("s_waitcnt lgkmcnt(0)\n\ts_barrier":::"memory");
  #undef DMA_K
  #undef DMA_V
  #undef CMASK
  #undef START
  #undef RESC
  #undef ROT
}

constexpr int U_SLOTK=8192,U_LDS_K=0,U_LDS_V=3*U_SLOTK,U_LDS_WS=U_LDS_V+3*16384,U_LDS_OST=U_LDS_WS+2048,U_LDS_Q=U_LDS_OST+NW*4096,U_LDS_BYTES=U_LDS_Q+NW*4096;
template<int THRL> __device__ __forceinline__ void attn_unit128(const bf16*Qu,const bf16*__restrict__ Kh,const bf16*__restrict__ Vh,bf16*Ou,int opitch,char*shm){
  const int tid=threadIdx.x,lane=tid&63,r32=lane&31,hi=lane>>5; const int wid=__builtin_amdgcn_readfirstlane(tid>>6);
  const bf16*Qw=Qu+(long)(wid*QBLK)*DM;
  const unsigned lds0=(unsigned)(uintptr_t)shm;
  float*wsf=(float*)(shm+U_LDS_WS)+wid*64;
  const bf16*ksrc=Kh+(long)lane*DM+wid*8;
  const bf16*vsrc=Vh+(long)(16*(wid&3)+(lane>>2))*DM+(wid>>2)*32+(lane&3)*8;
  const unsigned kdst=lds0+U_LDS_K+wid*1024, vdst=lds0+U_LDS_V+wid*1024;
  #define DMA_K(t,slot) glds16(ksrc+(long)(t)*KVBLK*DM,(unsigned)__builtin_amdgcn_readfirstlane(kdst+(slot)))
  #define DMA_V(t,slot) do{ glds16(vsrc+(long)(t)*KVBLK*DM,(unsigned)__builtin_amdgcn_readfirstlane(vdst+2*(slot))); glds16(vsrc+(long)(t)*KVBLK*DM+64,(unsigned)__builtin_amdgcn_readfirstlane(vdst+2*(slot)+8192)); }while(0)
  const int vb0=(int)(lds0+U_LDS_V)+((lane>>4)&1)*32+(lane&3)*8+(4*hi+((lane&15)>>2))*64;
  bf16x8 kf[8];
  const lds_cptr shm3=(lds_cptr)shm; const lds_cptr kp0=shm3+U_LDS_K+hi*1024+r32*16; const lds_cptr vp0=shm3+U_LDS_V+((lane>>4)&1)*32+(lane&3)*8+(4*hi+((lane&15)>>2))*64;
  constexpr int NT=36;
  DMA_K(0,0);DMA_V(0,0);DMA_K(1,U_SLOTK);
  const lds_cptr qp0=shm3+U_LDS_Q+tid*16;
  { bf16x8 qr[4];
    #pragma unroll
    for(int d0=0;d0<4;++d0)qr[d0]=*reinterpret_cast<const bf16x8*>(&Qw[(long)r32*DM+d0*16+hi*8]);
    #pragma unroll
    for(int d0=0;d0<4;++d0)*(__attribute__((address_space(3))) bf16x8*)(qp0+d0*8192)=qr[d0]; }
  #define QF(d0) (*(const __attribute__((address_space(3))) bf16x8*)(qp0+(d0)*8192))
  float l_reg=0.f;f32x16 o[4];o[0]=f32x16{};o[1]=f32x16{};o[2]=f32x16{};o[3]=f32x16{};
  #define RESC() do{}while(0)
  f32x16 pA0,pA1,pB0,pB1;
  int sl_prev=0,sl_cur=0,sl_next=U_SLOTK;
  #define ROT() do{sl_prev=sl_cur;sl_cur=sl_next;sl_next=(sl_next==2*U_SLOTK)?0:sl_next+U_SLOTK;}while(0)
  DMA_K(2,2*U_SLOTK);
  WAIT_BAR(4);
  { kload8(kf,kp0);
    { const bf16x8 q0=QF(0),q1=QF(1),q2=QF(2),q3=QF(3);
    pA0=mf16(kf[0],q0,f32x16{},0,0,0);pA1=mf16(kf[1],q0,f32x16{},0,0,0);pA0=mf16(kf[2],q1,pA0,0,0,0);pA1=mf16(kf[3],q1,pA1,0,0,0);
    pA0=mf16(kf[4],q2,pA0,0,0,0);pA1=mf16(kf[5],q2,pA1,0,0,0);pA0=mf16(kf[6],q3,pA0,0,0,0);pA1=mf16(kf[7],q3,pA1,0,0,0); }
    asm volatile("s_nop 15\n\ts_nop 7":"+v"(pA0),"+v"(pA1));
    _Pragma("unroll") for(int r=0;r<16;++r){pA0[r]=__builtin_amdgcn_exp2f(pA0[r]);pA1[r]=__builtin_amdgcn_exp2f(pA1[r]);} }
  WAIT_BAR(0);
  DMA_K(3,0);DMA_V(1,U_SLOTK);
  ROT();
  kload8(kf,kp0+sl_cur);
  WAIT_BAR(3);
  s16x4 vrl[4],vrh[4]; u32x4 pw0,pw1,pw2,pw3;
  #define PKW(P,B) cvtpk_b(P[B],P[B+1])
  #define PAF(k) __builtin_bit_cast(bf16x8,pw##k)
  #define FID(g) ((((g)&3)<<2)+((g)>>2))
  #define VF(g) (bf16x8){vrl[(g)&3][0],vrl[(g)&3][1],vrl[(g)&3][2],vrl[(g)&3][3],vrh[(g)&3][0],vrh[(g)&3][1],vrh[(g)&3][2],vrh[(g)&3][3]}
  #define VRDR(g) do{ vrl[(g)&3]=vtr(vp_+((FID(g)>>2)*4096+(FID(g)&3)*1024)); vrh[(g)&3]=vtr(vp_+((FID(g)>>2)*4096+(FID(g)&3)*1024+512)); }while(0)
  #define PIN(x) asm volatile("":"+v"(x))
  #define MX3(a,b,c) __builtin_fmaxf(__builtin_fmaxf((a),(b)),(c))
  #define EX(v) __builtin_amdgcn_exp2f(v)
  { float s0=pA0[0]+pA0[1]; _Pragma("unroll") for(int r=2;r<16;++r)s0+=pA0[r]; _Pragma("unroll") for(int r=0;r<16;++r)s0+=pA1[r]; l_reg+=s0;
    pw0=(u32x4){PKW(pA0,0),PKW(pA0,2),PKW(pA0,4),PKW(pA0,6)};pw1=(u32x4){PKW(pA0,8),PKW(pA0,10),PKW(pA0,12),PKW(pA0,14)};pw2=(u32x4){PKW(pA1,0),PKW(pA1,2),PKW(pA1,4),PKW(pA1,6)}; pw3=(u32x4){0u,0u,0u,0u}; }
  #define GAPA(MF,W) do{ MF; W; SBAR(); }while(0)
  #define GAPB(g,KS,X,B,PKSTMT) do{ o[(g)&3]=mfb16(PAF(KS),VF(g),o[(g)&3],0,0,0); if((g)+4<16){VRDR((g)+4);} X[B]=EX(X[B]); X[B+1]=EX(X[B+1]); sacc+=X[B]; sacc+=X[B+1]; PIN(sacc); PKSTMT; PIN(X); SBAR(); }while(0)
  #define KRD(G,j) do{ if(G){ kload2(kf,kp0+sl_next,j); SBAR(); } }while(0)
  #define STEP(C0,C1,P0,P1,t,GK,GV,GL) do{ SBAR(); \
    const lds_cptr vp_=vp0+2*sl_prev; \
    bf16x8 qa=QF(0),qb=QF(1); SBAR(); \
    GAPA(C0=mf16(kf[0],qa,f32x16{},0,0,0), pw3[0]=PKW(P1,8)); \
    GAPA(C1=mf16(kf[1],qa,f32x16{},0,0,0), pw3[1]=PKW(P1,10)); \
    qa=QF(2); SBAR(); \
    GAPA(C0=mf16(kf[2],qb,C0,0,0,0),       pw3[2]=PKW(P1,12)); \
    GAPA(C1=mf16(kf[3],qb,C1,0,0,0),       pw3[3]=PKW(P1,14); PIN(pw3)); \
    qb=QF(3); SBAR(); \
    VRDR(0); SBAR(); GAPA(C0=mf16(kf[4],qa,C0,0,0,0), (void)0); \
    VRDR(1); SBAR(); GAPA(C1=mf16(kf[5],qa,C1,0,0,0), (void)0); \
    VRDR(2); SBAR(); GAPA(C0=mf16(kf[6],qb,C0,0,0,0), (void)0); \
    VRDR(3); SBAR(); GAPA(C1=mf16(kf[7],qb,C1,0,0,0), (void)0); \
    if(GK){DMA_K((t)+3,sl_cur);} if(GV){DMA_V((t)+1,sl_next);} \
    float sacc=0.f; \
    SBAR(); \
    GAPB(0,0,C0,0,(void)0);  GAPB(1,0,C0,2,(void)0);  GAPB(2,0,C0,4,(void)0);  GAPB(3,0,C0,6,(void)0); \
    KRD(GL,0); GAPB(4,1,C0,8,pw0[0]=PKW(C0,0));  KRD(GL,1); GAPB(5,1,C0,10,pw0[1]=PKW(C0,2)); KRD(GL,2); GAPB(6,1,C0,12,pw0[2]=PKW(C0,4)); KRD(GL,3); GAPB(7,1,C0,14,pw0[3]=PKW(C0,6); PIN(pw0)); \
    GAPB(8,2,C1,0,pw1[0]=PKW(C0,8));  GAPB(9,2,C1,2,pw1[1]=PKW(C0,10)); GAPB(10,2,C1,4,pw1[2]=PKW(C0,12)); GAPB(11,2,C1,6,pw1[3]=PKW(C0,14); PIN(pw1)); \
    GAPB(12,3,C1,8,pw2[0]=PKW(C1,0)); GAPB(13,3,C1,10,pw2[1]=PKW(C1,2));GAPB(14,3,C1,12,pw2[2]=PKW(C1,4));GAPB(15,3,C1,14,pw2[3]=PKW(C1,6); PIN(pw2)); \
    l_reg+=sacc; \
    }while(0)
  int t=1;
  for(;t+5<NT;t+=2){
    STEP(pB0,pB1,pA0,pA1,t,true,true,true);     WAIT_BAR(3); RESC(); ROT();
    STEP(pA0,pA1,pB0,pB1,t+1,true,true,true);   WAIT_BAR(3); RESC(); ROT();
  }
  #define ENDW(tt) do{ if((tt)+3<NT){WAIT_BAR(3);} else if((tt)+2<NT){WAIT_BAR(2);} else {WAIT_BAR(0);} }while(0)
  for(;t+1<NT;t+=2){
    STEP(pB0,pB1,pA0,pA1,t,(t+3<NT),(t+1<NT),(t+1<NT));       ENDW(t);   RESC(); ROT();
    STEP(pA0,pA1,pB0,pB1,t+1,(t+4<NT),(t+2<NT),(t+2<NT));     ENDW(t+1); RESC(); ROT();
  }
  STEP(pB0,pB1,pA0,pA1,NT-1,false,false,false); RESC();
  { pw3=(u32x4){PKW(pB1,8),PKW(pB1,10),PKW(pB1,12),PKW(pB1,14)};
    SBAR(); pv(o,vb0+2*sl_cur,PAF(0),PAF(1),PAF(2),PAF(3)); pv(o+2,vb0+2*sl_cur+8192,PAF(0),PAF(1),PAF(2),PAF(3)); }
  #undef PKW
  #undef PAF
  #undef FID
  #undef VF
  #undef VRDR
  #undef PIN
  #undef MX3
  #undef GAPA
  #undef GAPB
  #undef EX
  #undef KRD
  #undef STEP
  #undef ENDW
  {auto rr=__builtin_amdgcn_permlane32_swap(__float_as_uint(l_reg),__float_as_uint(l_reg),false,false);l_reg=__uint_as_float(rr[0])+__uint_as_float(rr[1]);}
  if(hi==0)wsf[32+r32]=l_reg;asm volatile("s_waitcnt lgkmcnt(0)":::"memory");
  float rli[16];
  #pragma unroll
  for(int r=0;r<16;++r)rli[r]=__builtin_amdgcn_rcpf(wsf[32+crow(r,hi)]);
  { bf16*stg=(bf16*)(shm+U_LDS_OST)+wid*2048;
    bf16*Ow=Ou+(long)(wid*QBLK)*opitch;
    #pragma unroll
    for(int hf=0;hf<2;++hf){
      #pragma unroll
      for(int r=0;r<16;++r){const int orow=crow(r,hi);
        #pragma unroll
        for(int d0=0;d0<2;++d0)stg[orow*64+d0*32+r32]=(bf16)(o[2*hf+d0][r]*rli[r]);}
      asm volatile("s_waitcnt lgkmcnt(0)":::"memory");
      #pragma unroll
      for(int i=0;i<4;++i){const int row=i*8+(lane>>3),ch=lane&7; const u32x4 v=*(const u32x4*)(stg+row*64+ch*8); *(u32x4*)(Ow+(long)row*opitch+hf*64+ch*8)=v;}
      asm volatile("s_waitcnt lgkmcnt(0)":::"memory"); } }
  asm volatile("s_waitcnt lgkmcnt(0)\n\ts_barrier":::"memory");
  #undef DMA_K
  #undef DMA_V
  #undef RESC
  #undef ROT
  #undef QF
}

__device__ __forceinline__ void diff_combine_unit(const bf16*O0u,const bf16*O1u,int opitch,float lam,const float*subg,bf16*Mx){
  const int tid=threadIdx.x,lane=tid&63; const int wid=__builtin_amdgcn_readfirstlane(tid>>6);
  asm volatile("s_waitcnt vmcnt(0)":::"memory");
  const bf16*O0w=O0u+(long)(wid*QBLK)*opitch; const bf16*O1w=O1u+(long)(wid*QBLK)*opitch; bf16*Mw=Mx+(long)(wid*QBLK)*1024;
  float sg[16];
  #pragma unroll
  for(int j=0;j<16;++j)sg[j]=subg[(j>>3)*64+(lane&7)*8+(j&7)];
  #pragma unroll
  for(int i=0;i<4;++i){const int row=i*8+(lane>>3),ch=lane&7;
    float d[16]; float ss=0.f;
    #pragma unroll
    for(int hf=0;hf<2;++hf){ const h16x8 v0=*(const h16x8*)(O0w+(long)row*opitch+hf*64+ch*8); const h16x8 v1=*(const h16x8*)(O1w+(long)row*opitch+hf*64+ch*8);
      #pragma unroll
      for(int j=0;j<8;++j){d[hf*8+j]=(float)v0[j]-lam*(float)v1[j];ss+=d[hf*8+j]*d[hf*8+j];} }
    ss+=__shfl_xor(ss,1);ss+=__shfl_xor(ss,2);ss+=__shfl_xor(ss,4);
    const float rs=__builtin_amdgcn_rsqf(ss*(1.f/128.f)+1e-6f)*0.8f;
    #pragma unroll
    for(int hf=0;hf<2;++hf){ h16x8 ov;
      #pragma unroll
      for(int j=0;j<8;++j)ov[j]=(_Float16)(d[hf*8+j]*rs*sg[hf*8+j]);
      *(h16x8*)(Mw+(long)row*1024+hf*64+ch*8)=ov; } }
}
constexpr int ATTN_LDS_BYTES=LDS_BYTES;
#undef SBAR
#undef WAIT_BAR
}

DEV void ph_attn(const Frame& F, int vcu) {
    const f16* qkv = WSP(f16, WS_QKV); f16* sdiff = WSP(f16, WS_SDIFF); f16* mixed = WSP(f16, WS_MIXED);
    const int spr = F.G >> 3, qb = vcu & 7;
#pragma unroll 1
    for (int i = 0;; ++i) {
        const int L = i * spr + (vcu >> 3); if (L >= NB * 4) break;
        const int b = L >> 2, h = L & 3;
        const size_t trow = (size_t)b * SEQ + qb * 256;
        const f16* base = qkv + (size_t)b * RB * NIN;
        const f16* qrow = base + (size_t)(CL + qb * 256) * NIN;
        f16* o0 = sdiff + trow * 512 + h * 128;
#pragma unroll 1
        for (int mp = 0; mp < 2; ++mp)
            attn_body::attn_unit128<8>(qrow + h * 128 + mp * 64, base + 512 + h * 128 + mp * 64, base + 1024 + h * 128, o0 + (size_t)mp * NT * 512, 512, (char*)F.lds);
        attn_body::diff_combine_unit(o0, o0 + (size_t)NT * 512, 512, WSP(float, WS_MISC)[0], F.in[15], mixed + trow * DM + h * 128);
    }
#pragma unroll 1
    for (int i = 0;; ++i) {
        const int L = i * spr + (vcu >> 3); if (L >= NB * 8) break;
        const int b = L >> 3, g = L & 7;
        const size_t trow = (size_t)b * SEQ + qb * 256;
        const f16* base = qkv + (size_t)b * RB * NIN;
        attn_body::attn_unit<8>(base + (size_t)(CL + qb * 256) * NIN + 1536 + g * 64, base + 2048 + (g >> 2) * 64, base + 2176 + (g >> 2) * 64, mixed + trow * DM + 512 + g * 64, DM, (char*)F.lds);
    }
}

DEV void ph_rowpass(const Frame& F) {
    const float* x = F.in[0]; const f16* y1 = WSP(f16, WS_Y1); const float* mod = WSP(float, WS_MOD); const float* gpost = F.in[7]; const float* gpre = F.in[17];
    const float* wr = F.in[19]; const float* rbias = F.in[20]; float* x1out = F.out; unsigned char* h2 = F.ws + WS_H2;
    int* idx = WSP(int, WS_IDX); int* rank = WSP(int, WS_RANK); float* gw = WSP(float, WS_GW); int* cnt = WSP(int, WS_CNT);
    constexpr int AROW = 2064;
    LAS unsigned char* Ahi = (LAS unsigned char*)F.lds; LAS unsigned char* Alo = Ahi + 16 * AROW; LAS float* part = (LAS float*)(Ahi + 32 * AROW);
    LAS int* lcnt = (LAS int*)(Ahi + 32 * AROW + 32768);
    if (F.tid < 64) lcnt[F.tid] = 0;
    const int wave = F.wave, lane = F.lane, fr = lane & 15, fq = lane >> 4;
    f16x8 Bh[4][4];
#pragma unroll
    for (int ks = 0; ks < 4; ++ks)
#pragma unroll
        for (int n = 0; n < 4; ++n) { const int k0 = wave * 128 + ks * 32 + fq * 8, e = n * 16 + fr;
#pragma unroll
            for (int j = 0; j < 8; ++j) Bh[ks][n][j] = (f16)wr[(k0 + j) * NE + e]; }
    const float rb = rbias[lane];
    f32x4 X[2][4]; f16x4 Y[2][4];
#define RP_LOAD(T0) do { _Pragma("unroll") for (int u = 0; u < 2; ++u) { const size_t t_ = (size_t)(T0) + wave * 2 + u; \
        _Pragma("unroll") for (int j = 0; j < 4; ++j) { const int c0 = j * 256 + lane * 4; X[u][j] = *(const f32x4*)(x + t_ * DM + c0); Y[u][j] = *(const f16x4*)(y1 + t_ * DM + c0); } } } while (0)
    if (F.bid * 16 < NT) RP_LOAD(F.bid * 16);
    for (int t0 = F.bid * 16; t0 < NT; t0 += F.G * 16) {
#pragma unroll
        for (int u = 0; u < 2; ++u) {
            const int r = wave * 2 + u; const size_t t = (size_t)t0 + r; const int b = (int)(t / SEQ);
            const float* m = mod + (size_t)b * NMOD;
            float ss = 0.f;
#pragma unroll
            for (int j = 0; j < 4; ++j)
#pragma unroll
                for (int i = 0; i < 4; ++i) { const float yv = (float)Y[u][j][i]; ss += yv * yv; }
            const float rstd1 = rsqrtf(wave_sum(ss) * (1.f / DM) + EPS);
            float s2 = 0.f;
#pragma unroll
            for (int j = 0; j < 4; ++j) { const int c0 = j * 256 + lane * 4; const f32x4 gp = *(const f32x4*)(gpost + c0), gt = *(const f32x4*)(m + 2048 + c0); f16x4 oh;
#pragma unroll
                for (int i = 0; i < 4; ++i) { const float v = X[u][j][i] + gt[i] * ((float)Y[u][j][i] * rstd1 * gp[i]); X[u][j][i] = v; oh[i] = (f16)v; s2 += v * v; }
                *(f16x4*)((f16*)(x1out + t * DM) + c0) = oh; }
            const float rstd2 = rsqrtf(wave_sum(s2) * (1.f / DM) + EPS);
#pragma unroll
            for (int j = 0; j < 4; ++j) { const int c0 = j * 256 + lane * 4; const f32x4 gp = *(const f32x4*)(gpre + c0), sh = *(const f32x4*)(m + 3072 + c0), sc = *(const f32x4*)(m + 4096 + c0); f16x4 o, ol;
#pragma unroll
                for (int i = 0; i < 4; ++i) { const float v = X[u][j][i] * rstd2 * gp[i] * (1.f + sc[i]) + sh[i]; o[i] = (f16)v; ol[i] = (f16)(v - (float)o[i]); }
                { int q8 = __builtin_amdgcn_cvt_pk_fp8_f32(c8((float)o.x + (float)ol.x), c8((float)o.y + (float)ol.y), 0, false); q8 = __builtin_amdgcn_cvt_pk_fp8_f32(c8((float)o.z + (float)ol.z), c8((float)o.w + (float)ol.w), q8, true); *(int*)(h2 + t * DM + c0) = q8; }
                *(LAS f16x4*)(Ahi + r * AROW + c0 * 2) = o; *(LAS f16x4*)(Alo + r * AROW + c0 * 2) = ol; }
        }
        if (t0 + F.G * 16 < NT) RP_LOAD(t0 + F.G * 16);
        __syncthreads();
        { f32x4 acc[4];
#pragma unroll
          for (int n = 0; n < 4; ++n) acc[n] = (f32x4){0.f, 0.f, 0.f, 0.f};
#pragma unroll
          for (int ks = 0; ks < 4; ++ks) { const int off = fr * AROW + (wave * 128 + ks * 32 + fq * 8) * 2;
              const f16x8 ah = *(const LAS f16x8*)(Ahi + off), al = *(const LAS f16x8*)(Alo + off);
#pragma unroll
              for (int n = 0; n < 4; ++n) { acc[n] = __builtin_amdgcn_mfma_f32_16x16x32_f16(ah, Bh[ks][n], acc[n], 0, 0, 0); acc[n] = __builtin_amdgcn_mfma_f32_16x16x32_f16(al, Bh[ks][n], acc[n], 0, 0, 0); } }
#pragma unroll
          for (int n = 0; n < 4; ++n)
#pragma unroll
              for (int q = 0; q < 4; ++q) part[(wave * 16 + 4 * fq + q) * 64 + n * 16 + fr] = acc[n][q]; }
        __syncthreads();
#pragma unroll 1
        for (int rr = 0; rr < 2; ++rr) {
            const int r = wave * 2 + rr; const size_t t = (size_t)t0 + r; const int e = lane;
            float lgt = 0.f;
#pragma unroll
            for (int p = 0; p < 8; ++p) lgt += part[(p * 16 + r) * 64 + e];
            const float s = 1.f / (1.f + expf(-lgt)); const float sel = s + rb;
            int rk = 0;
#pragma unroll
            for (int d = 1; d < 8; ++d) { const float o = __shfl_xor(sel, d); rk += (o > sel || (o == sel && (e ^ d) < e)) ? 1 : 0; }
            float gs = rk < 2 ? sel : 0.f; gs += __shfl_xor(gs, 1); gs += __shfl_xor(gs, 2); gs += __shfl_xor(gs, 4);
            int grk = 0; const int g = e >> 3;
#pragma unroll
            for (int d = 1; d < 8; ++d) { const float o = __shfl_xor(gs, d * 8); grk += (o > gs || (o == gs && (g ^ d) < g)) ? 1 : 0; }
            const bool gsel = grk < 4;
            const float v = gsel ? sel : -INFINITY;
            int r8 = 0;
#pragma unroll
            for (int j = 0; j < 64; ++j) { const float o = __builtin_bit_cast(float, __builtin_amdgcn_readlane(__builtin_bit_cast(int, v), j)); r8 += (o > v || (o == v && j < e)) ? 1 : 0; }
            const bool chosen = gsel && r8 < 8;
            const float tot = wave_sum(chosen ? s : 0.f);
            if (chosen) { idx[t * 8 + r8] = e; gw[t * 8 + r8] = s / tot * 2.5f; rank[t * 8 + r8] = __hip_atomic_fetch_add(&lcnt[e], 1, __ATOMIC_RELAXED, __HIP_MEMORY_SCOPE_WORKGROUP); }
        }
    }
#undef RP_LOAD
    __syncthreads();
    if (F.tid < 64) WSP(int, WS_WGB)[F.bid * 64 + F.tid] = atomicAdd(&cnt[F.tid * 64], lcnt[F.tid]);
    __syncthreads();
}

DEV void ph_dispatch(const Frame& F) {
    const int* idx = WSP(int, WS_IDX); const int* rank = WSP(int, WS_RANK); const float* gw = WSP(float, WS_GW); const int* cnt = WSP(int, WS_CNT); const int* wgb = WSP(int, WS_WGB);
    int* tok = WSP(int, WS_TOK); int* pair = WSP(int, WS_PAIR); float* wsl = WSP(float, WS_WSL); int* blke = WSP(int, WS_BLKE); int* nblk = WSP(int, WS_CTL) + 64;
    int* pst = (int*)F.lds;
    const int tid = F.tid;
    if (tid < 64) { const int pc = ((cnt[tid * 64] + 255) >> 8) << 8; int incl = pc;
#pragma unroll
        for (int o = 1; o < 64; o <<= 1) { const int n = __shfl_up(incl, o); if (tid >= o) incl += n; }
        pst[tid] = incl - pc; if (tid == 63) pst[64] = incl; }
    __syncthreads();
    for (int gid = F.bid * NTHR + tid; gid < NT * 8; gid += F.G * NTHR) {
        const int e = idx[gid]; const int t = gid >> 3, k = gid & 7; const int slot = NT + pst[e] + wgb[((t >> 4) % F.G) * 64 + e] + rank[gid]; tok[slot] = t; pair[slot] = t * NSLOTK + k; wsl[slot] = gw[gid];
        if (gid < NT) { tok[gid] = gid; pair[gid] = gid * NSLOTK + 8; wsl[gid] = 1.f; }
    }
    for (int e = F.bid; e < 64; e += F.G) {
        for (int s = NT + pst[e] + cnt[e * 64] + tid; s < NT + pst[e + 1]; s += NTHR) { tok[s] = 0; pair[s] = -1; wsl[s] = 0.f; }
    }
    if (F.bid == 0) {
        const int nb = SH_BLKS + (pst[64] >> 8);
        if (tid == 0) *nblk = nb;
        for (int bk = tid; bk < MAX_BLKS; bk += NTHR) {
            int e = 64;
            if (bk >= SH_BLKS) { const int off = (bk - SH_BLKS) << 8; e = 0; for (int q = 0; q < 64; ++q) if (off >= pst[q] && off < pst[q + 1]) e = q; }
            blke[bk] = e;
        }
    }
    __syncthreads();
}

DEV void ph_combine(const Frame& F, float* dst) {
    const unsigned char* yp = F.ws + WS_YP; const float* mod = WSP(float, WS_MOD); const float* gpf = F.in[18]; float* out = F.out;
    const int lane = F.lane;
    for (size_t t0 = (size_t)F.gw * 2; t0 < (size_t)NT; t0 += (size_t)F.NGW * 2) {
        f16x8 xa[2], xb[2]; uint4 w[2][NSLOTK];
#pragma unroll
        for (int u = 0; u < 2; ++u) { const size_t t = t0 + u;
            xa[u] = *(const f16x8*)((const f16*)(out + t * DM) + lane * 16); xb[u] = *(const f16x8*)((const f16*)(out + t * DM) + lane * 16 + 8);
#pragma unroll
            for (int k = 0; k < NSLOTK; ++k) w[u][k] = *(const uint4*)(yp + (t * NSLOTK + k) * DM + lane * 16); }
#pragma unroll
        for (int u = 0; u < 2; ++u) { const size_t t = t0 + u; const int b = (int)(t / SEQ);
            float acc[16];
#pragma unroll
            for (int i = 0; i < 16; ++i) acc[i] = 0.f;
#pragma unroll
            for (int k = 0; k < NSLOTK; ++k) {
                const unsigned ww[4] = {w[u][k].x, w[u][k].y, w[u][k].z, w[u][k].w};
#pragma unroll
                for (int i = 0; i < 4; ++i) { const f32x2 lo = __builtin_amdgcn_cvt_pk_f32_fp8((int)ww[i], false), hi = __builtin_amdgcn_cvt_pk_f32_fp8((int)ww[i], true);
                    acc[i * 4] += lo.x; acc[i * 4 + 1] += lo.y; acc[i * 4 + 2] += hi.x; acc[i * 4 + 3] += hi.y; }
            }
            float ss = 0.f;
#pragma unroll
            for (int i = 0; i < 16; ++i) { acc[i] *= (1.f / YSCALE); ss += acc[i] * acc[i]; }
            const float rstd = rsqrtf(wave_sum(ss) * (1.f / DM) + EPS);
            const float* m = mod + (size_t)b * NMOD + 5120;
#pragma unroll
            for (int i = 0; i < 4; ++i) { const int c0 = lane * 16 + i * 4; const f32x4 g = *(const f32x4*)(gpf + c0), gt = *(const f32x4*)(m + c0); f32x4 o;
#pragma unroll
                for (int j = 0; j < 4; ++j) { const int q = i * 4 + j; const float x1 = (float)(q < 8 ? xa[u][q & 7] : xb[u][q & 7]); o[j] = x1 + gt[j] * (acc[q] * rstd * g[j]); }
                *(f32x4*)(dst + t * DM + c0) = o; }
        }
    }
}

#define XB_TMO      128
#define XB_XCNT(j)  (256  + 64 * (j))
#define XB_XSUB(j)  (1280 + 64 * (j))
#define XB_XGEN(j)  (2304 + 64 * (j))
#define XB_TOP      3328
#define XB_TOPGEN   3392
#define XCD_BAR_WORDS 3456
#define XB_SPIN_CAP (1u << 20)
DEV unsigned xb_ld(unsigned* p)              { return __hip_atomic_load(p, __ATOMIC_RELAXED, __HIP_MEMORY_SCOPE_AGENT); }
DEV unsigned xb_add(unsigned* p, unsigned v) { return __hip_atomic_fetch_add(p, v, __ATOMIC_RELAXED, __HIP_MEMORY_SCOPE_AGENT); }
DEV unsigned xb_xcc_id() { return (unsigned)__builtin_amdgcn_s_getreg((3 << 11) | 20) & 0xFu; }
#define XB_SPIN(cond, bar) do { unsigned _sp = 0; while (cond) { __builtin_amdgcn_s_sleep(1); \
    if ((++_sp & 255u) == 0u) { if (xb_ld(&(bar)[XB_TMO])) break; if (_sp > XB_SPIN_CAP) { atomicAdd(&(bar)[XB_TMO], 1u); break; } } } } while (0)
struct XcdBarrier { unsigned* bar; unsigned x; volatile LAS unsigned* st; };
DEV XcdBarrier xcd_barrier_post(unsigned* bar, volatile LAS unsigned* st) {
    XcdBarrier b; b.bar = bar; b.x = xb_xcc_id(); b.st = st;
    if (threadIdx.x == 0) (void)xb_add(&bar[XB_XCNT(b.x)], 1u);
    return b;
}
DEV void xcd_barrier_complete(unsigned* bar, unsigned x, unsigned& nloc, unsigned& nx) {
    const unsigned G = gridDim.x * gridDim.y * gridDim.z;
    unsigned sum, cnt, mine, sp = 0u;
    for (;;) {
        sum = 0u; cnt = 0u; mine = 0u;
#pragma unroll
        for (unsigned j = 0; j < 16; ++j) { const unsigned c = xb_ld(&bar[XB_XCNT(j)]); sum += c; cnt += (c > 0u) ? 1u : 0u; mine = (j == x) ? c : mine; }
        if (sum == G) break;
        __builtin_amdgcn_s_sleep(1);
        if ((++sp & 255u) == 0u) { if (xb_ld(&bar[XB_TMO])) break; if (sp > XB_SPIN_CAP) { atomicAdd(&bar[XB_TMO], 1u); break; } }
    }
    nloc = mine > 0u ? mine : 1u; nx = cnt > 0u ? cnt : 1u;
}
DEV void xcd_barrier(const XcdBarrier& b) {
    asm volatile("s_waitcnt vmcnt(0)" ::: "memory");
    __syncthreads();
    if (threadIdx.x == 0) {
        unsigned* bar = b.bar;
        __builtin_amdgcn_s_waitcnt(0);
        unsigned nloc = b.st[0], nx = b.st[1];
        if (nloc == 0u) { xcd_barrier_complete(bar, b.x, nloc, nx); b.st[0] = nloc; b.st[1] = nx; }
        const unsigned old = xb_add(&bar[XB_XSUB(b.x)], 1u);
        const unsigned gen = old / nloc;
        if (old + 1u == (gen + 1u) * nloc) {
            __builtin_amdgcn_fence(__ATOMIC_RELEASE, "agent");
            asm volatile("s_waitcnt vmcnt(0)" ::: "memory");
            const unsigned og = xb_add(&bar[XB_TOP], 1u);
            const unsigned tg = og / nx;
            if (og + 1u == (tg + 1u) * nx) xb_add(&bar[XB_TOPGEN], 1u);
            else XB_SPIN(xb_ld(&bar[XB_TOPGEN]) == tg, bar);
            __builtin_amdgcn_fence(__ATOMIC_ACQUIRE, "agent");
            xb_add(&bar[XB_XGEN(b.x)], 1u);
            asm volatile("s_waitcnt vmcnt(0)" ::: "memory");
        } else {
            XB_SPIN(xb_ld(&bar[XB_XGEN(b.x)]) == gen, bar);
            __builtin_amdgcn_fence(__ATOMIC_ACQUIRE, "agent");
            asm volatile("s_waitcnt vmcnt(0)" ::: "memory");
        }
    }
    __syncthreads();
}

#ifndef PROBE_DUP
#define PROBE_DUP -1
#endif
constexpr int NPHASE = 11;
__global__ void __launch_bounds__(NTHR, 2) mega(Args a) {
    extern __shared__ __attribute__((aligned(16))) unsigned char lds[];
    cg::grid_group grid = cg::this_grid();
    Frame F;
    F.lds = lds; F.tid = threadIdx.x; F.lane = F.tid & 63; F.wave = __builtin_amdgcn_readfirstlane(F.tid >> 6); F.bid = blockIdx.x; F.G = gridDim.x;
    F.gw = F.bid * NWAVE + F.wave; F.NGW = F.G * NWAVE; F.in = a.in; F.out = a.out; F.ws = a.ws;
    const int lo = a.ph_lo, hi = a.ph_hi;
#ifndef ONLY_PHASE
#define ONLY_PHASE -1
#endif
#define IN(k) (lo <= (k) && (k) < hi && (ONLY_PHASE < 0 || (k) == ONLY_PHASE))
    volatile LAS unsigned* xst = (volatile LAS unsigned*)((LAS unsigned char*)lds + LDS_BYTES - 128);
    if (F.tid < 2) xst[F.tid] = 0u;
    __syncthreads();
    const XcdBarrier xbar = xcd_barrier_post((unsigned*)(a.ws + WS_BAR), xst);
#define SEAM(k) do { if (IN(k) && IN((k) + 1)) { if (hi > 64) grid.sync(); else xcd_barrier(xbar); } } while (0)
#define RUN(k, ...) do { if (IN(k)) { __VA_ARGS__; if (PROBE_DUP == (k) && (k) != 10) { xcd_barrier(xbar); __VA_ARGS__; } } } while (0)
    const int vcu = (F.G % 8 == 0) ? (F.bid % 8) * (F.G / 8) + F.bid / 8 : F.bid;
    LAS unsigned char* lds3 = (LAS unsigned char*)lds;
    RUN(0, { ph_mod(F); ph_wconv(F); }); SEAM(0);
    RUN(1, ph_prenorm(F)); SEAM(1);
    RUN(2, { pg8::SchedInProj S{(const char*)WSP(f16, WS_HALL), (const char*)WSP(f16, WS_WIN), vcu, F.G};
        pg8::EpiInProj E{WSP(f16, WS_QKV), F.in[9], F.in[10], WSP(float, WS_ROPE)};
        pg8::gemm_phase<pg8::EpiInProj, pg8::SchedInProj, false>(lds3, DM * 2, S, E, nullptr, nullptr, nullptr); }); SEAM(2);
    RUN(3, ph_attn(F, vcu)); if (IN(3) && IN(5)) xcd_barrier(xbar);
    RUN(5, { pg8::SchedDense S{(const char*)WSP(f16, WS_MIXED), (const char*)WSP(f16, WS_WOUT), vcu, F.G, (NT / 256) * 4, 4, DM};
        pg8::EpiPlain E{WSP(f16, WS_Y1), DM};
        pg8::gemm_phase<pg8::EpiPlain, pg8::SchedDense, false>(lds3, DM * 2, S, E, nullptr, nullptr, nullptr); }); SEAM(5);
    RUN(6, ph_rowpass(F)); SEAM(6);
    RUN(7, ph_dispatch(F)); SEAM(7);
    RUN(8, { const int nb = *(WSP(int, WS_CTL) + 64);
        pg8::SchedGrouped S{nullptr, (const char*)(F.ws + WS_WGU), WSP(int, WS_BLKE), vcu, F.G, nb * 2, 2, DM / 2, (size_t)512 * DM, 1};
        pg8::EpiGU E{F.ws + WS_H, WSP(float, WS_WSL)};
        pg8::gemm_phase<pg8::EpiGU, pg8::SchedGrouped, true, true>(lds3, DM, S, E, WSP(int, WS_TOK), (const char*)(F.ws + WS_H2), WSP(unsigned, WS_WSL), 0x79797979, 0x7F7F7F7F); }); SEAM(8);
    RUN(9, { const int nb = *(WSP(int, WS_CTL) + 64);
        pg8::SchedGrouped S{(const char*)(F.ws + WS_H), (const char*)(F.ws + WS_WD), WSP(int, WS_BLKE), vcu, F.G, nb * 4, 4, EH / 2, (size_t)DM * EH, 1};
        pg8::EpiDown E{F.ws + WS_YP, WSP(int, WS_PAIR)};
        pg8::gemm_phase<pg8::EpiDown, pg8::SchedGrouped, false, true, true>(lds3, EH, S, E, nullptr, nullptr, WSP(unsigned, WS_PAIR), 0x79797979, 0x80808080  ); }); SEAM(9);
    RUN(10, ph_combine(F, F.out));
}

extern "C" void kernel_launch(void* const* d_in, const int* in_sizes, int n_in, void* d_out, int out_size, void* d_ws, size_t ws_size, hipStream_t stream) {
    (void)in_sizes; (void)out_size;
    static int grid = 0;
    if (grid == 0) {
        if (n_in != 27 || ws_size < WS_END) { fprintf(stderr, "kernel_launch: unexpected n_in %d / ws_size %zu (need %zu)\n", n_in, ws_size, (size_t)WS_END); grid = -1; return; }
        int dev = 0, cus = 0, per_cu = 0;
        (void)hipGetDevice(&dev); (void)hipDeviceGetAttribute(&cus, hipDeviceAttributeMultiprocessorCount, dev);
        if (hipFuncSetAttribute((const void*)mega, hipFuncAttributeMaxDynamicSharedMemorySize, LDS_BYTES) != hipSuccess) { fprintf(stderr, "kernel_launch: hipFuncSetAttribute failed\n"); grid = -1; return; }
        if (hipOccupancyMaxActiveBlocksPerMultiprocessor(&per_cu, (const void*)mega, NTHR, LDS_BYTES) != hipSuccess || per_cu < 1) { fprintf(stderr, "kernel_launch: occupancy query failed (%d)\n", per_cu); (void)hipGetLastError(); per_cu = 1; }
        grid = cus * (per_cu > 1 ? 1 : per_cu);
        if (grid <= 0) grid = 256;
    }
    if (grid < 0) return;
    (void)hipMemsetAsync((unsigned char*)d_ws + WS_CTL, 0, 64 * 1024, stream);
    Args a{};
    for (int i = 0; i < 27; ++i) a.in[i] = (const float*)d_in[i];
    a.out = (float*)d_out; a.ws = (unsigned char*)d_ws; a.ph_lo = 0; a.ph_hi = NPHASE;
    void* args[] = {&a};
    hipError_t e = hipLaunchCooperativeKernel((const void*)mega, dim3(grid), dim3(NTHR), args, LDS_BYTES, stream);
    if (e != hipSuccess) fprintf(stderr, "kernel_launch: cooperative launch failed: %s (grid %d)\n", hipGetErrorString(e), grid);
}
```

```cpp
#include <hip/hip_runtime.h>
#include <hip/hip_cooperative_groups.h>
#include <stdint.h>
#include <math.h>
#include <cstdio>
namespace cg = cooperative_groups;

typedef _Float16 f16;
typedef _Float16 f16x8 __attribute__((ext_vector_type(8)));
typedef _Float16 f16x4 __attribute__((ext_vector_type(4)));
typedef float f32x4 __attribute__((ext_vector_type(4)));
typedef float f32x2 __attribute__((ext_vector_type(2)));
#define DEV __device__ __forceinline__
#define LAS __attribute__((address_space(3)))

constexpr int NB = 32, SEQ = 2048, DM = 1024, NT = NB * SEQ, CL = 256, RB = SEQ + CL, RALL = NB * RB;
constexpr int NIN = 2304, NMOD = 6144, NE = 64, EH = 256, TOPK = 8, NSLOTK = 9;
constexpr int SH_BLKS = NT / 256;
constexpr int MAX_BLKS = SH_BLKS + (NT * TOPK) / 256 + NE;
constexpr int MAX_SLOTS = MAX_BLKS * 256;
constexpr float EPS = 1e-6f;
constexpr float QSCALE = 0.125f * 1.4426950408889634f;
constexpr float YSCALE = 8.0f;
constexpr int NTHR = 512, NWAVE = 8;
constexpr int LDS_BYTES = 147456;

constexpr size_t MiB = 1ull << 20;
constexpr size_t WS_CTL = 0;
constexpr size_t WS_CNT = 32768;
constexpr size_t WS_BAR = 4096;
constexpr size_t WS_MOD = 64 * 1024;
constexpr size_t WS_ROPE = 1 * MiB;
constexpr size_t WS_MISC = 1 * MiB + 64 * 1024;
constexpr size_t WS_BLKE = 1 * MiB + 128 * 1024;
constexpr size_t WS_WIN = 4 * MiB;
constexpr size_t WS_WOUT = WS_WIN + (size_t)NIN * DM * 2;
constexpr size_t WS_WGU = WS_WOUT + (size_t)DM * DM * 2;
constexpr size_t WS_WD = WS_WGU + (size_t)65 * 512 * DM * 2;
constexpr size_t WS_WEND = WS_WD + (size_t)65 * DM * EH * 2;
static_assert(WS_WEND <= 108 * MiB, "weights");
constexpr size_t WS_HALL = 108 * MiB;
constexpr size_t WS_MIXED = 108 * MiB;
constexpr size_t WS_QKV = 252 * MiB;
constexpr size_t WS_SDIFF = 576 * MiB;
constexpr size_t WS_Y1 = 704 * MiB;
constexpr size_t WS_H = 108 * MiB;
constexpr size_t WS_YP = 404 * MiB;
constexpr size_t WS_H2 = 404 * MiB;
constexpr size_t WS_TAB = 980 * MiB;
constexpr size_t WS_IDX = WS_TAB;
constexpr size_t WS_RANK = WS_IDX + (size_t)NT * 8 * 4;
constexpr size_t WS_GW = WS_RANK + (size_t)NT * 8 * 4;
constexpr size_t WS_TOK = WS_GW + (size_t)NT * 8 * 4;
constexpr size_t WS_PAIR = WS_TOK + (size_t)MAX_SLOTS * 4;
constexpr size_t WS_WSL = WS_PAIR + (size_t)MAX_SLOTS * 4;
constexpr size_t WS_WGB = WS_WSL + (size_t)MAX_SLOTS * 4;
constexpr size_t WS_END = WS_WGB + (size_t)1024 * 64 * 4;
static_assert(WS_END <= 1024 * MiB, "ws");

DEV float wave_sum(float v) {
#pragma unroll
    for (int o = 32; o > 0; o >>= 1) v += __shfl_xor(v, o);
    return v;
}
DEV float silu(float v) { return v / (1.f + __expf(-v)); }
DEV float silu_f(float v) { return v * __builtin_amdgcn_rcpf(1.f + __builtin_amdgcn_exp2f(v * -1.44269504f)); }
DEV float c8(float v) { return __builtin_amdgcn_fmed3f(v, -448.f, 448.f); }
DEV unsigned char f2fp8(float v) { const int r = __builtin_amdgcn_cvt_pk_fp8_f32(v, v, 0, false); return (unsigned char)(r & 0xff); }

struct Args { const float* in[27]; float* out; unsigned char* ws; int ph_lo, ph_hi; };
struct Frame {
    unsigned char* lds; int tid, lane, wave, bid, G, gw, NGW;
    const float* const* in; float* out; unsigned char* ws;
};
#define WSP(T, off) ((T*)(F.ws + (off)))

DEV void ph_mod(const Frame& F) {
    const float* c = F.in[1]; const float* c_ctx = F.in[3]; const float* w_mod = F.in[4]; const float* b_mod = F.in[5];
    float* mod = WSP(float, WS_MOD);
    if (F.bid == 0) {
        if (F.tid < 64) { float a = F.in[11][F.tid] * F.in[12][F.tid], b = F.in[13][F.tid] * F.in[14][F.tid]; a = wave_sum(a); b = wave_sum(b); if (F.tid == 0) WSP(float, WS_MISC)[0] = expf(a) - expf(b) + 0.2f; }
        float* rope = WSP(float, WS_ROPE);
        for (int i = F.tid; i < 64 * 16; i += NTHR) { const int pos = i >> 4, j = i & 15; const float ang = (float)pos * powf(10000.0f, -(float)j / 16.0f); rope[i * 2] = cosf(ang); rope[i * 2 + 1] = sinf(ang); }
    }
    constexpr int MC = 24;
    if (F.bid >= NMOD / MC) return;
    float* sc = (float*)F.lds;
    const int c0 = F.bid * MC, kh = F.lane / MC, col = F.lane - kh * MC;
    const float* wp = w_mod + (size_t)(F.wave * 128 + kh) * NMOD + c0 + col;
    float wa[8], wb[8];
#define MOD_LOAD(W, IT0) do { if (kh < 2) { _Pragma("unroll") for (int u = 0; u < 8; ++u) W[u] = wp[(size_t)((IT0) + u) * 2 * NMOD]; } } while (0)
#define MOD_FMA(W, IT0) do { if (kh < 2) { _Pragma("unroll") for (int u = 0; u < 8; ++u) { const int k = F.wave * 128 + ((IT0) + u) * 2 + kh; _Pragma("unroll") for (int r = 0; r < 33; ++r) acc[r] += sc[r * DM + k] * W[u]; } } } while (0)
    MOD_LOAD(wa, 0);
    for (int i = F.tid; i < 33 * DM; i += NTHR) { const int r = i >> 10, k = i & 1023; sc[i] = silu_f(r < 32 ? c[r * DM + k] : c_ctx[k]); }
    __syncthreads();
    float acc[33];
#pragma unroll
    for (int r = 0; r < 33; ++r) acc[r] = 0.f;
#pragma unroll 1
    for (int it0 = 0; it0 < 64; it0 += 16) {
        MOD_LOAD(wb, it0 + 8); MOD_FMA(wa, it0);
        if (it0 + 16 < 64) MOD_LOAD(wa, it0 + 16);
        MOD_FMA(wb, it0 + 8);
    }
#undef MOD_LOAD
#undef MOD_FMA
#pragma unroll
    for (int r = 0; r < 33; ++r) acc[r] += __shfl_down(acc[r], MC);
    __syncthreads();
    float* red = (float*)F.lds;
    if (F.lane < MC) {
#pragma unroll
        for (int r = 0; r < 33; ++r) red[(F.wave * 33 + r) * MC + col] = acc[r];
    }
    __syncthreads();
    for (int i = F.tid; i < 33 * MC; i += NTHR) { const int r = i / MC, cc = i - r * MC; float s = b_mod[c0 + cc];
#pragma unroll
        for (int w = 0; w < 8; ++w) s += red[(w * 33 + r) * MC + cc];
        mod[(size_t)r * NMOD + c0 + cc] = s; }
    __syncthreads();
}

struct WItem { const float* W; unsigned char* WT; int K, N, rowmode, f8, item; };
DEV void wconv_load(const WItem& d, int lane, f32x4 (&t)[8]) {
    const int nblk = d.N / 32, kb = d.item / nblk, nb = d.item % nblk, k0 = 64 * kb, n0 = 32 * nb;
#pragma unroll
    for (int i = 0; i < 8; ++i) t[i] = *(const f32x4*)(d.W + (size_t)(k0 + i * 8 + (lane >> 3)) * d.N + n0 + (lane & 7) * 4);
}
DEV void wconv_put(const WItem& d, int lane, const f32x4 (&t)[8], float* scr) {
    const int K = d.K, nblk = d.N / 32, kb = d.item / nblk, nb = d.item % nblk, k0 = 64 * kb, n0 = 32 * nb;
#pragma unroll
    for (int i = 0; i < 8; ++i) { float* q = scr + (i * 8 + (lane >> 3)) * 33 + (lane & 7) * 4; q[0] = t[i].x; q[1] = t[i].y; q[2] = t[i].z; q[3] = t[i].w; }
    __builtin_amdgcn_s_waitcnt(0xC07F); asm volatile("" ::: "memory");
    const int c = lane & 7;
#pragma unroll
    for (int j = 0; j < 4; ++j) {
        const int n = (lane >> 3) + 8 * j; const float* sp = scr + (8 * c) * 33 + n;
        const int nn = n0 + n;
        int row;
        if (d.rowmode == 0) row = nn;
        else if (d.rowmode == 3) { const int cc = nn & 255; row = (nn & ~255) + ((cc >> 5) & 1) * 128 + (cc >> 6) * 32 + (cc & 31); }
        else row = (nn >> 7) * 256 + (nn & 127) + (d.rowmode == 2 ? 128 : 0);
        if (d.f8) {
            int lo = __builtin_amdgcn_cvt_pk_fp8_f32(c8(sp[0] * 64.f), c8(sp[33] * 64.f), 0, false); lo = __builtin_amdgcn_cvt_pk_fp8_f32(c8(sp[66] * 64.f), c8(sp[99] * 64.f), lo, true);
            int hi = __builtin_amdgcn_cvt_pk_fp8_f32(c8(sp[132] * 64.f), c8(sp[165] * 64.f), 0, false); hi = __builtin_amdgcn_cvt_pk_fp8_f32(c8(sp[198] * 64.f), c8(sp[231] * 64.f), hi, true);
            *(uint2*)(d.WT + (size_t)row * K + k0 + 8 * c) = make_uint2((unsigned)lo, (unsigned)hi);
        } else {
            f16x8 o;
#pragma unroll
            for (int q = 0; q < 8; ++q) o[q] = (f16)sp[q * 33];
            *(f16x8*)(d.WT + ((size_t)row * K + k0 + 8 * c) * 2) = o;
        }
    }
    __builtin_amdgcn_s_waitcnt(0xC07F); asm volatile("" ::: "memory");
}
DEV void ph_wconv(const Frame& F) {
    float* scr = (float*)(F.lds + F.wave * 16384);
    constexpr int I_IN = (DM / 64) * (NIN / 32), I_OUT = (DM / 64) * (DM / 32), I_E = (DM / 64) * (EH / 32);
    constexpr int NITEMS = I_IN + I_OUT + 65 * 3 * I_E;
    auto decode = [&](int it, WItem& d) {
        int r = it;
        if (r < I_IN) { d = WItem{F.in[8], F.ws + WS_WIN, DM, NIN, 3, 0, r}; return; } r -= I_IN;
        if (r < I_OUT) { d = WItem{F.in[16], F.ws + WS_WOUT, DM, DM, 0, 0, r}; return; } r -= I_OUT;
        const int e = r / (3 * I_E), q = (r % (3 * I_E)) / I_E, ii = r % I_E;
        if (q == 0) d = WItem{e < 64 ? F.in[21] + (size_t)e * DM * EH : F.in[24], F.ws + WS_WGU + (size_t)e * 512 * DM, DM, EH, 1, 1, ii};
        else if (q == 1) d = WItem{e < 64 ? F.in[22] + (size_t)e * DM * EH : F.in[25], F.ws + WS_WGU + (size_t)e * 512 * DM, DM, EH, 2, 1, ii};
        else d = WItem{e < 64 ? F.in[23] + (size_t)e * DM * EH : F.in[26], F.ws + WS_WD + (size_t)e * DM * EH, EH, DM, 3, 1, ii};
    };
    int it = F.gw; if (it >= NITEMS) return;
    WItem cur, nxt; f32x4 ta[8], tb[8];
    decode(it, cur); wconv_load(cur, F.lane, ta);
#pragma unroll 1
    for (;;) {
        const int i1 = it + F.NGW; const bool h1 = i1 < NITEMS;
        if (h1) { decode(i1, nxt); wconv_load(nxt, F.lane, tb); }
        wconv_put(cur, F.lane, ta, scr);
        if (!h1) break;
        const int i2 = i1 + F.NGW; const bool h2 = i2 < NITEMS;
        if (h2) { decode(i2, cur); wconv_load(cur, F.lane, ta); }
        wconv_put(nxt, F.lane, tb, scr);
        if (!h2) break;
        it = i2;
    }
}

DEV void ph_prenorm(const Frame& F) {
    const float* x = F.in[0]; const float* ctx = F.in[2]; const float* g = F.in[6]; const float* mod = WSP(float, WS_MOD); f16* hall = WSP(f16, WS_HALL);
    const int lane = F.lane;
    constexpr int PBLK = 288; static_assert(RB % PBLK == 0 && RALL % PBLK == 0, "prenorm block");
    f32x4 gg[4];
#pragma unroll
    for (int j = 0; j < 4; ++j) gg[j] = *(const f32x4*)(g + j * 256 + lane * 4);
    for (int blk = F.bid; blk < RALL / PBLK; blk += F.G) {
        int curm = -1; f32x4 G2[4], SH[4];
#pragma unroll 1
        for (int i = F.wave * 2; i < PBLK; i += 16) {
            const int row0 = blk * PBLK + i;
            f32x4 v[2][4]; int mr[2];
#pragma unroll
            for (int u = 0; u < 2; ++u) { const int row = row0 + u; const int b = row / RB, p = row % RB;
                const float* src = p < CL ? ctx + ((size_t)b * CL + p) * DM : x + ((size_t)b * SEQ + (p - CL)) * DM;
                mr[u] = p < CL ? 32 : b;
#pragma unroll
                for (int j = 0; j < 4; ++j) v[u][j] = *(const f32x4*)(src + j * 256 + lane * 4); }
#pragma unroll
            for (int u = 0; u < 2; ++u) {
                if (mr[u] != curm) { curm = mr[u]; const float* mp = mod + (size_t)curm * NMOD;
#pragma unroll
                    for (int j = 0; j < 4; ++j) { const int c0 = j * 256 + lane * 4; const f32x4 sc = *(const f32x4*)(mp + 1024 + c0); SH[j] = *(const f32x4*)(mp + c0); G2[j] = gg[j] * (sc + 1.f); } }
                float ss = 0.f;
#pragma unroll
                for (int j = 0; j < 4; ++j) ss += v[u][j].x * v[u][j].x + v[u][j].y * v[u][j].y + v[u][j].z * v[u][j].z + v[u][j].w * v[u][j].w;
                const float rstd = rsqrtf(wave_sum(ss) * (1.f / DM) + EPS);
#pragma unroll
                for (int j = 0; j < 4; ++j) {
                    const int c0 = j * 256 + lane * 4;
                    f16x4 o;
                    o.x = (f16)(v[u][j].x * rstd * G2[j].x + SH[j].x); o.y = (f16)(v[u][j].y * rstd * G2[j].y + SH[j].y);
                    o.z = (f16)(v[u][j].z * rstd * G2[j].z + SH[j].z); o.w = (f16)(v[u][j].w * rstd * G2[j].w + SH[j].w);
                    *(f16x4*)(hall + (size_t)(row0 + u) * DM + c0) = o;
                }
            }
        }
    }
}


namespace pg8 {
typedef int v8i __attribute__((ext_vector_type(8)));
typedef unsigned u32x4v __attribute__((ext_vector_type(4)));
constexpr int BM = 256, BK = 64, HALF = 128, HTB = HALF * BK * 2  , STAGE_BYTES = 8 * HTB;
DEV int lds_byte(int r, int c) { const int st = (r >> 4) * 2 + (c >> 5), rr = r & 15, cc = c & 31, ob = rr * 64 + cc * 2; return st * 1024 + (ob ^ (((ob >> 9) & 1) << 5)); }
DEV void stage_rc(int b, int& R, int& C) { const int st = b / 1024, sb = b % 1024, swz = sb ^ (((sb >> 9) & 1) << 5); R = (st >> 1) * 16 + swz / 64; C = (st & 1) * 32 + (swz % 64) / 2; }
struct GUnit { const char* A; const char* B; int pm, pn, aux; };
DEV void glds16s(const char* sbase, unsigned voff, unsigned lds_dst) { unsigned keep;
    asm volatile("s_mov_b32 %0, m0\n\ts_mov_b32 m0, %3\n\ts_nop 0\n\tglobal_load_lds_dwordx4 %1, %2\n\ts_mov_b32 m0, %0" : "=&s"(keep) : "v"(voff), "s"(sbase), "s"(lds_dst) : "memory"); }
DEV void stage2(LAS unsigned char* lds, unsigned bufoff, const char* base, unsigned o0, unsigned o1) {
    const unsigned d = (unsigned)__builtin_amdgcn_readfirstlane((int)((unsigned)(uintptr_t)lds + bufoff));
    glds16s(base, o0, d); glds16s(base, o1, d + 8192u);
}
template <class Epi, class Sched, bool GATHER, bool FP8 = false, bool ARES = false>
DEV void gemm_phase(LAS unsigned char* lds, const int PB, const Sched& S, const Epi& E, const int* tok, const char* Ag, const unsigned* rowarg, const int scaleW = 0x7F7F7F7F, const int scaleA = 0x7F7F7F7F) {
    const int tid = threadIdx.x, wid = __builtin_amdgcn_readfirstlane(tid >> 6), lane = tid & 63, wr = wid >> 2, wc = wid & 3, fr = lane & 15, fq = lane >> 4;
    const int nt = PB / 128;
    unsigned voff[2]; int sR[2]; unsigned sC2[2];
#pragma unroll
    for (int i = 0; i < 2; ++i) { int R, C; stage_rc(tid * 16 + i * 8192, R, C); sR[i] = R; sC2[i] = (unsigned)C * 2u; voff[i] = (unsigned)(R * PB) + (unsigned)C * 2u; }
    const size_t kstep = (size_t)(BK * 2), hstep = (size_t)HALF * PB;
    const unsigned ldsw = (unsigned)wid * 1024u;
    const int aoff = FP8 ? lds_byte(wr * 64 + fr, fq * 16) : lds_byte(wr * 64 + fr, fq * 8), boff = FP8 ? lds_byte(wc * 32 + fr, fq * 16) : lds_byte(wc * 32 + fr, fq * 8);
#define PG8_SA(b, h) (((b) * 2 + (h)) * HTB)
#define PG8_SB(b, h) ((4 + (b) * 2 + (h)) * HTB)
#define PG8_STB(bufoff, gbase) stage2(lds, (bufoff) + ldsw, (gbase), voff[0], voff[1])
#define PG8_STA(bufoff, dbase, gko, g0, g1) do { if (GATHER) stage2(lds, (bufoff) + ldsw, Ag + (gko), (g0), (g1)); else stage2(lds, (bufoff) + ldsw, (dbase), voff[0], voff[1]); } while (0)
#define PG8_LDA(dst, b, h) do { if constexpr (FP8) { _Pragma("unroll") for (int m = 0; m < 4; ++m) { const u32x4v lo_ = *(const LAS u32x4v*)(lds + PG8_SA(b, h) + aoff + m * 2048), hi_ = *(const LAS u32x4v*)(lds + PG8_SA(b, h) + aoff + m * 2048 + 16); \
            dst##8[m] = (v8i){(int)lo_.x, (int)lo_.y, (int)lo_.z, (int)lo_.w, (int)hi_.x, (int)hi_.y, (int)hi_.z, (int)hi_.w}; } } \
        else { _Pragma("unroll") for (int m = 0; m < 4; ++m) _Pragma("unroll") for (int k = 0; k < 2; ++k) dst[m][k] = *(const LAS f16x8*)(lds + PG8_SA(b, h) + aoff + m * 2048 + k * 1024); } } while (0)
#define PG8_LDB(dst, b, h) do { if constexpr (FP8) { _Pragma("unroll") for (int n = 0; n < 2; ++n) { const u32x4v lo_ = *(const LAS u32x4v*)(lds + PG8_SB(b, h) + boff + n * 2048), hi_ = *(const LAS u32x4v*)(lds + PG8_SB(b, h) + boff + n * 2048 + 16); \
            dst##8[n] = (v8i){(int)lo_.x, (int)lo_.y, (int)lo_.z, (int)lo_.w, (int)hi_.x, (int)hi_.y, (int)hi_.z, (int)hi_.w}; } } \
        else { _Pragma("unroll") for (int n = 0; n < 2; ++n) _Pragma("unroll") for (int k = 0; k < 2; ++k) dst[n][k] = *(const LAS f16x8*)(lds + PG8_SB(b, h) + boff + n * 2048 + k * 1024); } } while (0)
#define PG8_MMA(ai, bj, At, Bt, Z) do { __builtin_amdgcn_s_setprio(1); if constexpr (FP8) { _Pragma("unroll") for (int m = 0; m < 4; ++m) _Pragma("unroll") for (int n = 0; n < 2; ++n) { \
            if (Z) asm volatile("v_mfma_scale_f32_16x16x128_f8f6f4 %0, %1, %2, 0, %3, %4 op_sel_hi:[0,0,0]" : "=&v"(acc[ai][bj][m][n]) : "v"(Bt##8[n]), "v"(At##8[m]), "v"(scaleW), "v"(scaleA)); \
            else asm volatile("v_mfma_scale_f32_16x16x128_f8f6f4 %0, %1, %2, %0, %3, %4 op_sel_hi:[0,0,0]" : "+v"(acc[ai][bj][m][n]) : "v"(Bt##8[n]), "v"(At##8[m]), "v"(scaleW), "v"(scaleA)); } } \
        else { _Pragma("unroll") for (int m = 0; m < 4; ++m) _Pragma("unroll") for (int n = 0; n < 2; ++n) { \
            acc[ai][bj][m][n] = __builtin_amdgcn_mfma_f32_16x16x32_f16(Bt[n][0], At[m][0], (Z) ? (f32x4){0.f, 0.f, 0.f, 0.f} : acc[ai][bj][m][n], 0, 0, 0); \
            acc[ai][bj][m][n] = __builtin_amdgcn_mfma_f32_16x16x32_f16(Bt[n][1], At[m][1], acc[ai][bj][m][n], 0, 0, 0); } } __builtin_amdgcn_s_setprio(0); } while (0)
#define PG8_WAIT_V(n) asm volatile("s_waitcnt vmcnt(" #n ")" ::: "memory")
#define PG8_WAIT_L(n) asm volatile("s_waitcnt lgkmcnt(" #n ")" ::: "memory")
#define PG8_BAR __builtin_amdgcn_s_barrier()
#define PG8_SCHED __builtin_amdgcn_sched_barrier(0)
    LAS unsigned* const sideR = (LAS unsigned*)(lds + STAGE_BYTES), * const sideE = (LAS unsigned*)(lds + STAGE_BYTES + 2048), * const sideT = (LAS unsigned*)(lds + STAGE_BYTES + 2560);
    GUnit cur, nxt, nn; int ui = 0; bool sc = false;
    if (!S.next(0, cur)) return;
    if constexpr (Sched::HAS_E) cur.B = S.bptr(cur, __builtin_amdgcn_readfirstlane(*S.eptr(cur)));
    unsigned cg0[2] = {0, 0}, cg1[2] = {0, 0}, ng0[2] = {0, 0}, ng1[2] = {0, 0};
    if (GATHER) {
#pragma unroll
        for (int i = 0; i < 2; ++i) { cg0[i] = (unsigned)tok[cur.pm * 256 + sR[i]] * (unsigned)PB + sC2[i]; cg1[i] = (unsigned)tok[cur.pm * 256 + 128 + sR[i]] * (unsigned)PB + sC2[i]; }
    }
#define PG8_SIDE_NEXT(u_, slot_) do { \
        if (Sched::HAS_E && wid == 4) __builtin_amdgcn_global_load_lds((const unsigned*)S.eptr(u_), sideE + (slot_) * 64, 4, 0, 0); \
        if (GATHER && wid >= 4) __builtin_amdgcn_global_load_lds((const unsigned*)tok + (u_).pm * 256 + (wid - 4) * 64 + lane, sideT + (slot_) * 256 + (wid - 4) * 64, 4, 0, 0); } while (0)
    if ((Sched::HAS_E || GATHER) && S.next(1, nxt)) PG8_SIDE_NEXT(nxt, 1);
    f32x4 acc[2][2][4][2];
    f16x8 At[4][2], B0[2][2], B1[2][2]; v8i At8[4], B08[2], B18[2];
    const char* cA = cur.A; const char* cB = cur.B;
    PG8_STB(PG8_SB(0, 0), cB); PG8_STB(PG8_SB(0, 1), cB + hstep); PG8_STA(PG8_SA(0, 0), cA, 0, cg0[0], cg0[1]); PG8_STA(PG8_SA(0, 1), cA + hstep, 0, cg1[0], cg1[1]);
    if (wr == 1) PG8_BAR;
    PG8_WAIT_V(2); PG8_BAR;
    PG8_STB(PG8_SB(1, 0), cB + kstep); PG8_STA(PG8_SA(1, 0), cA + kstep, kstep, cg0[0], cg0[1]); PG8_STB(PG8_SB(1, 1), cB + hstep + kstep);
    PG8_WAIT_V(0); PG8_BAR;
    for (;;) {
        const bool has_next = S.next(ui + 1, nxt);
        if (has_next) {
            if constexpr (Sched::HAS_E) nxt.B = S.bptr(nxt, __builtin_amdgcn_readfirstlane((int)sideE[((ui + 1) & 1) * 64]));
            if (GATHER) {
#pragma unroll
                for (int i = 0; i < 2; ++i) { ng0[i] = sideT[((ui + 1) & 1) * 256 + sR[i]] * (unsigned)PB + sC2[i]; ng1[i] = sideT[((ui + 1) & 1) * 256 + 128 + sR[i]] * (unsigned)PB + sC2[i]; }
            }
        } else { ng0[0] = cg0[0]; ng0[1] = cg0[1]; ng1[0] = cg1[0]; ng1[1] = cg1[1]; }
        if (rowarg != nullptr && wid < 4) __builtin_amdgcn_global_load_lds(rowarg + cur.pm * 256 + wid * 64 + lane, sideR + (ui & 1) * 256 + wid * 64, 4, 0, 0);
        if ((Sched::HAS_E || GATHER) && has_next && S.next(ui + 2, nn)) PG8_SIDE_NEXT(nn, ui & 1);
        const char* nA = has_next ? nxt.A : cA; const char* nB = has_next ? nxt.B : cB;
        const bool sn = ARES && has_next && nxt.pm == cur.pm;
#define PG8_ITER(FIRST) do { \
            const bool last = (t == nt - 2); \
            const size_t ko1 = (size_t)(t + 1) * kstep, ko2 = last ? 0 : (size_t)(t + 2) * kstep, ko3 = ko2 + kstep; \
            const char* a1 = cA + ko1; \
            const char* a2 = (last ? nA : cA) + ko2; const char* b2 = (last ? nB : cB) + ko2; \
            const char* a3 = a2 + kstep; const char* b3 = b2 + kstep; \
            const unsigned g20 = last ? ng0[0] : cg0[0], g21 = last ? ng0[1] : cg0[1], h20 = last ? ng1[0] : cg1[0], h21 = last ? ng1[1] : cg1[1]; \
              \
            PG8_LDB(B0, 0, 0); PG8_LDB(B1, 0, 1); PG8_SCHED; PG8_LDA(At, 0, 0); if (!(ARES && sc)) PG8_STA(PG8_SA(1, 1), a1 + hstep, ko1, cg1[0], cg1[1]); \
            if (!(FIRST)) PG8_WAIT_V(8); PG8_WAIT_L(0); PG8_BAR; PG8_MMA(0, 0, At, B0, FIRST); PG8_MMA(0, 1, At, B1, FIRST); PG8_BAR; PG8_SCHED; \
              \
            PG8_LDA(At, 0, 1); PG8_STB(PG8_SB(0, 0), b2); PG8_STB(PG8_SB(0, 1), b2 + hstep); if (!(ARES && sn)) PG8_STA(PG8_SA(0, 0), a2, ko2, g20, g21); \
            if (!(FIRST)) PG8_WAIT_V(8); PG8_WAIT_L(0); PG8_BAR; PG8_MMA(1, 0, At, B0, FIRST); PG8_MMA(1, 1, At, B1, FIRST); PG8_BAR; PG8_SCHED; \
              \
            PG8_LDB(B0, 1, 0); PG8_LDB(B1, 1, 1); PG8_SCHED; PG8_LDA(At, 1, 0); if (!(ARES && sn)) PG8_STA(PG8_SA(0, 1), a2 + hstep, ko2, h20, h21); \
            if (ARES && sn) PG8_WAIT_V(4); else PG8_WAIT_V(8); PG8_WAIT_L(0); PG8_BAR; PG8_MMA(0, 0, At, B0, 0); PG8_MMA(0, 1, At, B1, 0); PG8_BAR; PG8_SCHED; \
              \
            PG8_LDA(At, 1, 1); PG8_STB(PG8_SB(1, 0), b3); PG8_STB(PG8_SB(1, 1), b3 + hstep); if (!(ARES && sn)) PG8_STA(PG8_SA(1, 0), a3, ko3, g20, g21); \
            if (ARES && sn) PG8_WAIT_V(4); else PG8_WAIT_V(8); PG8_WAIT_L(0); PG8_BAR; PG8_MMA(1, 0, At, B0, 0); PG8_MMA(1, 1, At, B1, 0); PG8_BAR; PG8_SCHED; \
        } while (0)
        { const int t = 0; PG8_ITER(1); }
#pragma unroll 1
        for (int t = 2; t < nt; t += 2) PG8_ITER(0);
        if constexpr (FP8) {
#pragma unroll
            for (int a_ = 0; a_ < 2; ++a_)
#pragma unroll
                for (int b_ = 0; b_ < 2; ++b_)
                    asm volatile("s_nop 15\n\ts_nop 7" : "+v"(acc[a_][b_][0][0]), "+v"(acc[a_][b_][0][1]), "+v"(acc[a_][b_][1][0]), "+v"(acc[a_][b_][1][1]), "+v"(acc[a_][b_][2][0]), "+v"(acc[a_][b_][2][1]), "+v"(acc[a_][b_][3][0]), "+v"(acc[a_][b_][3][1]));
        }
        PG8_WAIT_V(0);
        if (wr == 0) PG8_BAR;
        { int fr_e = fr, fq_e = fq; asm volatile("" : "+v"(fr_e), "+v"(fq_e));
          E(acc, cur, wr, wc, fr_e, fq_e, (const LAS unsigned*)(sideR + (ui & 1) * 256)); }
        if (!has_next) break;
        cur = nxt; cA = nA; cB = nB; ++ui; sc = sn;
        cg0[0] = ng0[0]; cg0[1] = ng0[1]; cg1[0] = ng1[0]; cg1[1] = ng1[1];
        if (wr == 1) PG8_BAR;
    }
    PG8_WAIT_V(0);
    PG8_BAR;
#undef PG8_SA
#undef PG8_SB
#undef PG8_STB
#undef PG8_STA
#undef PG8_LDA
#undef PG8_LDB
#undef PG8_MMA
#undef PG8_ITER
#undef PG8_SIDE_NEXT
#undef PG8_WAIT_V
#undef PG8_WAIT_L
#undef PG8_BAR
#undef PG8_SCHED
}

DEV void swap16(unsigned& a, unsigned& b) { const auto r = __builtin_amdgcn_permlane16_swap(a, b, false, false); a = r[0]; b = r[1]; }
DEV void swap32(unsigned& a, unsigned& b) { const auto r = __builtin_amdgcn_permlane32_swap(a, b, false, false); a = r[0]; b = r[1]; }
typedef _Float16 f16x2v __attribute__((ext_vector_type(2)));
DEV unsigned pkh(float a, float b) { f16x2v t; t.x = (f16)a; t.y = (f16)b; return __builtin_bit_cast(unsigned, t); }
DEV unsigned pkb(float a, float b) { typedef __bf16 bfx2 __attribute__((ext_vector_type(2))); typedef float fx2 __attribute__((ext_vector_type(2))); const fx2 v = {a, b}; return __builtin_bit_cast(unsigned, __builtin_convertvector(v, bfx2)); }
DEV void store_pair16b(f16* rowbase, const f32x4 v0, const f32x4 v1, int fq) {
    unsigned al = pkb(v0.x, v0.y), ah = pkb(v0.z, v0.w), bl = pkb(v1.x, v1.y), bh = pkb(v1.z, v1.w);
    swap16(al, bl); swap16(ah, bh);
    const int co = (fq & 1) ? 16 + 4 * (fq - 1) : 4 * fq;
    *(uint4*)(rowbase + co) = make_uint4(al, ah, bl, bh);
}
DEV void store_pair16(f16* rowbase, const f32x4 v0, const f32x4 v1, int fq) {
    unsigned al = pkh(v0.x, v0.y), ah = pkh(v0.z, v0.w), bl = pkh(v1.x, v1.y), bh = pkh(v1.z, v1.w);
    swap16(al, bl); swap16(ah, bh);
    const int co = (fq & 1) ? 16 + 4 * (fq - 1) : 4 * fq;
    *(uint4*)(rowbase + co) = make_uint4(al, ah, bl, bh);
}
struct EpiPlain {
    f16* O; int ldc;
    DEV void operator()(const f32x4 (&acc)[2][2][4][2], const GUnit& u, int wr, int wc, int fr, int fq, const LAS unsigned* side) const {
#pragma unroll
        for (int ai = 0; ai < 2; ++ai)
#pragma unroll
            for (int m = 0; m < 4; ++m) { f16* rowp = O + (size_t)(u.pm * BM + ai * HALF + wr * 64 + m * 16 + fr) * ldc + u.pn * BM + wc * 32;
#pragma unroll
                for (int bj = 0; bj < 2; ++bj) store_pair16(rowp + bj * HALF, acc[ai][bj][m][0], acc[ai][bj][m][1], fq); }
    }
};
struct EpiInProj {
    f16* O; const float* qg; const float* kg; const float* rope;
    DEV void operator()(f32x4 (&acc)[2][2][4][2], const GUnit& u, int wr, int wc, int fr, int fq, const LAS unsigned* side) const {
        const int pn = u.pn, seg = u.pm % 9; const bool latent = seg > 0;
        const bool isq = (pn < 2) || (pn == 6) || (pn == 7);
        const bool isk = (pn == 2) || (pn == 3) || (pn == 8 && wc < 2);
        const bool norm = (pn == 6) || (pn == 7) || (pn == 8 && wc < 2);
        const bool isv = (pn == 4) || (pn == 5) || (pn == 8 && wc >= 2);
        if (norm) {
            const float* g = isq ? qg : kg;
            f32x4 gv[2][2];
#pragma unroll
            for (int bj = 0; bj < 2; ++bj)
#pragma unroll
                for (int n = 0; n < 2; ++n) gv[bj][n] = *(const f32x4*)(g + 32 * bj + 16 * n + 4 * fq);
#pragma unroll
            for (int ai = 0; ai < 2; ++ai)
#pragma unroll
                for (int m = 0; m < 4; ++m) {
                    float ss = 0.f;
#pragma unroll
                    for (int bj = 0; bj < 2; ++bj)
#pragma unroll
                        for (int n = 0; n < 2; ++n) { const f32x4 v = acc[ai][bj][m][n]; ss += v.x * v.x + v.y * v.y + v.z * v.z + v.w * v.w; }
                    ss += __shfl_xor(ss, 16); ss += __shfl_xor(ss, 32);
                    const float rstd = rsqrtf(ss * (1.f / 64.f) + EPS);
#pragma unroll
                    for (int bj = 0; bj < 2; ++bj)
#pragma unroll
                        for (int n = 0; n < 2; ++n) acc[ai][bj][m][n] = acc[ai][bj][m][n] * rstd * gv[bj][n];
                }
        }
        if ((isq || isk) && latent) {
            const int s0 = (seg - 1) * 256;
#pragma unroll
            for (int ai = 0; ai < 2; ++ai) {
                const int prow = (s0 + ai * HALF + wr * 64) >> 6;
                const f32x4 r0 = *(const f32x4*)(rope + (prow * 16 + 4 * fq) * 2), r1 = *(const f32x4*)(rope + (prow * 16 + 4 * fq) * 2 + 4);
                const float rc[4] = {r0.x, r0.z, r1.x, r1.z}, rs[4] = {r0.y, r0.w, r1.y, r1.w};
#pragma unroll
                for (int m = 0; m < 4; ++m) {
                    const int pcol = m * 16 + fr;
                    const f32x4 c0 = *(const f32x4*)(rope + (pcol * 16 + 4 * fq) * 2), c1 = *(const f32x4*)(rope + (pcol * 16 + 4 * fq) * 2 + 4);
                    const float cc[4] = {c0.x, c0.z, c1.x, c1.z}, cs[4] = {c0.y, c0.w, c1.y, c1.w};
#pragma unroll
                    for (int q = 0; q < 4; ++q) {
                        const float a = acc[ai][0][m][0][q], b = acc[ai][0][m][1][q]; acc[ai][0][m][0][q] = a * rc[q] - b * rs[q]; acc[ai][0][m][1][q] = a * rs[q] + b * rc[q];
                        const float a2 = acc[ai][1][m][0][q], b2 = acc[ai][1][m][1][q]; acc[ai][1][m][0][q] = a2 * cc[q] - b2 * cs[q]; acc[ai][1][m][1][q] = a2 * cs[q] + b2 * cc[q];
                    }
                }
            }
        }
        const float sc = isq ? QSCALE : 1.f;
#pragma unroll
        for (int ai = 0; ai < 2; ++ai)
#pragma unroll
            for (int m = 0; m < 4; ++m) { f16* rowp = O + (size_t)(u.pm * BM + ai * HALF + wr * 64 + m * 16 + fr) * NIN + pn * BM + wc * 64;
#pragma unroll
                for (int bj = 0; bj < 2; ++bj) { if (isv) store_pair16b(rowp + bj * 32, acc[ai][bj][m][0], acc[ai][bj][m][1], fq); else store_pair16(rowp + bj * 32, acc[ai][bj][m][0] * sc, acc[ai][bj][m][1] * sc, fq); } }
    }
};
struct EpiGU {
    unsigned char* H; const float* wsl;
    DEV void operator()(const f32x4 (&acc)[2][2][4][2], const GUnit& u, int wr, int wc, int fr, int fq, const LAS unsigned* side) const {
#pragma unroll
        for (int ai = 0; ai < 2; ++ai)
#pragma unroll
            for (int m = 0; m < 4; ++m) { const int rl = ai * HALF + wr * 64 + m * 16 + fr, row = u.pm * BM + rl; const float w = __builtin_bit_cast(float, side[rl]) * 4.0f; unsigned char* rowp = H + (size_t)row * EH + u.pn * 128 + wc * 32;
                unsigned d[2];
#pragma unroll
                for (int n = 0; n < 2; ++n) { const f32x4 g = acc[ai][0][m][n], up = acc[ai][1][m][n];
                    int q = __builtin_amdgcn_cvt_pk_fp8_f32(c8(silu_f(g.x) * up.x * w), c8(silu_f(g.y) * up.y * w), 0, false); q = __builtin_amdgcn_cvt_pk_fp8_f32(c8(silu_f(g.z) * up.z * w), c8(silu_f(g.w) * up.w * w), q, true); d[n] = (unsigned)q; }
                swap16(d[0], d[1]);
                const int co = (fq & 1) ? 16 + 4 * (fq - 1) : 4 * fq;
                *(uint2*)(rowp + co) = make_uint2(d[0], d[1]); }
    }
};
struct EpiDown {
    unsigned char* Y; const int* pair;
    DEV void operator()(const f32x4 (&acc)[2][2][4][2], const GUnit& u, int wr, int wc, int fr, int fq, const LAS unsigned* side) const {
#pragma unroll
        for (int ai = 0; ai < 2; ++ai)
#pragma unroll
            for (int m = 0; m < 4; ++m) { const int pr = (int)side[ai * HALF + wr * 64 + m * 16 + fr];
                unsigned d[4];
#pragma unroll
                for (int bj = 0; bj < 2; ++bj)
#pragma unroll
                    for (int n = 0; n < 2; ++n) { const f32x4 v = acc[ai][bj][m][n]; int w = __builtin_amdgcn_cvt_pk_fp8_f32(c8(v.x), c8(v.y), 0, false); w = __builtin_amdgcn_cvt_pk_fp8_f32(c8(v.z), c8(v.w), w, true); d[bj * 2 + n] = (unsigned)w; }
                swap32(d[0], d[2]); swap32(d[1], d[3]); swap16(d[0], d[1]); swap16(d[2], d[3]);
                if (pr >= 0) *(uint4*)(Y + (size_t)pr * DM + u.pn * BM + wc * 64 + 16 * fq) = make_uint4(d[0], d[1], d[2], d[3]); }
    }
};
struct SchedInProj {
    const char* A; const char* B; int v, G;
    static constexpr bool HAS_E = false;
    DEV bool next(int i, GUnit& u) const {
        const int L = i * G + v; if (L >= 2304 + 160) return false;
        if (L < 2304) { const int pl = L / 9; u.pn = L % 9; u.pm = (pl >> 3) * 9 + 1 + (pl & 7); }
        else { const int Lc = L - 2304, q = Lc % 5; u.pm = (Lc / 5) * 9; u.pn = q < 4 ? 2 + q : 8; }
        u.A = A + (size_t)u.pm * 256 * DM * 2; u.B = B + (size_t)u.pn * 256 * DM * 2; u.aux = 0; return true;
    }
    DEV const int* eptr(const GUnit&) const { return nullptr; }
    DEV const char* bptr(const GUnit& u, int) const { return u.B; }
};
struct SchedDense {
    const char* A; const char* B; int v, G, nunits, ntn, K;
    static constexpr bool HAS_E = false;
    DEV bool next(int i, GUnit& u) const {
        const int L = i * G + v; if (L >= nunits) return false;
        u.pm = L / ntn; u.pn = L % ntn; u.A = A + (size_t)u.pm * 256 * K * 2; u.B = B + (size_t)u.pn * 256 * K * 2; u.aux = 0; return true;
    }
    DEV const int* eptr(const GUnit&) const { return nullptr; }
    DEV const char* bptr(const GUnit& u, int) const { return u.B; }
};
struct SchedGrouped {
    const char* A; const char* B; const int* blke; int v, G, nunits, ntn, K; size_t estride; int seq;
    static constexpr bool HAS_E = true;
    DEV bool next(int i, GUnit& u) const {
        if (seq) {
            const int nb = nunits / ntn, rf = nb / G, nf = rf * ntn;
            if (i < nf) { u.pm = (i / ntn) * G + v; u.pn = i % ntn; }
            else { const int L = (i - nf) * G + v; if (L >= (nb - rf * G) * ntn) return false; u.pm = rf * G + L / ntn; u.pn = L % ntn; }
        } else { const int L = i * G + v; if (L >= nunits) return false; u.pm = L / ntn; u.pn = L % ntn; }
        u.aux = 0; u.A = A + (size_t)u.pm * 256 * K * 2; u.B = nullptr; return true;
    }
    DEV const int* eptr(const GUnit& u) const { return blke + u.pm; }
    DEV const char* bptr(const GUnit& u, int e) const { return B + (size_t)e * estride + (size_t)u.pn * 256 * K * 2; }
};
}

namespace attn_body {
using bf16=_Float16;
using bf16x8=__attribute__((ext_vector_type(8)))short;
using s16x4=__attribute__((ext_vector_type(4)))short;
using f32x16=__attribute__((ext_vector_type(16)))float;
using u32x4=__attribute__((ext_vector_type(4)))unsigned;
using h16x8=__attribute__((ext_vector_type(8)))_Float16;
__device__ __forceinline__ f32x16 mf16(bf16x8 a,bf16x8 b,f32x16 c,int,int,int){return __builtin_amdgcn_mfma_f32_32x32x16_f16(__builtin_bit_cast(h16x8,a),__builtin_bit_cast(h16x8,b),c,0,0,0);}
constexpr int D=64,DM=2304;
constexpr int NW=8,QBLK=32,QB=QBLK*NW,KVBLK=64;
__device__ __forceinline__ int crow(int r,int hi){return (r&3)+8*(r>>2)+4*hi;}
#define SBAR() __builtin_amdgcn_sched_barrier(0)
__device__ __forceinline__ void cmask(f32x16&p0,f32x16&p1,int jb,int qrel,int hi){
  const float NEG=-INFINITY; int kb=64*jb+4*hi;
  #pragma unroll
  for(int r=0;r<16;++r){int kv=kb+(r&3)+8*(r>>2); if(kv>qrel)p0[r]=NEG; if(kv+32>qrel)p1[r]=NEG;}
}

constexpr int NSLOT=3, SLOTB=8192;
constexpr int LDS_K=0, LDS_V=NSLOT*SLOTB, LDS_WS=2*NSLOT*SLOTB, LDS_OST=LDS_WS+NW*64*4, LDS_BYTES=LDS_OST+NW*4096;
constexpr float C2=0.125f*1.4426950408889634f;
__device__ __forceinline__ void glds16(const void*gsrc,unsigned lds_dst){unsigned keep;
  asm volatile("s_mov_b32 %0, m0\n\ts_mov_b32 m0, %2\n\ts_nop 0\n\tglobal_load_lds_dwordx4 %1, off\n\ts_mov_b32 m0, %0":"=&s"(keep):"v"(gsrc),"s"(lds_dst):"memory");}
__device__ __forceinline__ float max3f(float a,float b,float c){float r;asm("v_max3_f32 %0, %1, %2, %3":"=v"(r):"v"(a),"v"(b),"v"(c));return r;}
__device__ __forceinline__ float max2f(float a,float b){float r;asm("v_max_f32_e32 %0, %1, %2":"=v"(r):"v"(a),"v"(b));return r;}
__device__ __forceinline__ float fadd_s(float a,float b){float r;asm("v_add_f32_e32 %0, %1, %2":"=v"(r):"v"(a),"v"(b));return r;}
__device__ __forceinline__ float fsub_s(float a,float b){float r;asm("v_sub_f32_e32 %0, %1, %2":"=v"(r):"v"(a),"v"(b));return r;}
typedef float f32x2_t __attribute__((ext_vector_type(2))); typedef _Float16 bf16x2_t __attribute__((ext_vector_type(2)));
__device__ __forceinline__ unsigned cvtpk_s(float lo,float hi){f32x2_t v={lo,hi};bf16x2_t b=__builtin_convertvector(v,bf16x2_t);return __builtin_bit_cast(unsigned,b);}
typedef __bf16 rbf16x2_t __attribute__((ext_vector_type(2))); typedef __bf16 rbf16x8_t __attribute__((ext_vector_type(8)));
__device__ __forceinline__ unsigned cvtpk_b(float lo,float hi){f32x2_t v={lo,hi};rbf16x2_t b=__builtin_convertvector(v,rbf16x2_t);return __builtin_bit_cast(unsigned,b);}
__device__ __forceinline__ f32x16 mfb16(bf16x8 a,bf16x8 b,f32x16 c,int,int,int){return __builtin_amdgcn_mfma_f32_32x32x16_bf16(__builtin_bit_cast(rbf16x8_t,a),__builtin_bit_cast(rbf16x8_t,b),c,0,0,0);}
#define WAIT_BAR(N) asm volatile("s_waitcnt vmcnt(" #N ") lgkmcnt(0)\n\ts_barrier":::"memory")

__device__ __forceinline__ void qkt(f32x16&p0,f32x16&p1,const char*Kslot,const bf16x8*qr,const f32x16&negm,int r32,int hi){
  const char*kb=Kslot+hi*1024+r32*16;
  #pragma unroll
  for(int d0=0;d0<4;++d0){
    const bf16x8 b0=*reinterpret_cast<const bf16x8*>(kb+d0*2048);
    const bf16x8 b1=*reinterpret_cast<const bf16x8*>(kb+d0*2048+512);
    if(d0==0){p0=mf16(b0,qr[0],negm,0,0,0);p1=mf16(b1,qr[0],negm,0,0,0);}
    else{p0=mf16(b0,qr[d0],p0,0,0,0);p1=mf16(b1,qr[d0],p1,0,0,0);}}
}
typedef __attribute__((address_space(3))) const char* lds_cptr;
typedef short v4i16_t __attribute__((ext_vector_type(4)));
__device__ __forceinline__ void kload8(bf16x8*kf,lds_cptr kp){
  kf[0]=*(const __attribute__((address_space(3))) bf16x8*)(kp);      kf[1]=*(const __attribute__((address_space(3))) bf16x8*)(kp+512);
  kf[2]=*(const __attribute__((address_space(3))) bf16x8*)(kp+2048); kf[3]=*(const __attribute__((address_space(3))) bf16x8*)(kp+2560);
  kf[4]=*(const __attribute__((address_space(3))) bf16x8*)(kp+4096); kf[5]=*(const __attribute__((address_space(3))) bf16x8*)(kp+4608);
  kf[6]=*(const __attribute__((address_space(3))) bf16x8*)(kp+6144); kf[7]=*(const __attribute__((address_space(3))) bf16x8*)(kp+6656);
}
__device__ __forceinline__ void kload2(bf16x8*kf,lds_cptr kp,int j){ kf[2*j]=*(const __attribute__((address_space(3))) bf16x8*)(kp+j*2048); kf[2*j+1]=*(const __attribute__((address_space(3))) bf16x8*)(kp+j*2048+512); }
__device__ __forceinline__ s16x4 vtr(lds_cptr p){ return __builtin_bit_cast(s16x4,__builtin_amdgcn_ds_read_tr16_b64_v4i16((__attribute__((address_space(3))) v4i16_t*)p)); }
__device__ __forceinline__ float rowmax(const f32x16&p0,const f32x16&p1){
  float a=max3f(p0[0],p0[1],p1[0]),b=max3f(p0[2],p0[3],p1[1]);a=max3f(a,p1[2],p1[3]);
  #pragma unroll
  for(int r=4;r<16;r+=4){a=max3f(a,p0[r],p0[r+1]);b=max3f(b,p0[r+2],p0[r+3]);a=max3f(a,p1[r],p1[r+1]);b=max3f(b,p1[r+2],p1[r+3]);}
  const float m=max2f(a,b);
  auto rr=__builtin_amdgcn_permlane32_swap(__float_as_uint(m),__float_as_uint(m),false,false);
  return max2f(__uint_as_float(rr[0]),__uint_as_float(rr[1]));
}
__device__ __forceinline__ void pv(f32x16*o,int vb,bf16x8 pa0,bf16x8 pa1,bf16x8 pa2,bf16x8 pa3){
  #pragma unroll
  for(int d0=0;d0<2;++d0){s16x4 lo[4],hi[4];
    #pragma unroll
    for(int ks=0;ks<4;++ks){
      asm volatile("ds_read_b64_tr_b16 %0,%1 offset:%c2":"=&v"(lo[ks]):"v"(vb),"i"(d0*4096+ks*1024):"memory");
      asm volatile("ds_read_b64_tr_b16 %0,%1 offset:%c2":"=&v"(hi[ks]):"v"(vb),"i"(d0*4096+ks*1024+512):"memory");}
    asm volatile("s_waitcnt lgkmcnt(0)":::"memory");SBAR();
    #define PK(k) (bf16x8){lo[k][0],lo[k][1],lo[k][2],lo[k][3],hi[k][0],hi[k][1],hi[k][2],hi[k][3]}
    o[d0]=mfb16(pa0,PK(0),o[d0],0,0,0);
    o[d0]=mfb16(pa1,PK(1),o[d0],0,0,0);
    o[d0]=mfb16(pa2,PK(2),o[d0],0,0,0);
    o[d0]=mfb16(pa3,PK(3),o[d0],0,0,0);
    #undef PK
  }
}

#ifndef ATTN_STORE16
#define ATTN_STORE16(p,v) (*(u32x4*)(p)=(v))
#endif
template<int THRL> __device__ __forceinline__ void attn_unit(const bf16*Qu,const bf16*__restrict__ Kh,const bf16*__restrict__ Vh,bf16*Ou,int opitch,char*shm){
  const int tid=threadIdx.x,lane=tid&63,r32=lane&31,hi=lane>>5; const int wid=__builtin_amdgcn_readfirstlane(tid>>6);
  const bf16*Qw=Qu+(long)(wid*QBLK)*DM;
  const unsigned lds0=(unsigned)(uintptr_t)shm;
  float*wsf=(float*)(shm+LDS_WS)+wid*64;
  const bf16*ksrc=Kh+(long)lane*DM+wid*8;
  const bf16*vsrc=Vh+(long)(16*(wid&3)+(lane>>2))*DM+(wid>>2)*32+(lane&3)*8;
  const unsigned kdst=lds0+LDS_K+wid*1024, vdst=lds0+LDS_V+wid*1024;
  #define DMA_K(t,slot) glds16(ksrc+(long)(t)*KVBLK*DM,(unsigned)__builtin_amdgcn_readfirstlane(kdst+(slot)))
  #define DMA_V(t,slot) glds16(vsrc+(long)(t)*KVBLK*DM,(unsigned)__builtin_amdgcn_readfirstlane(vdst+(slot)))
  const int vb0=(int)(lds0+LDS_V)+((lane>>4)&1)*32+(lane&3)*8+(4*hi+((lane&15)>>2))*64;
  const char*Kbase=shm+LDS_K; bf16x8 kf[8];
  const lds_cptr shm3=(lds_cptr)shm; const lds_cptr kp0=shm3+LDS_K+hi*1024+r32*16; const lds_cptr vp0=shm3+LDS_V+((lane>>4)&1)*32+(lane&3)*8+(4*hi+((lane&15)>>2))*64;
  constexpr int NT=36;
  DMA_K(0,0);DMA_V(0,0);DMA_K(1,SLOTB);
  bf16x8 qr[4];
  #pragma unroll
  for(int d0=0;d0<4;++d0)qr[d0]=*reinterpret_cast<const bf16x8*>(&Qw[(long)r32*DM+d0*16+hi*8]);
  float l_reg=0.f;f32x16 o[2];o[0]=f32x16{};o[1]=f32x16{};
  #define CMASK(P0,P1,t) do{}while(0)
  #define START(P0,P1) do{ _Pragma("unroll") for(int r=0;r<16;++r)P0[r]=__builtin_amdgcn_exp2f(P0[r]); }while(0)
  #define RESC() do{}while(0)
  f32x16 pA0,pA1,pB0,pB1;
  int sl_prev=0,sl_cur=0,sl_next=SLOTB;
  #define ROT() do{sl_prev=sl_cur;sl_cur=sl_next;sl_next=(sl_next==(NSLOT-1)*SLOTB)?0:sl_next+SLOTB;}while(0)
  DMA_K(2,2*SLOTB);
  WAIT_BAR(3);
  qkt(pA0,pA1,Kbase,qr,f32x16{},r32,hi);asm volatile("s_nop 15\n\ts_nop 7":"+v"(pA0),"+v"(pA1));CMASK(pA0,pA1,0);
  START(pA0,pA1);
  _Pragma("unroll") for(int r=0;r<16;++r)pA1[r]=__builtin_amdgcn_exp2f(pA1[r]);
  WAIT_BAR(0);
  DMA_K(3,0);DMA_V(1,SLOTB);
  ROT();
  kload8(kf,kp0+sl_cur);
  WAIT_BAR(2);
  s16x4 vlo[8],vhi[8]; u32x4 pw0,pw1,pw2,pw3;
  #define PKW(P,B) cvtpk_b(P[B],P[B+1])
  #define PAF(k) __builtin_bit_cast(bf16x8,pw##k)
  #define VFR(i) (bf16x8){vlo[i][0],vlo[i][1],vlo[i][2],vlo[i][3],vhi[i][0],vhi[i][1],vhi[i][2],vhi[i][3]}
  #define PIN(x) asm volatile("":"+v"(x))
  #define MX3(a,b,c) __builtin_fmaxf(__builtin_fmaxf((a),(b)),(c))
  #define GAPA(MF,A0,A1,A2,A3,W0,W1,PW) do{ MF; sacc+=A0; sacc+=A1; sacc+=A2; sacc+=A3; PIN(sacc); W0; W1; PIN(PW); SBAR(); }while(0)
  #define EX(v) __builtin_amdgcn_exp2f(v)
  #define GAPB(MF,X,B) do{ MF; X[B]=EX(X[B]); X[B+1]=EX(X[B+1]); X[B+2]=EX(X[B+2]); X[B+3]=EX(X[B+3]); PIN(X); SBAR(); }while(0)
  #define VRD(i) do{ vlo[i]=vtr(vp_+(((i)>>2)*4096+((i)&3)*1024)); vhi[i]=vtr(vp_+(((i)>>2)*4096+((i)&3)*1024+512)); }while(0)
  #define KRD(G,j) do{ if(G){ kload2(kf,kp0+sl_next,j); SBAR(); } }while(0)
  #define STEP(C0,C1,P0,P1,t,GK,GV,GL) do{ SBAR(); \
    const lds_cptr vp_=vp0+sl_prev; \
    VRD(0); SBAR(); float sacc=(P0[0]+P0[1]); \
    GAPA(C0=mf16(kf[0],qr[0],f32x16{},0,0,0), P0[2],P0[3],P0[4],P0[5],     pw0[0]=PKW(P0,0), pw0[1]=PKW(P0,2), pw0); \
    VRD(4); SBAR(); GAPA(C1=mf16(kf[1],qr[0],f32x16{},0,0,0), P0[6],P0[7],P0[8],P0[9],     pw0[2]=PKW(P0,4), pw0[3]=PKW(P0,6), pw0); \
    VRD(1); SBAR(); GAPA(C0=mf16(kf[2],qr[1],C0,0,0,0),   P0[10],P0[11],P0[12],P0[13], pw1[0]=PKW(P0,8), pw1[1]=PKW(P0,10), pw1); \
    VRD(5); SBAR(); GAPA(C1=mf16(kf[3],qr[1],C1,0,0,0),   P0[14],P0[15],P1[0],P1[1],   pw1[2]=PKW(P0,12),pw1[3]=PKW(P0,14), pw1); \
    VRD(2); SBAR(); GAPA(C0=mf16(kf[4],qr[2],C0,0,0,0),   P1[2],P1[3],P1[4],P1[5],     pw2[0]=PKW(P1,0), pw2[1]=PKW(P1,2), pw2); \
    VRD(6); SBAR(); GAPA(C1=mf16(kf[5],qr[2],C1,0,0,0),   P1[6],P1[7],P1[8],P1[9],     pw2[2]=PKW(P1,4), pw2[3]=PKW(P1,6), pw2); \
    VRD(3); SBAR(); GAPA(C0=mf16(kf[6],qr[3],C0,0,0,0),   P1[10],P1[11],P1[12],P1[13], pw3[0]=PKW(P1,8), pw3[1]=PKW(P1,10), pw3); \
    VRD(7); SBAR(); GAPA(C1=mf16(kf[7],qr[3],C1,0,0,0),   P1[14],P1[15],0.f,0.f,       pw3[2]=PKW(P1,12),pw3[3]=PKW(P1,14), pw3); \
    l_reg+=sacc; \
    if(GK){DMA_K((t)+3,sl_cur);} if(GV){DMA_V((t)+1,sl_next);} \
    SBAR(); \
    GAPB(o[0]=mfb16(PAF(0),VFR(0),o[0],0,0,0), C0,0); \
    GAPB(o[1]=mfb16(PAF(0),VFR(4),o[1],0,0,0), C0,4); \
    KRD(GL,0); GAPB(o[0]=mfb16(PAF(1),VFR(1),o[0],0,0,0), C0,8); \
    KRD(GL,1); GAPB(o[1]=mfb16(PAF(1),VFR(5),o[1],0,0,0), C0,12); \
    KRD(GL,2); GAPB(o[0]=mfb16(PAF(2),VFR(2),o[0],0,0,0), C1,0); \
    KRD(GL,3); GAPB(o[1]=mfb16(PAF(2),VFR(6),o[1],0,0,0), C1,4); \
    GAPB(o[0]=mfb16(PAF(3),VFR(3),o[0],0,0,0), C1,8); \
    GAPB(o[1]=mfb16(PAF(3),VFR(7),o[1],0,0,0), C1,12); \
    }while(0)
  int t=1;
  #undef CMASK
  #define CMASK(P0,P1,t) do{}while(0)
  for(;t+5<NT;t+=2){
    STEP(pB0,pB1,pA0,pA1,t,true,true,true);     WAIT_BAR(2); RESC(); ROT();
    STEP(pA0,pA1,pB0,pB1,t+1,true,true,true);   WAIT_BAR(2); RESC(); ROT();
  }
  #undef CMASK
  #define CMASK(P0,P1,t) do{}while(0)
  #define ENDW(tt) do{ if((tt)+3<NT){WAIT_BAR(2);} else if((tt)+2<NT){WAIT_BAR(1);} else {WAIT_BAR(0);} }while(0)
  for(;t+1<NT;t+=2){
    STEP(pB0,pB1,pA0,pA1,t,(t+3<NT),(t+1<NT),(t+1<NT));       ENDW(t);   RESC(); ROT();
    STEP(pA0,pA1,pB0,pB1,t+1,(t+4<NT),(t+2<NT),(t+2<NT));     ENDW(t+1); RESC(); ROT();
  }
  STEP(pB0,pB1,pA0,pA1,NT-1,false,false,false); RESC();
  { float sacc=pB0[0]+pB0[1]; _Pragma("unroll") for(int r=2;r<16;++r)sacc+=pB0[r]; _Pragma("unroll") for(int r=0;r<16;++r)sacc+=pB1[r]; l_reg+=sacc;
    pw0=(u32x4){PKW(pB0,0),PKW(pB0,2),PKW(pB0,4),PKW(pB0,6)};pw1=(u32x4){PKW(pB0,8),PKW(pB0,10),PKW(pB0,12),PKW(pB0,14)};pw2=(u32x4){PKW(pB1,0),PKW(pB1,2),PKW(pB1,4),PKW(pB1,6)};pw3=(u32x4){PKW(pB1,8),PKW(pB1,10),PKW(pB1,12),PKW(pB1,14)};
    SBAR(); pv(o,vb0+sl_cur,PAF(0),PAF(1),PAF(2),PAF(3)); }
  #undef PKW
  #undef PAF
  #undef VFR
  #undef PIN
  #undef MX3
  #undef GAPA
  #undef GAPB
  #undef EX
  #undef VRD
  #undef KRD
  #undef STEP
  #undef ENDW
  {auto rr=__builtin_amdgcn_permlane32_swap(__float_as_uint(l_reg),__float_as_uint(l_reg),false,false);l_reg=__uint_as_float(rr[0])+__uint_as_float(rr[1]);}
  if(hi==0)wsf[32+r32]=l_reg;asm volatile("s_waitcnt lgkmcnt(0)":::"memory");
  float rli[16];
  #pragma unroll
  for(int r=0;r<16;++r)rli[r]=__builtin_amdgcn_rcpf(wsf[32+crow(r,hi)]);
  bf16*Ow=Ou+(long)(wid*QBLK)*opitch;
  { bf16*stg=(bf16*)(shm+LDS_OST)+wid*2048;
    #pragma unroll
    for(int r=0;r<16;++r){const int orow=crow(r,hi);
      #pragma unroll
      for(int d0=0;d0<2;++d0)stg[orow*64+d0*32+r32]=(bf16)(o[d0][r]*rli[r]);}
    asm volatile("s_waitcnt lgkmcnt(0)":::"memory");
    #pragma unroll
    for(int i=0;i<4;++i){const int row=i*8+(lane>>3),ch=lane&7; const u32x4 v=*(const u32x4*)(stg+row*64+ch*8); ATTN_STORE16(Ow+(long)row*opitch+ch*8,v);} }
  asm volatile("s_waitcnt lgkmcnt(0)\n\ts_barrier":::"memory");
  #undef DMA_K
  #undef DMA_V
  #undef CMASK
  #undef START
  #undef RESC
  #undef ROT
}

constexpr int U_SLOTK=8192,U_LDS_K=0,U_LDS_V=3*U_SLOTK,U_LDS_WS=U_LDS_V+3*16384,U_LDS_OST=U_LDS_WS+2048,U_LDS_Q=U_LDS_OST+NW*4096,U_LDS_BYTES=U_LDS_Q+NW*4096;
template<int THRL> __device__ __forceinline__ void attn_unit128(const bf16*Qu,const bf16*__restrict__ Kh,const bf16*__restrict__ Vh,bf16*Ou,int opitch,char*shm){
  const int tid=threadIdx.x,lane=tid&63,r32=lane&31,hi=lane>>5; const int wid=__builtin_amdgcn_readfirstlane(tid>>6);
  const bf16*Qw=Qu+(long)(wid*QBLK)*DM;
  const unsigned lds0=(unsigned)(uintptr_t)shm;
  float*wsf=(float*)(shm+U_LDS_WS)+wid*64;
  const bf16*ksrc=Kh+(long)lane*DM+wid*8;
  const bf16*vsrc=Vh+(long)(16*(wid&3)+(lane>>2))*DM+(wid>>2)*32+(lane&3)*8;
  const unsigned kdst=lds0+U_LDS_K+wid*1024, vdst=lds0+U_LDS_V+wid*1024;
  #define DMA_K(t,slot) glds16(ksrc+(long)(t)*KVBLK*DM,(unsigned)__builtin_amdgcn_readfirstlane(kdst+(slot)))
  #define DMA_V(t,slot) do{ glds16(vsrc+(long)(t)*KVBLK*DM,(unsigned)__builtin_amdgcn_readfirstlane(vdst+2*(slot))); glds16(vsrc+(long)(t)*KVBLK*DM+64,(unsigned)__builtin_amdgcn_readfirstlane(vdst+2*(slot)+8192)); }while(0)
  const int vb0=(int)(lds0+U_LDS_V)+((lane>>4)&1)*32+(lane&3)*8+(4*hi+((lane&15)>>2))*64;
  bf16x8 kf[8];
  const lds_cptr shm3=(lds_cptr)shm; const lds_cptr kp0=shm3+U_LDS_K+hi*1024+r32*16; const lds_cptr vp0=shm3+U_LDS_V+((lane>>4)&1)*32+(lane&3)*8+(4*hi+((lane&15)>>2))*64;
  constexpr int NT=36;
  DMA_K(0,0);DMA_V(0,0);DMA_K(1,U_SLOTK);
  const lds_cptr qp0=shm3+U_LDS_Q+tid*16;
  { bf16x8 qr[4];
    #pragma unroll
    for(int d0=0;d0<4;++d0)qr[d0]=*reinterpret_cast<const bf16x8*>(&Qw[(long)r32*DM+d0*16+hi*8]);
    #pragma unroll
    for(int d0=0;d0<4;++d0)*(__attribute__((address_space(3))) bf16x8*)(qp0+d0*8192)=qr[d0]; }
  #define QF(d0) (*(const __attribute__((address_space(3))) bf16x8*)(qp0+(d0)*8192))
  float l_reg=0.f;f32x16 o[4];o[0]=f32x16{};o[1]=f32x16{};o[2]=f32x16{};o[3]=f32x16{};
  #define RESC() do{}while(0)
  f32x16 pA0,pA1,pB0,pB1;
  int sl_prev=0,sl_cur=0,sl_next=U_SLOTK;
  #define ROT() do{sl_prev=sl_cur;sl_cur=sl_next;sl_next=(sl_next==2*U_SLOTK)?0:sl_next+U_SLOTK;}while(0)
  DMA_K(2,2*U_SLOTK);
  WAIT_BAR(4);
  { kload8(kf,kp0);
    { const bf16x8 q0=QF(0),q1=QF(1),q2=QF(2),q3=QF(3);
    pA0=mf16(kf[0],q0,f32x16{},0,0,0);pA1=mf16(kf[1],q0,f32x16{},0,0,0);pA0=mf16(kf[2],q1,pA0,0,0,0);pA1=mf16(kf[3],q1,pA1,0,0,0);
    pA0=mf16(kf[4],q2,pA0,0,0,0);pA1=mf16(kf[5],q2,pA1,0,0,0);pA0=mf16(kf[6],q3,pA0,0,0,0);pA1=mf16(kf[7],q3,pA1,0,0,0); }
    asm volatile("s_nop 15\n\ts_nop 7":"+v"(pA0),"+v"(pA1));
    _Pragma("unroll") for(int r=0;r<16;++r){pA0[r]=__builtin_amdgcn_exp2f(pA0[r]);pA1[r]=__builtin_amdgcn_exp2f(pA1[r]);} }
  WAIT_BAR(0);
  DMA_K(3,0);DMA_V(1,U_SLOTK);
  ROT();
  kload8(kf,kp0+sl_cur);
  WAIT_BAR(3);
  s16x4 vrl[4],vrh[4]; u32x4 pw0,pw1,pw2,pw3;
  #define PKW(P,B) cvtpk_b(P[B],P[B+1])
  #define PAF(k) __builtin_bit_cast(bf16x8,pw##k)
  #define FID(g) ((((g)&3)<<2)+((g)>>2))
  #define VF(g) (bf16x8){vrl[(g)&3][0],vrl[(g)&3][1],vrl[(g)&3][2],vrl[(g)&3][3],vrh[(g)&3][0],vrh[(g)&3][1],vrh[(g)&3][2],vrh[(g)&3][3]}
  #define VRDR(g) do{ vrl[(g)&3]=vtr(vp_+((FID(g)>>2)*4096+(FID(g)&3)*1024)); vrh[(g)&3]=vtr(vp_+((FID(g)>>2)*4096+(FID(g)&3)*1024+512)); }while(0)
  #define PIN(x) asm volatile("":"+v"(x))
  #define MX3(a,b,c) __builtin_fmaxf(__builtin_fmaxf((a),(b)),(c))
  #define EX(v) __builtin_amdgcn_exp2f(v)
  { float s0=pA0[0]+pA0[1]; _Pragma("unroll") for(int r=2;r<16;++r)s0+=pA0[r]; _Pragma("unroll") for(int r=0;r<16;++r)s0+=pA1[r]; l_reg+=s0;
    pw0=(u32x4){PKW(pA0,0),PKW(pA0,2),PKW(pA0,4),PKW(pA0,6)};pw1=(u32x4){PKW(pA0,8),PKW(pA0,10),PKW(pA0,12),PKW(pA0,14)};pw2=(u32x4){PKW(pA1,0),PKW(pA1,2),PKW(pA1,4),PKW(pA1,6)}; pw3=(u32x4){0u,0u,0u,0u}; }
  #define GAPA(MF,W) do{ MF; W; SBAR(); }while(0)
  #define GAPB(g,KS,X,B,PKSTMT) do{ o[(g)&3]=mfb16(PAF(KS),VF(g),o[(g)&3],0,0,0); if((g)+4<16){VRDR((g)+4);} X[B]=EX(X[B]); X[B+1]=EX(X[B+1]); sacc+=X[B]; sacc+=X[B+1]; PIN(sacc); PKSTMT; PIN(X); SBAR(); }while(0)
  #define KRD(G,j) do{ if(G){ kload2(kf,kp0+sl_next,j); SBAR(); } }while(0)
  #define STEP(C0,C1,P0,P1,t,GK,GV,GL) do{ SBAR(); \
    const lds_cptr vp_=vp0+2*sl_prev; \
    bf16x8 qa=QF(0),qb=QF(1); SBAR(); \
    GAPA(C0=mf16(kf[0],qa,f32x16{},0,0,0), pw3[0]=PKW(P1,8)); \
    GAPA(C1=mf16(kf[1],qa,f32x16{},0,0,0), pw3[1]=PKW(P1,10)); \
    qa=QF(2); SBAR(); \
    GAPA(C0=mf16(kf[2],qb,C0,0,0,0),       pw3[2]=PKW(P1,12)); \
    GAPA(C1=mf16(kf[3],qb,C1,0,0,0),       pw3[3]=PKW(P1,14); PIN(pw3)); \
    qb=QF(3); SBAR(); \
    VRDR(0); SBAR(); GAPA(C0=mf16(kf[4],qa,C0,0,0,0), (void)0); \
    VRDR(1); SBAR(); GAPA(C1=mf16(kf[5],qa,C1,0,0,0), (void)0); \
    VRDR(2); SBAR(); GAPA(C0=mf16(kf[6],qb,C0,0,0,0), (void)0); \
    VRDR(3); SBAR(); GAPA(C1=mf16(kf[7],qb,C1,0,0,0), (void)0); \
    if(GK){DMA_K((t)+3,sl_cur);} if(GV){DMA_V((t)+1,sl_next);} \
    float sacc=0.f; \
    SBAR(); \
    GAPB(0,0,C0,0,(void)0);  GAPB(1,0,C0,2,(void)0);  GAPB(2,0,C0,4,(void)0);  GAPB(3,0,C0,6,(void)0); \
    KRD(GL,0); GAPB(4,1,C0,8,pw0[0]=PKW(C0,0));  KRD(GL,1); GAPB(5,1,C0,10,pw0[1]=PKW(C0,2)); KRD(GL,2); GAPB(6,1,C0,12,pw0[2]=PKW(C0,4)); KRD(GL,3); GAPB(7,1,C0,14,pw0[3]=PKW(C0,6); PIN(pw0)); \
    GAPB(8,2,C1,0,pw1[0]=PKW(C0,8));  GAPB(9,2,C1,2,pw1[1]=PKW(C0,10)); GAPB(10,2,C1,4,pw1[2]=PKW(C0,12)); GAPB(11,2,C1,6,pw1[3]=PKW(C0,14); PIN(pw1)); \
    GAPB(12,3,C1,8,pw2[0]=PKW(C1,0)); GAPB(13,3,C1,10,pw2[1]=PKW(C1,2));GAPB(14,3,C1,12,pw2[2]=PKW(C1,4));GAPB(15,3,C1,14,pw2[3]=PKW(C1,6); PIN(pw2)); \
    l_reg+=sacc; \
    }while(0)
  int t=1;
  for(;t+5<NT;t+=2){
    STEP(pB0,pB1,pA0,pA1,t,true,true,true);     WAIT_BAR(3); RESC(); ROT();
    STEP(pA0,pA1,pB0,pB1,t+1,true,true,true);   WAIT_BAR(3); RESC(); ROT();
  }
  #define ENDW(tt) do{ if((tt)+3<NT){WAIT_BAR(3);} else if((tt)+2<NT){WAIT_BAR(2);} else {WAIT_BAR(0);} }while(0)
  for(;t+1<NT;t+=2){
    STEP(pB0,pB1,pA0,pA1,t,(t+3<NT),(t+1<NT),(t+1<NT));       ENDW(t);   RESC(); ROT();
    STEP(pA0,pA1,pB0,pB1,t+1,(t+4<NT),(t+2<NT),(t+2<NT));     ENDW(t+1); RESC(); ROT();
  }
  STEP(pB0,pB1,pA0,pA1,NT-1,false,false,false); RESC();
  { pw3=(u32x4){PKW(pB1,8),PKW(pB1,10),PKW(pB1,12),PKW(pB1,14)};
    SBAR(); pv(o,vb0+2*sl_cur,PAF(0),PAF(1),PAF(2),PAF(3)); pv(o+2,vb0+2*sl_cur+8192,PAF(0),PAF(1),PAF(2),PAF(3)); }
  #undef PKW
  #undef PAF
  #undef FID
  #undef VF
  #undef VRDR
  #undef PIN
  #undef MX3
  #undef GAPA
  #undef GAPB
  #undef EX
  #undef KRD
  #undef STEP
  #undef ENDW
  {auto rr=__builtin_amdgcn_permlane32_swap(__float_as_uint(l_reg),__float_as_uint(l_reg),false,false);l_reg=__uint_as_float(rr[0])+__uint_as_float(rr[1]);}
  if(hi==0)wsf[32+r32]=l_reg;asm volatile("s_waitcnt lgkmcnt(0)":::"memory");
  float rli[16];
  #pragma unroll
  for(int r=0;r<16;++r)rli[r]=__builtin_amdgcn_rcpf(wsf[32+crow(r,hi)]);
  { bf16*stg=(bf16*)(shm+U_LDS_OST)+wid*2048;
    bf16*Ow=Ou+(long)(wid*QBLK)*opitch;
    #pragma unroll
    for(int hf=0;hf<2;++hf){
      #pragma unroll
      for(int r=0;r<16;++r){const int orow=crow(r,hi);
        #pragma unroll
        for(int d0=0;d0<2;++d0)stg[orow*64+d0*32+r32]=(bf16)(o[2*hf+d0][r]*rli[r]);}
      asm volatile("s_waitcnt lgkmcnt(0)":::"memory");
      #pragma unroll
      for(int i=0;i<4;++i){const int row=i*8+(lane>>3),ch=lane&7; const u32x4 v=*(const u32x4*)(stg+row*64+ch*8); *(u32x4*)(Ow+(long)row*opitch+hf*64+ch*8)=v;}
      asm volatile("s_waitcnt lgkmcnt(0)":::"memory"); } }
  asm volatile("s_waitcnt lgkmcnt(0)\n\ts_barrier":::"memory");
  #undef DMA_K
  #undef DMA_V
  #undef RESC
  #undef ROT
  #undef QF
}

__device__ __forceinline__ void diff_combine_unit(const bf16*O0u,const bf16*O1u,int opitch,float lam,const float*subg,bf16*Mx){
  const int tid=threadIdx.x,lane=tid&63; const int wid=__builtin_amdgcn_readfirstlane(tid>>6);
  asm volatile("s_waitcnt vmcnt(0)":::"memory");
  const bf16*O0w=O0u+(long)(wid*QBLK)*opitch; const bf16*O1w=O1u+(long)(wid*QBLK)*opitch; bf16*Mw=Mx+(long)(wid*QBLK)*1024;
  float sg[16];
  #pragma unroll
  for(int j=0;j<16;++j)sg[j]=subg[(j>>3)*64+(lane&7)*8+(j&7)];
  #pragma unroll
  for(int i=0;i<4;++i){const int row=i*8+(lane>>3),ch=lane&7;
    float d[16]; float ss=0.f;
    #pragma unroll
    for(int hf=0;hf<2;++hf){ const h16x8 v0=*(const h16x8*)(O0w+(long)row*opitch+hf*64+ch*8); const h16x8 v1=*(const h16x8*)(O1w+(long)row*opitch+hf*64+ch*8);
      #pragma unroll
      for(int j=0;j<8;++j){d[hf*8+j]=(float)v0[j]-lam*(float)v1[j];ss+=d[hf*8+j]*d[hf*8+j];} }
    ss+=__shfl_xor(ss,1);ss+=__shfl_xor(ss,2);ss+=__shfl_xor(ss,4);
    const float rs=__builtin_amdgcn_rsqf(ss*(1.f/128.f)+1e-6f)*0.8f;
    #pragma unroll
    for(int hf=0;hf<2;++hf){ h16x8 ov;
      #pragma unroll
      for(int j=0;j<8;++j)ov[j]=(_Float16)(d[hf*8+j]*rs*sg[hf*8+j]);
      *(h16x8*)(Mw+(long)row*1024+hf*64+ch*8)=ov; } }
}
constexpr int ATTN_LDS_BYTES=LDS_BYTES;
#undef SBAR
#undef WAIT_BAR
}

DEV void ph_attn(const Frame& F, int vcu) {
    const f16* qkv = WSP(f16, WS_QKV); f16* sdiff = WSP(f16, WS_SDIFF); f16* mixed = WSP(f16, WS_MIXED);
    const int spr = F.G >> 3, qb = vcu & 7;
#pragma unroll 1
    for (int i = 0;; ++i) {
        const int L = i * spr + (vcu >> 3); if (L >= NB * 4) break;
        const int b = L >> 2, h = L & 3;
        const size_t trow = (size_t)b * SEQ + qb * 256;
        const f16* base = qkv + (size_t)b * RB * NIN;
        const f16* qrow = base + (size_t)(CL + qb * 256) * NIN;
        f16* o0 = sdiff + trow * 512 + h * 128;
#pragma unroll 1
        for (int mp = 0; mp < 2; ++mp)
            attn_body::attn_unit128<8>(qrow + h * 128 + mp * 64, base + 512 + h * 128 + mp * 64, base + 1024 + h * 128, o0 + (size_t)mp * NT * 512, 512, (char*)F.lds);
        attn_body::diff_combine_unit(o0, o0 + (size_t)NT * 512, 512, WSP(float, WS_MISC)[0], F.in[15], mixed + trow * DM + h * 128);
    }
#pragma unroll 1
    for (int i = 0;; ++i) {
        const int L = i * spr + (vcu >> 3); if (L >= NB * 8) break;
        const int b = L >> 3, g = L & 7;
        const size_t trow = (size_t)b * SEQ + qb * 256;
        const f16* base = qkv + (size_t)b * RB * NIN;
        attn_body::attn_unit<8>(base + (size_t)(CL + qb * 256) * NIN + 1536 + g * 64, base + 2048 + (g >> 2) * 64, base + 2176 + (g >> 2) * 64, mixed + trow * DM + 512 + g * 64, DM, (char*)F.lds);
    }
}

DEV void ph_rowpass(const Frame& F) {
    const float* x = F.in[0]; const f16* y1 = WSP(f16, WS_Y1); const float* mod = WSP(float, WS_MOD); const float* gpost = F.in[7]; const float* gpre = F.in[17];
    const float* wr = F.in[19]; const float* rbias = F.in[20]; float* x1out = F.out; unsigned char* h2 = F.ws + WS_H2;
    int* idx = WSP(int, WS_IDX); int* rank = WSP(int, WS_RANK); float* gw = WSP(float, WS_GW); int* cnt = WSP(int, WS_CNT);
    constexpr int AROW = 2064;
    LAS unsigned char* Ahi = (LAS unsigned char*)F.lds; LAS unsigned char* Alo = Ahi + 16 * AROW; LAS float* part = (LAS float*)(Ahi + 32 * AROW);
    LAS int* lcnt = (LAS int*)(Ahi + 32 * AROW + 32768);
    if (F.tid < 64) lcnt[F.tid] = 0;
    const int wave = F.wave, lane = F.lane, fr = lane & 15, fq = lane >> 4;
    f16x8 Bh[4][4];
#pragma unroll
    for (int ks = 0; ks < 4; ++ks)
#pragma unroll
        for (int n = 0; n < 4; ++n) { const int k0 = wave * 128 + ks * 32 + fq * 8, e = n * 16 + fr;
#pragma unroll
            for (int j = 0; j < 8; ++j) Bh[ks][n][j] = (f16)wr[(k0 + j) * NE + e]; }
    const float rb = rbias[lane];
    f32x4 X[2][4]; f16x4 Y[2][4];
#define RP_LOAD(T0) do { _Pragma("unroll") for (int u = 0; u < 2; ++u) { const size_t t_ = (size_t)(T0) + wave * 2 + u; \
        _Pragma("unroll") for (int j = 0; j < 4; ++j) { const int c0 = j * 256 + lane * 4; X[u][j] = *(const f32x4*)(x + t_ * DM + c0); Y[u][j] = *(const f16x4*)(y1 + t_ * DM + c0); } } } while (0)
    constexpr int NBLK = NT / 256;
    if (F.bid < NBLK) RP_LOAD(F.bid * 256);
#pragma unroll 1
    for (int blk = F.bid; blk < NBLK; blk += F.G) {
      f32x4 A1[4], G2[4]; const float* const mb = mod + (size_t)(blk / (SEQ / 256)) * NMOD;
      { const float* m = mb;
#pragma unroll
        for (int j = 0; j < 4; ++j) { const int c0 = j * 256 + lane * 4; A1[j] = *(const f32x4*)(m + 2048 + c0) * *(const f32x4*)(gpost + c0); G2[j] = *(const f32x4*)(gpre + c0) * (*(const f32x4*)(m + 4096 + c0) + 1.f); } }
#pragma unroll 1
      for (int st = 0; st < 16; ++st) {
        const int t0 = blk * 256 + st * 16;
#pragma unroll
        for (int u = 0; u < 2; ++u) {
            const int r = wave * 2 + u; const size_t t = (size_t)t0 + r;
            float ss = 0.f;
#pragma unroll
            for (int j = 0; j < 4; ++j)
#pragma unroll
                for (int i = 0; i < 4; ++i) { const float yv = (float)Y[u][j][i]; ss += yv * yv; }
            const float rstd1 = rsqrtf(wave_sum(ss) * (1.f / DM) + EPS);
            float s2 = 0.f;
#pragma unroll
            for (int j = 0; j < 4; ++j) { const int c0 = j * 256 + lane * 4; f16x4 oh;
#pragma unroll
                for (int i = 0; i < 4; ++i) { const float v = X[u][j][i] + A1[j][i] * ((float)Y[u][j][i] * rstd1); X[u][j][i] = v; oh[i] = (f16)v; s2 += v * v; }
                *(f16x4*)((f16*)(x1out + t * DM) + c0) = oh; }
            const float rstd2 = rsqrtf(wave_sum(s2) * (1.f / DM) + EPS);
#pragma unroll
            for (int j = 0; j < 4; ++j) { const int c0 = j * 256 + lane * 4; const f32x4 sh = *(const f32x4*)(mb + 3072 + c0); f16x4 o, ol;
#pragma unroll
                for (int i = 0; i < 4; ++i) { const float v = X[u][j][i] * rstd2 * G2[j][i] + sh[i]; o[i] = (f16)v; ol[i] = (f16)(v - (float)o[i]); }
                { int q8 = __builtin_amdgcn_cvt_pk_fp8_f32(c8((float)o.x + (float)ol.x), c8((float)o.y + (float)ol.y), 0, false); q8 = __builtin_amdgcn_cvt_pk_fp8_f32(c8((float)o.z + (float)ol.z), c8((float)o.w + (float)ol.w), q8, true); *(int*)(h2 + t * DM + c0) = q8; }
                *(LAS f16x4*)(Ahi + r * AROW + c0 * 2) = o; *(LAS f16x4*)(Alo + r * AROW + c0 * 2) = ol; }
        }
        if (st < 15) RP_LOAD(t0 + 16); else if (blk + F.G < NBLK) RP_LOAD((blk + F.G) * 256);
        __syncthreads();
        { f32x4 acc[4];
#pragma unroll
          for (int n = 0; n < 4; ++n) acc[n] = (f32x4){0.f, 0.f, 0.f, 0.f};
#pragma unroll
          for (int ks = 0; ks < 4; ++ks) { const int off = fr * AROW + (wave * 128 + ks * 32 + fq * 8) * 2;
              const f16x8 ah = *(const LAS f16x8*)(Ahi + off), al = *(const LAS f16x8*)(Alo + off);
#pragma unroll
              for (int n = 0; n < 4; ++n) { acc[n] = __builtin_amdgcn_mfma_f32_16x16x32_f16(ah, Bh[ks][n], acc[n], 0, 0, 0); acc[n] = __builtin_amdgcn_mfma_f32_16x16x32_f16(al, Bh[ks][n], acc[n], 0, 0, 0); } }
#pragma unroll
          for (int n = 0; n < 4; ++n)
#pragma unroll
              for (int q = 0; q < 4; ++q) part[(wave * 16 + 4 * fq + q) * 64 + n * 16 + fr] = acc[n][q]; }
        __syncthreads();
#pragma unroll 1
        for (int rr = 0; rr < 2; ++rr) {
            const int r = wave * 2 + rr; const size_t t = (size_t)t0 + r; const int e = lane;
            float lgt = 0.f;
#pragma unroll
            for (int p = 0; p < 8; ++p) lgt += part[(p * 16 + r) * 64 + e];
            const float s = 1.f / (1.f + expf(-lgt)); const float sel = s + rb;
            int rk = 0;
#pragma unroll
            for (int d = 1; d < 8; ++d) { const float o = __shfl_xor(sel, d); rk += (o > sel || (o == sel && (e ^ d) < e)) ? 1 : 0; }
            float gs = rk < 2 ? sel : 0.f; gs += __shfl_xor(gs, 1); gs += __shfl_xor(gs, 2); gs += __shfl_xor(gs, 4);
            int grk = 0; const int g = e >> 3;
#pragma unroll
            for (int d = 1; d < 8; ++d) { const float o = __shfl_xor(gs, d * 8); grk += (o > gs || (o == gs && (g ^ d) < g)) ? 1 : 0; }
            const bool gsel = grk < 4;
            const float v = gsel ? sel : -INFINITY;
            int r8 = 0;
#pragma unroll
            for (int j = 0; j < 64; ++j) { const float o = __builtin_bit_cast(float, __builtin_amdgcn_readlane(__builtin_bit_cast(int, v), j)); r8 += (o > v || (o == v && j < e)) ? 1 : 0; }
            const bool chosen = gsel && r8 < 8;
            const float tot = wave_sum(chosen ? s : 0.f);
            if (chosen) { idx[t * 8 + r8] = e; gw[t * 8 + r8] = s / tot * 2.5f; rank[t * 8 + r8] = __hip_atomic_fetch_add(&lcnt[e], 1, __ATOMIC_RELAXED, __HIP_MEMORY_SCOPE_WORKGROUP); }
        }
      }
    }
#undef RP_LOAD
    __syncthreads();
    if (F.tid < 64) WSP(int, WS_WGB)[F.bid * 64 + F.tid] = atomicAdd(&cnt[F.tid * 64], lcnt[F.tid]);
    __syncthreads();
}

DEV void ph_dispatch(const Frame& F) {
    const int* idx = WSP(int, WS_IDX); const int* rank = WSP(int, WS_RANK); const float* gw = WSP(float, WS_GW); const int* cnt = WSP(int, WS_CNT); const int* wgb = WSP(int, WS_WGB);
    int* tok = WSP(int, WS_TOK); int* pair = WSP(int, WS_PAIR); float* wsl = WSP(float, WS_WSL); int* blke = WSP(int, WS_BLKE); int* nblk = WSP(int, WS_CTL) + 64;
    int* pst = (int*)F.lds;
    const int tid = F.tid;
    if (tid < 64) { const int pc = ((cnt[tid * 64] + 255) >> 8) << 8; int incl = pc;
#pragma unroll
        for (int o = 1; o < 64; o <<= 1) { const int n = __shfl_up(incl, o); if (tid >= o) incl += n; }
        pst[tid] = incl - pc; if (tid == 63) pst[64] = incl; }
    __syncthreads();
    for (int gid = F.bid * NTHR + tid; gid < NT * 8; gid += F.G * NTHR) {
        const int e = idx[gid]; const int t = gid >> 3, k = gid & 7; const int slot = NT + pst[e] + wgb[((t >> 8) % F.G) * 64 + e] + rank[gid]; tok[slot] = t; pair[slot] = t * NSLOTK + k; wsl[slot] = gw[gid];
        if (gid < NT) { tok[gid] = gid; pair[gid] = gid * NSLOTK + 8; wsl[gid] = 1.f; }
    }
    for (int e = F.bid; e < 64; e += F.G) {
        for (int s = NT + pst[e] + cnt[e * 64] + tid; s < NT + pst[e + 1]; s += NTHR) { tok[s] = 0; pair[s] = -1; wsl[s] = 0.f; }
    }
    if (F.bid == 0) {
        const int nb = SH_BLKS + (pst[64] >> 8);
        if (tid == 0) *nblk = nb;
        for (int bk = tid; bk < MAX_BLKS; bk += NTHR) {
            int e = 64;
            if (bk >= SH_BLKS) { const int off = (bk - SH_BLKS) << 8; e = 0; for (int q = 0; q < 64; ++q) if (off >= pst[q] && off < pst[q + 1]) e = q; }
            blke[bk] = e;
        }
    }
    __syncthreads();
}

DEV void ph_combine(const Frame& F, float* dst) {
    const unsigned char* yp = F.ws + WS_YP; const float* mod = WSP(float, WS_MOD); const float* gpf = F.in[18]; float* out = F.out;
    const int lane = F.lane;
    for (int blk = F.bid; blk < NT / 256; blk += F.G) {
      float A2[16];
      { const float* m = mod + (size_t)(blk / (SEQ / 256)) * NMOD + 5120;
#pragma unroll
        for (int i = 0; i < 4; ++i) { const int c0 = lane * 16 + i * 4; const f32x4 g = *(const f32x4*)(gpf + c0), gt = *(const f32x4*)(m + c0);
#pragma unroll
            for (int j = 0; j < 4; ++j) A2[i * 4 + j] = g[j] * gt[j]; } }
#pragma unroll 1
      for (int st = 0; st < 16; ++st) { const size_t t0 = (size_t)blk * 256 + st * 16 + F.wave * 2;
        f16x8 xa[2], xb[2]; uint4 w[2][NSLOTK];
#pragma unroll
        for (int u = 0; u < 2; ++u) { const size_t t = t0 + u;
            xa[u] = *(const f16x8*)((const f16*)(out + t * DM) + lane * 16); xb[u] = *(const f16x8*)((const f16*)(out + t * DM) + lane * 16 + 8);
#pragma unroll
            for (int k = 0; k < NSLOTK; ++k) w[u][k] = *(const uint4*)(yp + (t * NSLOTK + k) * DM + lane * 16); }
#pragma unroll
        for (int u = 0; u < 2; ++u) { const size_t t = t0 + u;
            float acc[16];
#pragma unroll
            for (int i = 0; i < 16; ++i) acc[i] = 0.f;
#pragma unroll
            for (int k = 0; k < NSLOTK; ++k) {
                const unsigned ww[4] = {w[u][k].x, w[u][k].y, w[u][k].z, w[u][k].w};
#pragma unroll
                for (int i = 0; i < 4; ++i) { const f32x2 lo = __builtin_amdgcn_cvt_pk_f32_fp8((int)ww[i], false), hi = __builtin_amdgcn_cvt_pk_f32_fp8((int)ww[i], true);
                    acc[i * 4] += lo.x; acc[i * 4 + 1] += lo.y; acc[i * 4 + 2] += hi.x; acc[i * 4 + 3] += hi.y; }
            }
            float ss = 0.f;
#pragma unroll
            for (int i = 0; i < 16; ++i) { acc[i] *= (1.f / YSCALE); ss += acc[i] * acc[i]; }
            const float rstd = rsqrtf(wave_sum(ss) * (1.f / DM) + EPS);
#pragma unroll
            for (int i = 0; i < 4; ++i) { const int c0 = lane * 16 + i * 4; f32x4 o;
#pragma unroll
                for (int j = 0; j < 4; ++j) { const int q = i * 4 + j; const float x1 = (float)(q < 8 ? xa[u][q & 7] : xb[u][q & 7]); o[j] = x1 + A2[q] * (acc[q] * rstd); }
                *(f32x4*)(dst + t * DM + c0) = o; }
        }
      }
    }
}

#define XB_TMO      128
#define XB_XCNT(j)  (256  + 64 * (j))
#define XB_XSUB(j)  (1280 + 64 * (j))
#define XB_XGEN(j)  (2304 + 64 * (j))
#define XB_TOP      3328
#define XB_TOPGEN   3392
#define XCD_BAR_WORDS 3456
#define XB_SPIN_CAP (1u << 20)
DEV unsigned xb_ld(unsigned* p)              { return __hip_atomic_load(p, __ATOMIC_RELAXED, __HIP_MEMORY_SCOPE_AGENT); }
DEV unsigned xb_add(unsigned* p, unsigned v) { return __hip_atomic_fetch_add(p, v, __ATOMIC_RELAXED, __HIP_MEMORY_SCOPE_AGENT); }
DEV unsigned xb_xcc_id() { return (unsigned)__builtin_amdgcn_s_getreg((3 << 11) | 20) & 0xFu; }
#define XB_SPIN(cond, bar) do { unsigned _sp = 0; while (cond) { __builtin_amdgcn_s_sleep(1); \
    if ((++_sp & 255u) == 0u) { if (xb_ld(&(bar)[XB_TMO])) break; if (_sp > XB_SPIN_CAP) { atomicAdd(&(bar)[XB_TMO], 1u); break; } } } } while (0)
struct XcdBarrier { unsigned* bar; unsigned x; volatile LAS unsigned* st; };
DEV XcdBarrier xcd_barrier_post(unsigned* bar, volatile LAS unsigned* st) {
    XcdBarrier b; b.bar = bar; b.x = xb_xcc_id(); b.st = st;
    if (threadIdx.x == 0) (void)xb_add(&bar[XB_XCNT(b.x)], 1u);
    return b;
}
DEV void xcd_barrier_complete(unsigned* bar, unsigned x, unsigned& nloc, unsigned& nx) {
    const unsigned G = gridDim.x * gridDim.y * gridDim.z;
    unsigned sum, cnt, mine, sp = 0u;
    for (;;) {
        sum = 0u; cnt = 0u; mine = 0u;
#pragma unroll
        for (unsigned j = 0; j < 16; ++j) { const unsigned c = xb_ld(&bar[XB_XCNT(j)]); sum += c; cnt += (c > 0u) ? 1u : 0u; mine = (j == x) ? c : mine; }
        if (sum == G) break;
        __builtin_amdgcn_s_sleep(1);
        if ((++sp & 255u) == 0u) { if (xb_ld(&bar[XB_TMO])) break; if (sp > XB_SPIN_CAP) { atomicAdd(&bar[XB_TMO], 1u); break; } }
    }
    nloc = mine > 0u ? mine : 1u; nx = cnt > 0u ? cnt : 1u;
}
DEV void xcd_barrier(const XcdBarrier& b) {
    asm volatile("s_waitcnt vmcnt(0)" ::: "memory");
    __syncthreads();
    if (threadIdx.x == 0) {
        unsigned* bar = b.bar;
        __builtin_amdgcn_s_waitcnt(0);
        unsigned nloc = b.st[0], nx = b.st[1];
        if (nloc == 0u) { xcd_barrier_complete(bar, b.x, nloc, nx); b.st[0] = nloc; b.st[1] = nx; }
        const unsigned old = xb_add(&bar[XB_XSUB(b.x)], 1u);
        const unsigned gen = old / nloc;
        if (old + 1u == (gen + 1u) * nloc) {
            __builtin_amdgcn_fence(__ATOMIC_RELEASE, "agent");
            asm volatile("s_waitcnt vmcnt(0)" ::: "memory");
            const unsigned og = xb_add(&bar[XB_TOP], 1u);
            const unsigned tg = og / nx;
            if (og + 1u == (tg + 1u) * nx) xb_add(&bar[XB_TOPGEN], 1u);
            else XB_SPIN(xb_ld(&bar[XB_TOPGEN]) == tg, bar);
            __builtin_amdgcn_fence(__ATOMIC_ACQUIRE, "agent");
            xb_add(&bar[XB_XGEN(b.x)], 1u);
            asm volatile("s_waitcnt vmcnt(0)" ::: "memory");
        } else {
            XB_SPIN(xb_ld(&bar[XB_XGEN(b.x)]) == gen, bar);
            __builtin_amdgcn_fence(__ATOMIC_ACQUIRE, "agent");
            asm volatile("s_waitcnt vmcnt(0)" ::: "memory");
        }
    }
    __syncthreads();
}

#ifndef PROBE_DUP
#define PROBE_DUP -1
#endif
constexpr int NPHASE = 11;
__global__ void __launch_bounds__(NTHR, 2) mega(Args a) {
    extern __shared__ __attribute__((aligned(16))) unsigned char lds[];
    cg::grid_group grid = cg::this_grid();
    Frame F;
    F.lds = lds; F.tid = threadIdx.x; F.lane = F.tid & 63; F.wave = __builtin_amdgcn_readfirstlane(F.tid >> 6); F.bid = blockIdx.x; F.G = gridDim.x;
    F.gw = F.bid * NWAVE + F.wave; F.NGW = F.G * NWAVE; F.in = a.in; F.out = a.out; F.ws = a.ws;
    const int lo = a.ph_lo, hi = a.ph_hi;
#ifndef ONLY_PHASE
#define ONLY_PHASE -1
#endif
#define IN(k) (lo <= (k) && (k) < hi && (ONLY_PHASE < 0 || (k) == ONLY_PHASE))
    volatile LAS unsigned* xst = (volatile LAS unsigned*)((LAS unsigned char*)lds + LDS_BYTES - 128);
    if (F.tid < 2) xst[F.tid] = 0u;
    __syncthreads();
    const XcdBarrier xbar = xcd_barrier_post((unsigned*)(a.ws + WS_BAR), xst);
#define SEAM(k) do { if (IN(k) && IN((k) + 1)) { if (hi > 64) grid.sync(); else xcd_barrier(xbar); } } while (0)
#define RUN(k, ...) do { if (IN(k)) { __VA_ARGS__; if (PROBE_DUP == (k) && (k) != 10) { xcd_barrier(xbar); __VA_ARGS__; } } } while (0)
    const int vcu = (F.G % 8 == 0) ? (F.bid % 8) * (F.G / 8) + F.bid / 8 : F.bid;
    LAS unsigned char* lds3 = (LAS unsigned char*)lds;
    RUN(0, { ph_mod(F); ph_wconv(F); }); SEAM(0);
    RUN(1, ph_prenorm(F)); SEAM(1);
    RUN(2, { pg8::SchedInProj S{(const char*)WSP(f16, WS_HALL), (const char*)WSP(f16, WS_WIN), vcu, F.G};
        pg8::EpiInProj E{WSP(f16, WS_QKV), F.in[9], F.in[10], WSP(float, WS_ROPE)};
        pg8::gemm_phase<pg8::EpiInProj, pg8::SchedInProj, false>(lds3, DM * 2, S, E, nullptr, nullptr, nullptr); }); SEAM(2);
    RUN(3, ph_attn(F, vcu)); if (IN(3) && IN(5)) xcd_barrier(xbar);
    RUN(5, { pg8::SchedDense S{(const char*)WSP(f16, WS_MIXED), (const char*)WSP(f16, WS_WOUT), vcu, F.G, (NT / 256) * 4, 4, DM};
        pg8::EpiPlain E{WSP(f16, WS_Y1), DM};
        pg8::gemm_phase<pg8::EpiPlain, pg8::SchedDense, false>(lds3, DM * 2, S, E, nullptr, nullptr, nullptr); }); SEAM(5);
    RUN(6, ph_rowpass(F)); SEAM(6);
    RUN(7, ph_dispatch(F)); SEAM(7);
    RUN(8, { const int nb = *(WSP(int, WS_CTL) + 64);
        pg8::SchedGrouped S{nullptr, (const char*)(F.ws + WS_WGU), WSP(int, WS_BLKE), vcu, F.G, nb * 2, 2, DM / 2, (size_t)512 * DM, 1};
        pg8::EpiGU E{F.ws + WS_H, WSP(float, WS_WSL)};
        pg8::gemm_phase<pg8::EpiGU, pg8::SchedGrouped, true, true>(lds3, DM, S, E, WSP(int, WS_TOK), (const char*)(F.ws + WS_H2), WSP(unsigned, WS_WSL), 0x79797979, 0x7F7F7F7F); }); SEAM(8);
    RUN(9, { const int nb = *(WSP(int, WS_CTL) + 64);
        pg8::SchedGrouped S{(const char*)(F.ws + WS_H), (const char*)(F.ws + WS_WD), WSP(int, WS_BLKE), vcu, F.G, nb * 4, 4, EH / 2, (size_t)DM * EH, 1};
        pg8::EpiDown E{F.ws + WS_YP, WSP(int, WS_PAIR)};
        pg8::gemm_phase<pg8::EpiDown, pg8::SchedGrouped, false, true, true>(lds3, EH, S, E, nullptr, nullptr, WSP(unsigned, WS_PAIR), 0x79797979, 0x80808080  ); }); SEAM(9);
    RUN(10, ph_combine(F, F.out));
}

extern "C" void kernel_launch(void* const* d_in, const int* in_sizes, int n_in, void* d_out, int out_size, void* d_ws, size_t ws_size, hipStream_t stream) {
    (void)in_sizes; (void)out_size;
    static int grid = 0;
    if (grid == 0) {
        if (n_in != 27 || ws_size < WS_END) { fprintf(stderr, "kernel_launch: unexpected n_in %d / ws_size %zu (need %zu)\n", n_in, ws_size, (size_t)WS_END); grid = -1; return; }
        int dev = 0, cus = 0, per_cu = 0;
        (void)hipGetDevice(&dev); (void)hipDeviceGetAttribute(&cus, hipDeviceAttributeMultiprocessorCount, dev);
        if (hipFuncSetAttribute((const void*)mega, hipFuncAttributeMaxDynamicSharedMemorySize, LDS_BYTES) != hipSuccess) { fprintf(stderr, "kernel_launch: hipFuncSetAttribute failed\n"); grid = -1; return; }
        if (hipOccupancyMaxActiveBlocksPerMultiprocessor(&per_cu, (const void*)mega, NTHR, LDS_BYTES) != hipSuccess || per_cu < 1) { fprintf(stderr, "kernel_launch: occupancy query failed (%d)\n", per_cu); (void)hipGetLastError(); per_cu = 1; }
        grid = cus * (per_cu > 1 ? 1 : per_cu);
        if (grid <= 0) grid = 256;
    }
    if (grid < 0) return;
    (void)hipMemsetAsync((unsigned char*)d_ws + WS_CTL, 0, 64 * 1024, stream);
    Args a{};
    for (int i = 0; i < 27; ++i) a.in[i] = (const float*)d_in[i];
    a.out = (float*)d_out; a.ws = (unsigned char*)d_ws; a.ph_lo = 0; a.ph_hi = NPHASE;
    void* args[] = {&a};
    hipError_t e = hipLaunchCooperativeKernel((const void*)mega, dim3(grid), dim3(NTHR), args, LDS_BYTES, stream);
    if (e != hipSuccess) fprintf(stderr, "kernel_launch: cooperative launch failed: %s (grid %d)\n", hipGetErrorString(e), grid);
}
```

```cpp
#include <hip/hip_runtime.h>
#include <hip/hip_cooperative_groups.h>
#include <stdint.h>
#include <math.h>
#include <cstdio>
namespace cg = cooperative_groups;

typedef _Float16 f16;
typedef _Float16 f16x8 __attribute__((ext_vector_type(8)));
typedef _Float16 f16x4 __attribute__((ext_vector_type(4)));
typedef float f32x4 __attribute__((ext_vector_type(4)));
typedef float f32x2 __attribute__((ext_vector_type(2)));
#define DEV __device__ __forceinline__
#define LAS __attribute__((address_space(3)))

constexpr int NB = 32, SEQ = 2048, DM = 1024, NT = NB * SEQ, CL = 256, RB = SEQ + CL, RALL = NB * RB;
constexpr int NIN = 2304, NMOD = 6144, NE = 64, EH = 256, TOPK = 8, NSLOTK = 9;
constexpr int SH_BLKS = NT / 256;
constexpr int MAX_BLKS = SH_BLKS + (NT * TOPK) / 256 + NE;
constexpr int MAX_SLOTS = MAX_BLKS * 256;
constexpr float EPS = 1e-6f;
constexpr float QSCALE = 0.125f * 1.4426950408889634f;
constexpr float YSCALE = 8.0f;
constexpr int NTHR = 512, NWAVE = 8;
constexpr int LDS_BYTES = 147456;

constexpr size_t MiB = 1ull << 20;
constexpr size_t WS_CTL = 0;
constexpr size_t WS_CNT = 32768;
constexpr size_t WS_BAR = 4096;
constexpr size_t WS_MOD = 64 * 1024;
constexpr size_t WS_ROPE = 1 * MiB;
constexpr size_t WS_MISC = 1 * MiB + 64 * 1024;
constexpr size_t WS_BLKE = 1 * MiB + 128 * 1024;
constexpr size_t WS_WIN = 4 * MiB;
constexpr size_t WS_WOUT = WS_WIN + (size_t)NIN * DM * 2;
constexpr size_t WS_WGU = WS_WOUT + (size_t)DM * DM * 2;
constexpr size_t WS_WD = WS_WGU + (size_t)65 * 512 * DM * 2;
constexpr size_t WS_WEND = WS_WD + (size_t)65 * DM * EH * 2;
static_assert(WS_WEND <= 108 * MiB, "weights");
constexpr size_t WS_HALL = 108 * MiB;
constexpr size_t WS_MIXED = 108 * MiB;
constexpr size_t WS_QKV = 252 * MiB;
constexpr size_t WS_SDIFF = 576 * MiB;
constexpr size_t WS_Y1 = 704 * MiB;
constexpr size_t WS_H = 108 * MiB;
constexpr size_t WS_YP = 404 * MiB;
constexpr size_t WS_H2 = 404 * MiB;
constexpr size_t WS_TAB = 980 * MiB;
constexpr size_t WS_IDX = WS_TAB;
constexpr size_t WS_RANK = WS_IDX + (size_t)NT * 8 * 4;
constexpr size_t WS_GW = WS_RANK + (size_t)NT * 8 * 4;
constexpr size_t WS_TOK = WS_GW + (size_t)NT * 8 * 4;
constexpr size_t WS_PAIR = WS_TOK + (size_t)MAX_SLOTS * 4;
constexpr size_t WS_WSL = WS_PAIR + (size_t)MAX_SLOTS * 4;
constexpr size_t WS_WGB = WS_WSL + (size_t)MAX_SLOTS * 4;
constexpr size_t WS_END = WS_WGB + (size_t)1024 * 64 * 4;
static_assert(WS_END <= 1024 * MiB, "ws");

DEV float wave_sum(float v) {
#pragma unroll
    for (int o = 32; o > 0; o >>= 1) v += __shfl_xor(v, o);
    return v;
}
DEV float silu(float v) { return v / (1.f + __expf(-v)); }
DEV float silu_f(float v) { return v * __builtin_amdgcn_rcpf(1.f + __builtin_amdgcn_exp2f(v * -1.44269504f)); }
DEV float c8(float v) { return __builtin_amdgcn_fmed3f(v, -448.f, 448.f); }
DEV unsigned char f2fp8(float v) { const int r = __builtin_amdgcn_cvt_pk_fp8_f32(v, v, 0, false); return (unsigned char)(r & 0xff); }

struct Args { const float* in[27]; float* out; unsigned char* ws; int ph_lo, ph_hi; };
struct Frame {
    unsigned char* lds; int tid, lane, wave, bid, G, gw, NGW;
    const float* const* in; float* out; unsigned char* ws;
};
#define WSP(T, off) ((T*)(F.ws + (off)))

DEV void ph_mod(const Frame& F) {
    const float* c = F.in[1]; const float* c_ctx = F.in[3]; const float* w_mod = F.in[4]; const float* b_mod = F.in[5];
    float* mod = WSP(float, WS_MOD);
    if (F.bid == 0) {
        if (F.tid < 64) { float a = F.in[11][F.tid] * F.in[12][F.tid], b = F.in[13][F.tid] * F.in[14][F.tid]; a = wave_sum(a); b = wave_sum(b); if (F.tid == 0) WSP(float, WS_MISC)[0] = expf(a) - expf(b) + 0.2f; }
        float* rope = WSP(float, WS_ROPE);
        for (int i = F.tid; i < 64 * 16; i += NTHR) { const int pos = i >> 4, j = i & 15; const float ang = (float)pos * powf(10000.0f, -(float)j / 16.0f); rope[i * 2] = cosf(ang); rope[i * 2 + 1] = sinf(ang); }
    }
    constexpr int MC = 24;
    if (F.bid >= NMOD / MC) return;
    float* sc = (float*)F.lds;
    const int c0 = F.bid * MC, kh = F.lane / MC, col = F.lane - kh * MC;
    const float* wp = w_mod + (size_t)(F.wave * 128 + kh) * NMOD + c0 + col;
    float wa[8], wb[8];
#define MOD_LOAD(W, IT0) do { if (kh < 2) { _Pragma("unroll") for (int u = 0; u < 8; ++u) W[u] = wp[(size_t)((IT0) + u) * 2 * NMOD]; } } while (0)
#define MOD_FMA(W, IT0) do { if (kh < 2) { _Pragma("unroll") for (int u = 0; u < 8; ++u) { const int k = F.wave * 128 + ((IT0) + u) * 2 + kh; _Pragma("unroll") for (int r = 0; r < 33; ++r) acc[r] += sc[r * DM + k] * W[u]; } } } while (0)
    MOD_LOAD(wa, 0);
    for (int i = F.tid; i < 33 * DM; i += NTHR) { const int r = i >> 10, k = i & 1023; sc[i] = silu_f(r < 32 ? c[r * DM + k] : c_ctx[k]); }
    __syncthreads();
    float acc[33];
#pragma unroll
    for (int r = 0; r < 33; ++r) acc[r] = 0.f;
#pragma unroll 1
    for (int it0 = 0; it0 < 64; it0 += 16) {
        MOD_LOAD(wb, it0 + 8); MOD_FMA(wa, it0);
        if (it0 + 16 < 64) MOD_LOAD(wa, it0 + 16);
        MOD_FMA(wb, it0 + 8);
    }
#undef MOD_LOAD
#undef MOD_FMA
#pragma unroll
    for (int r = 0; r < 33; ++r) acc[r] += __shfl_down(acc[r], MC);
    __syncthreads();
    float* red = (float*)F.lds;
    if (F.lane < MC) {
#pragma unroll
        for (int r = 0; r < 33; ++r) red[(F.wave * 33 + r) * MC + col] = acc[r];
    }
    __syncthreads();
    for (int i = F.tid; i < 33 * MC; i += NTHR) { const int r = i / MC, cc = i - r * MC; float s = b_mod[c0 + cc];
#pragma unroll
        for (int w = 0; w < 8; ++w) s += red[(w * 33 + r) * MC + cc];
        mod[(size_t)r * NMOD + c0 + cc] = s; }
    __syncthreads();
}

struct WItem { const float* W; unsigned char* WT; int K, N, rowmode, f8, item; };
DEV void wconv_load(const WItem& d, int lane, f32x4 (&t)[8]) {
    const int nblk = d.N / 32, kb = d.item / nblk, nb = d.item % nblk, k0 = 64 * kb, n0 = 32 * nb;
#pragma unroll
    for (int i = 0; i < 8; ++i) t[i] = *(const f32x4*)(d.W + (size_t)(k0 + i * 8 + (lane >> 3)) * d.N + n0 + (lane & 7) * 4);
}
DEV void wconv_put(const WItem& d, int lane, const f32x4 (&t)[8], float* scr) {
    const int K = d.K, nblk = d.N / 32, kb = d.item / nblk, nb = d.item % nblk, k0 = 64 * kb, n0 = 32 * nb;
#pragma unroll
    for (int i = 0; i < 8; ++i) { float* q = scr + (i * 8 + (lane >> 3)) * 33 + (lane & 7) * 4; q[0] = t[i].x; q[1] = t[i].y; q[2] = t[i].z; q[3] = t[i].w; }
    __builtin_amdgcn_s_waitcnt(0xC07F); asm volatile("" ::: "memory");
    const int c = lane & 7;
#pragma unroll
    for (int j = 0; j < 4; ++j) {
        const int n = (lane >> 3) + 8 * j; const float* sp = scr + (8 * c) * 33 + n;
        const int nn = n0 + n;
        int row;
        if (d.rowmode == 0) row = nn;
        else if (d.rowmode == 3) { const int cc = nn & 255; row = (nn & ~255) + ((cc >> 5) & 1) * 128 + (cc >> 6) * 32 + (cc & 31); }
        else row = (nn >> 7) * 256 + (nn & 127) + (d.rowmode == 2 ? 128 : 0);
        if (d.f8) {
            int lo = __builtin_amdgcn_cvt_pk_fp8_f32(c8(sp[0] * 64.f), c8(sp[33] * 64.f), 0, false); lo = __builtin_amdgcn_cvt_pk_fp8_f32(c8(sp[66] * 64.f), c8(sp[99] * 64.f), lo, true);
            int hi = __builtin_amdgcn_cvt_pk_fp8_f32(c8(sp[132] * 64.f), c8(sp[165] * 64.f), 0, false); hi = __builtin_amdgcn_cvt_pk_fp8_f32(c8(sp[198] * 64.f), c8(sp[231] * 64.f), hi, true);
            *(uint2*)(d.WT + (size_t)row * K + k0 + 8 * c) = make_uint2((unsigned)lo, (unsigned)hi);
        } else {
            f16x8 o;
#pragma unroll
            for (int q = 0; q < 8; ++q) o[q] = (f16)sp[q * 33];
            *(f16x8*)(d.WT + ((size_t)row * K + k0 + 8 * c) * 2) = o;
        }
    }
    __builtin_amdgcn_s_waitcnt(0xC07F); asm volatile("" ::: "memory");
}
DEV void ph_wconv(const Frame& F) {
    float* scr = (float*)(F.lds + F.wave * 16384);
    constexpr int I_IN = (DM / 64) * (NIN / 32), I_OUT = (DM / 64) * (DM / 32), I_E = (DM / 64) * (EH / 32);
    constexpr int NITEMS = I_IN + I_OUT + 65 * 3 * I_E;
    auto decode = [&](int it, WItem& d) {
        int r = it;
        if (r < I_IN) { d = WItem{F.in[8], F.ws + WS_WIN, DM, NIN, 3, 0, r}; return; } r -= I_IN;
        if (r < I_OUT) { d = WItem{F.in[16], F.ws + WS_WOUT, DM, DM, 0, 0, r}; return; } r -= I_OUT;
        const int e = r / (3 * I_E), q = (r % (3 * I_E)) / I_E, ii = r % I_E;
        if (q == 0) d = WItem{e < 64 ? F.in[21] + (size_t)e * DM * EH : F.in[24], F.ws + WS_WGU + (size_t)e * 512 * DM, DM, EH, 1, 1, ii};
        else if (q == 1) d = WItem{e < 64 ? F.in[22] + (size_t)e * DM * EH : F.in[25], F.ws + WS_WGU + (size_t)e * 512 * DM, DM, EH, 2, 1, ii};
        else d = WItem{e < 64 ? F.in[23] + (size_t)e * DM * EH : F.in[26], F.ws + WS_WD + (size_t)e * DM * EH, EH, DM, 3, 1, ii};
    };
    int it = F.gw; if (it >= NITEMS) return;
    WItem cur, nxt; f32x4 ta[8], tb[8];
    decode(it, cur); wconv_load(cur, F.lane, ta);
#pragma unroll 1
    for (;;) {
        const int i1 = it + F.NGW; const bool h1 = i1 < NITEMS;
        if (h1) { decode(i1, nxt); wconv_load(nxt, F.lane, tb); }
        wconv_put(cur, F.lane, ta, scr);
        if (!h1) break;
        const int i2 = i1 + F.NGW; const bool h2 = i2 < NITEMS;
        if (h2) { decode(i2, cur); wconv_load(cur, F.lane, ta); }
        wconv_put(nxt, F.lane, tb, scr);
        if (!h2) break;
        it = i2;
    }
}

DEV void ph_prenorm(const Frame& F) {
    const float* x = F.in[0]; const float* ctx = F.in[2]; const float* g = F.in[6]; const float* mod = WSP(float, WS_MOD); f16* hall = WSP(f16, WS_HALL);
    const int lane = F.lane;
    constexpr int PBLK = 288; static_assert(RB % PBLK == 0 && RALL % PBLK == 0, "prenorm block");
    f32x4 gg[4];
#pragma unroll
    for (int j = 0; j < 4; ++j) gg[j] = *(const f32x4*)(g + j * 256 + lane * 4);
    for (int blk = F.bid; blk < RALL / PBLK; blk += F.G) {
        int curm = -1; f32x4 G2[4], SH[4];
#pragma unroll 1
        for (int i = F.wave * 2; i < PBLK; i += 16) {
            const int row0 = blk * PBLK + i;
            f32x4 v[2][4]; int mr[2];
#pragma unroll
            for (int u = 0; u < 2; ++u) { const int row = row0 + u; const int b = row / RB, p = row % RB;
                const float* src = p < CL ? ctx + ((size_t)b * CL + p) * DM : x + ((size_t)b * SEQ + (p - CL)) * DM;
                mr[u] = p < CL ? 32 : b;
#pragma unroll
                for (int j = 0; j < 4; ++j) v[u][j] = *(const f32x4*)(src + j * 256 + lane * 4); }
#pragma unroll
            for (int u = 0; u < 2; ++u) {
                if (mr[u] != curm) { curm = mr[u]; const float* mp = mod + (size_t)curm * NMOD;
#pragma unroll
                    for (int j = 0; j < 4; ++j) { const int c0 = j * 256 + lane * 4; const f32x4 sc = *(const f32x4*)(mp + 1024 + c0); SH[j] = *(const f32x4*)(mp + c0); G2[j] = gg[j] * (sc + 1.f); } }
                float ss = 0.f;
#pragma unroll
                for (int j = 0; j < 4; ++j) ss += v[u][j].x * v[u][j].x + v[u][j].y * v[u][j].y + v[u][j].z * v[u][j].z + v[u][j].w * v[u][j].w;
                const float rstd = rsqrtf(wave_sum(ss) * (1.f / DM) + EPS);
#pragma unroll
                for (int j = 0; j < 4; ++j) {
                    const int c0 = j * 256 + lane * 4;
                    f16x4 o;
                    o.x = (f16)(v[u][j].x * rstd * G2[j].x + SH[j].x); o.y = (f16)(v[u][j].y * rstd * G2[j].y + SH[j].y);
                    o.z = (f16)(v[u][j].z * rstd * G2[j].z + SH[j].z); o.w = (f16)(v[u][j].w * rstd * G2[j].w + SH[j].w);
                    *(f16x4*)(hall + (size_t)(row0 + u) * DM + c0) = o;
                }
            }
        }
    }
}


namespace pg8 {
typedef int v8i __attribute__((ext_vector_type(8)));
typedef unsigned u32x4v __attribute__((ext_vector_type(4)));
constexpr int BM = 256, BK = 64, HALF = 128, HTB = HALF * BK * 2  , STAGE_BYTES = 8 * HTB;
DEV int lds_byte(int r, int c) { const int st = (r >> 4) * 2 + (c >> 5), rr = r & 15, cc = c & 31, ob = rr * 64 + cc * 2; return st * 1024 + (ob ^ (((ob >> 9) & 1) << 5)); }
DEV void stage_rc(int b, int& R, int& C) { const int st = b / 1024, sb = b % 1024, swz = sb ^ (((sb >> 9) & 1) << 5); R = (st >> 1) * 16 + swz / 64; C = (st & 1) * 32 + (swz % 64) / 2; }
struct GUnit { const char* A; const char* B; int pm, pn, aux; };
DEV void glds16s(const char* sbase, unsigned voff, unsigned lds_dst) { unsigned keep;
    asm volatile("s_mov_b32 %0, m0\n\ts_mov_b32 m0, %3\n\ts_nop 0\n\tglobal_load_lds_dwordx4 %1, %2\n\ts_mov_b32 m0, %0" : "=&s"(keep) : "v"(voff), "s"(sbase), "s"(lds_dst) : "memory"); }
DEV void stage2(LAS unsigned char* lds, unsigned bufoff, const char* base, unsigned o0, unsigned o1) {
    const unsigned d = (unsigned)__builtin_amdgcn_readfirstlane((int)((unsigned)(uintptr_t)lds + bufoff));
    glds16s(base, o0, d); glds16s(base, o1, d + 8192u);
}
template <class Epi, class Sched, bool GATHER, bool FP8 = false, bool ARES = false>
DEV void gemm_phase(LAS unsigned char* lds, const int PB, const Sched& S, const Epi& E, const int* tok, const char* Ag, const unsigned* rowarg, const int scaleW = 0x7F7F7F7F, const int scaleA = 0x7F7F7F7F) {
    const int tid = threadIdx.x, wid = __builtin_amdgcn_readfirstlane(tid >> 6), lane = tid & 63, wr = wid >> 2, wc = wid & 3, fr = lane & 15, fq = lane >> 4;
    const int nt = PB / 128;
    unsigned voff[2]; int sR[2]; unsigned sC2[2];
#pragma unroll
    for (int i = 0; i < 2; ++i) { int R, C; stage_rc(tid * 16 + i * 8192, R, C); sR[i] = R; sC2[i] = (unsigned)C * 2u; voff[i] = (unsigned)(R * PB) + (unsigned)C * 2u; }
    const size_t kstep = (size_t)(BK * 2), hstep = (size_t)HALF * PB;
    const unsigned ldsw = (unsigned)wid * 1024u;
    const int aoff = FP8 ? lds_byte(wr * 64 + fr, fq * 16) : lds_byte(wr * 64 + fr, fq * 8), boff = FP8 ? lds_byte(wc * 32 + fr, fq * 16) : lds_byte(wc * 32 + fr, fq * 8);
#define PG8_SA(b, h) (((b) * 2 + (h)) * HTB)
#define PG8_SB(b, h) ((4 + (b) * 2 + (h)) * HTB)
#define PG8_STB(bufoff, gbase) stage2(lds, (bufoff) + ldsw, (gbase), voff[0], voff[1])
#define PG8_STA(bufoff, dbase, gko, g0, g1) do { if (GATHER) stage2(lds, (bufoff) + ldsw, Ag + (gko), (g0), (g1)); else stage2(lds, (bufoff) + ldsw, (dbase), voff[0], voff[1]); } while (0)
#define PG8_LDA(dst, b, h) do { if constexpr (FP8) { _Pragma("unroll") for (int m = 0; m < 4; ++m) { const u32x4v lo_ = *(const LAS u32x4v*)(lds + PG8_SA(b, h) + aoff + m * 2048), hi_ = *(const LAS u32x4v*)(lds + PG8_SA(b, h) + aoff + m * 2048 + 16); \
            dst##8[m] = (v8i){(int)lo_.x, (int)lo_.y, (int)lo_.z, (int)lo_.w, (int)hi_.x, (int)hi_.y, (int)hi_.z, (int)hi_.w}; } } \
        else { _Pragma("unroll") for (int m = 0; m < 4; ++m) _Pragma("unroll") for (int k = 0; k < 2; ++k) dst[m][k] = *(const LAS f16x8*)(lds + PG8_SA(b, h) + aoff + m * 2048 + k * 1024); } } while (0)
#define PG8_LDB(dst, b, h) do { if constexpr (FP8) { _Pragma("unroll") for (int n = 0; n < 2; ++n) { const u32x4v lo_ = *(const LAS u32x4v*)(lds + PG8_SB(b, h) + boff + n * 2048), hi_ = *(const LAS u32x4v*)(lds + PG8_SB(b, h) + boff + n * 2048 + 16); \
            dst##8[n] = (v8i){(int)lo_.x, (int)lo_.y, (int)lo_.z, (int)lo_.w, (int)hi_.x, (int)hi_.y, (int)hi_.z, (int)hi_.w}; } } \
        else { _Pragma("unroll") for (int n = 0; n < 2; ++n) _Pragma("unroll") for (int k = 0; k < 2; ++k) dst[n][k] = *(const LAS f16x8*)(lds + PG8_SB(b, h) + boff + n * 2048 + k * 1024); } } while (0)
#define PG8_MMA(ai, bj, At, Bt, Z) do { __builtin_amdgcn_s_setprio(1); if constexpr (FP8) { _Pragma("unroll") for (int m = 0; m < 4; ++m) _Pragma("unroll") for (int n = 0; n < 2; ++n) { \
            if (Z) asm volatile("v_mfma_scale_f32_16x16x128_f8f6f4 %0, %1, %2, 0, %3, %4 op_sel_hi:[0,0,0]" : "=&v"(acc[ai][bj][m][n]) : "v"(Bt##8[n]), "v"(At##8[m]), "v"(scaleW), "v"(scaleA)); \
            else asm volatile("v_mfma_scale_f32_16x16x128_f8f6f4 %0, %1, %2, %0, %3, %4 op_sel_hi:[0,0,0]" : "+v"(acc[ai][bj][m][n]) : "v"(Bt##8[n]), "v"(At##8[m]), "v"(scaleW), "v"(scaleA)); } } \
        else { _Pragma("unroll") for (int m = 0; m < 4; ++m) _Pragma("unroll") for (int n = 0; n < 2; ++n) { \
            acc[ai][bj][m][n] = __builtin_amdgcn_mfma_f32_16x16x32_f16(Bt[n][0], At[m][0], (Z) ? (f32x4){0.f, 0.f, 0.f, 0.f} : acc[ai][bj][m][n], 0, 0, 0); \
            acc[ai][bj][m][n] = __builtin_amdgcn_mfma_f32_16x16x32_f16(Bt[n][1], At[m][1], acc[ai][bj][m][n], 0, 0, 0); } } __builtin_amdgcn_s_setprio(0); } while (0)
#define PG8_WAIT_V(n) asm volatile("s_waitcnt vmcnt(" #n ")" ::: "memory")
#define PG8_WAIT_L(n) asm volatile("s_waitcnt lgkmcnt(" #n ")" ::: "memory")
#define PG8_BAR __builtin_amdgcn_s_barrier()
#define PG8_SCHED __builtin_amdgcn_sched_barrier(0)
    LAS unsigned* const sideR = (LAS unsigned*)(lds + STAGE_BYTES), * const sideE = (LAS unsigned*)(lds + STAGE_BYTES + 2048), * const sideT = (LAS unsigned*)(lds + STAGE_BYTES + 2560);
    GUnit cur, nxt, nn; int ui = 0; bool sc = false;
    if (!S.next(0, cur)) return;
    if constexpr (Sched::HAS_E) cur.B = S.bptr(cur, __builtin_amdgcn_readfirstlane(*S.eptr(cur)));
    unsigned cg0[2] = {0, 0}, cg1[2] = {0, 0}, ng0[2] = {0, 0}, ng1[2] = {0, 0};
    if (GATHER) {
#pragma unroll
        for (int i = 0; i < 2; ++i) { cg0[i] = (unsigned)tok[cur.pm * 256 + sR[i]] * (unsigned)PB + sC2[i]; cg1[i] = (unsigned)tok[cur.pm * 256 + 128 + sR[i]] * (unsigned)PB + sC2[i]; }
    }
#define PG8_SIDE_NEXT(u_, slot_) do { \
        if (Sched::HAS_E && wid == 4) __builtin_amdgcn_global_load_lds((const unsigned*)S.eptr(u_), sideE + (slot_) * 64, 4, 0, 0); \
        if (GATHER && wid >= 4) __builtin_amdgcn_global_load_lds((const unsigned*)tok + (u_).pm * 256 + (wid - 4) * 64 + lane, sideT + (slot_) * 256 + (wid - 4) * 64, 4, 0, 0); } while (0)
    if ((Sched::HAS_E || GATHER) && S.next(1, nxt)) PG8_SIDE_NEXT(nxt, 1);
    f32x4 acc[2][2][4][2];
    f16x8 At[4][2], B0[2][2], B1[2][2]; v8i At8[4], B08[2], B18[2];
    const char* cA = cur.A; const char* cB = cur.B;
    PG8_STB(PG8_SB(0, 0), cB); PG8_STB(PG8_SB(0, 1), cB + hstep); PG8_STA(PG8_SA(0, 0), cA, 0, cg0[0], cg0[1]); PG8_STA(PG8_SA(0, 1), cA + hstep, 0, cg1[0], cg1[1]);
    if (wr == 1) PG8_BAR;
    PG8_WAIT_V(2); PG8_BAR;
    PG8_STB(PG8_SB(1, 0), cB + kstep); PG8_STA(PG8_SA(1, 0), cA + kstep, kstep, cg0[0], cg0[1]); PG8_STB(PG8_SB(1, 1), cB + hstep + kstep);
    PG8_WAIT_V(0); PG8_BAR;
    for (;;) {
        const bool has_next = S.next(ui + 1, nxt);
        if (has_next) {
            if constexpr (Sched::HAS_E) nxt.B = S.bptr(nxt, __builtin_amdgcn_readfirstlane((int)sideE[((ui + 1) & 1) * 64]));
            if (GATHER) {
#pragma unroll
                for (int i = 0; i < 2; ++i) { ng0[i] = sideT[((ui + 1) & 1) * 256 + sR[i]] * (unsigned)PB + sC2[i]; ng1[i] = sideT[((ui + 1) & 1) * 256 + 128 + sR[i]] * (unsigned)PB + sC2[i]; }
            }
        } else { ng0[0] = cg0[0]; ng0[1] = cg0[1]; ng1[0] = cg1[0]; ng1[1] = cg1[1]; }
        if (rowarg != nullptr && wid < 4) __builtin_amdgcn_global_load_lds(rowarg + cur.pm * 256 + wid * 64 + lane, sideR + (ui & 1) * 256 + wid * 64, 4, 0, 0);
        if ((Sched::HAS_E || GATHER) && has_next && S.next(ui + 2, nn)) PG8_SIDE_NEXT(nn, ui & 1);
        const char* nA = has_next ? nxt.A : cA; const char* nB = has_next ? nxt.B : cB;
        const bool sn = ARES && has_next && nxt.pm == cur.pm;
#define PG8_ITER(FIRST) do { \
            const bool last = (t == nt - 2); \
            const size_t ko1 = (size_t)(t + 1) * kstep, ko2 = last ? 0 : (size_t)(t + 2) * kstep, ko3 = ko2 + kstep; \
            const char* a1 = cA + ko1; \
            const char* a2 = (last ? nA : cA) + ko2; const char* b2 = (last ? nB : cB) + ko2; \
            const char* a3 = a2 + kstep; const char* b3 = b2 + kstep; \
            const unsigned g20 = last ? ng0[0] : cg0[0], g21 = last ? ng0[1] : cg0[1], h20 = last ? ng1[0] : cg1[0], h21 = last ? ng1[1] : cg1[1]; \
              \
            PG8_LDB(B0, 0, 0); PG8_LDB(B1, 0, 1); PG8_SCHED; PG8_LDA(At, 0, 0); if (!(ARES && sc)) PG8_STA(PG8_SA(1, 1), a1 + hstep, ko1, cg1[0], cg1[1]); \
            if (!(FIRST)) PG8_WAIT_V(8); PG8_WAIT_L(0); PG8_BAR; PG8_MMA(0, 0, At, B0, FIRST); PG8_MMA(0, 1, At, B1, FIRST); PG8_BAR; PG8_SCHED; \
              \
            PG8_LDA(At, 0, 1); PG8_STB(PG8_SB(0, 0), b2); PG8_STB(PG8_SB(0, 1), b2 + hstep); if (!(ARES && sn)) PG8_STA(PG8_SA(0, 0), a2, ko2, g20, g21); \
            if (!(FIRST)) PG8_WAIT_V(8); PG8_WAIT_L(0); PG8_BAR; PG8_MMA(1, 0, At, B0, FIRST); PG8_MMA(1, 1, At, B1, FIRST); PG8_BAR; PG8_SCHED; \
              \
            PG8_LDB(B0, 1, 0); PG8_LDB(B1, 1, 1); PG8_SCHED; PG8_LDA(At, 1, 0); if (!(ARES && sn)) PG8_STA(PG8_SA(0, 1), a2 + hstep, ko2, h20, h21); \
            if (ARES && sn) PG8_WAIT_V(4); else PG8_WAIT_V(8); PG8_WAIT_L(0); PG8_BAR; PG8_MMA(0, 0, At, B0, 0); PG8_MMA(0, 1, At, B1, 0); PG8_BAR; PG8_SCHED; \
              \
            PG8_LDA(At, 1, 1); PG8_STB(PG8_SB(1, 0), b3); PG8_STB(PG8_SB(1, 1), b3 + hstep); if (!(ARES && sn)) PG8_STA(PG8_SA(1, 0), a3, ko3, g20, g21); \
            if (ARES && sn) PG8_WAIT_V(4); else PG8_WAIT_V(8); PG8_WAIT_L(0); PG8_BAR; PG8_MMA(1, 0, At, B0, 0); PG8_MMA(1, 1, At, B1, 0); PG8_BAR; PG8_SCHED; \
        } while (0)
        { const int t = 0; PG8_ITER(1); }
#pragma unroll 1
        for (int t = 2; t < nt; t += 2) PG8_ITER(0);
        if constexpr (FP8) {
#pragma unroll
            for (int a_ = 0; a_ < 2; ++a_)
#pragma unroll
                for (int b_ = 0; b_ < 2; ++b_)
                    asm volatile("s_nop 15\n\ts_nop 7" : "+v"(acc[a_][b_][0][0]), "+v"(acc[a_][b_][0][1]), "+v"(acc[a_][b_][1][0]), "+v"(acc[a_][b_][1][1]), "+v"(acc[a_][b_][2][0]), "+v"(acc[a_][b_][2][1]), "+v"(acc[a_][b_][3][0]), "+v"(acc[a_][b_][3][1]));
        }
        PG8_WAIT_V(0);
        if (wr == 0) PG8_BAR;
        { int fr_e = fr, fq_e = fq; asm volatile("" : "+v"(fr_e), "+v"(fq_e));
          E(acc, cur, wr, wc, fr_e, fq_e, (const LAS unsigned*)(sideR + (ui & 1) * 256)); }
        if (!has_next) break;
        cur = nxt; cA = nA; cB = nB; ++ui; sc = sn;
        cg0[0] = ng0[0]; cg0[1] = ng0[1]; cg1[0] = ng1[0]; cg1[1] = ng1[1];
        if (wr == 1) PG8_BAR;
    }
    PG8_WAIT_V(0);
    PG8_BAR;
#undef PG8_SA
#undef PG8_SB
#undef PG8_STB
#undef PG8_STA
#undef PG8_LDA
#undef PG8_LDB
#undef PG8_MMA
#undef PG8_ITER
#undef PG8_SIDE_NEXT
#undef PG8_WAIT_V
#undef PG8_WAIT_L
#undef PG8_BAR
#undef PG8_SCHED
}

DEV void swap16(unsigned& a, unsigned& b) { const auto r = __builtin_amdgcn_permlane16_swap(a, b, false, false); a = r[0]; b = r[1]; }
DEV void swap32(unsigned& a, unsigned& b) { const auto r = __builtin_amdgcn_permlane32_swap(a, b, false, false); a = r[0]; b = r[1]; }
typedef _Float16 f16x2v __attribute__((ext_vector_type(2)));
DEV unsigned pkh(float a, float b) { f16x2v t; t.x = (f16)a; t.y = (f16)b; return __builtin_bit_cast(unsigned, t); }
DEV unsigned pkb(float a, float b) { typedef __bf16 bfx2 __attribute__((ext_vector_type(2))); typedef float fx2 __attribute__((ext_vector_type(2))); const fx2 v = {a, b}; return __builtin_bit_cast(unsigned, __builtin_convertvector(v, bfx2)); }
DEV void store_pair16b(f16* rowbase, const f32x4 v0, const f32x4 v1, int fq) {
    unsigned al = pkb(v0.x, v0.y), ah = pkb(v0.z, v0.w), bl = pkb(v1.x, v1.y), bh = pkb(v1.z, v1.w);
    swap16(al, bl); swap16(ah, bh);
    const int co = (fq & 1) ? 16 + 4 * (fq - 1) : 4 * fq;
    *(uint4*)(rowbase + co) = make_uint4(al, ah, bl, bh);
}
DEV void store_pair16(f16* rowbase, const f32x4 v0, const f32x4 v1, int fq) {
    unsigned al = pkh(v0.x, v0.y), ah = pkh(v0.z, v0.w), bl = pkh(v1.x, v1.y), bh = pkh(v1.z, v1.w);
    swap16(al, bl); swap16(ah, bh);
    const int co = (fq & 1) ? 16 + 4 * (fq - 1) : 4 * fq;
    *(uint4*)(rowbase + co) = make_uint4(al, ah, bl, bh);
}
struct EpiPlain {
    f16* O; int ldc;
    DEV void operator()(const f32x4 (&acc)[2][2][4][2], const GUnit& u, int wr, int wc, int fr, int fq, const LAS unsigned* side) const {
#pragma unroll
        for (int ai = 0; ai < 2; ++ai)
#pragma unroll
            for (int m = 0; m < 4; ++m) { f16* rowp = O + (size_t)(u.pm * BM + ai * HALF + wr * 64 + m * 16 + fr) * ldc + u.pn * BM + wc * 32;
#pragma unroll
                for (int bj = 0; bj < 2; ++bj) store_pair16(rowp + bj * HALF, acc[ai][bj][m][0], acc[ai][bj][m][1], fq); }
    }
};
struct EpiInProj {
    f16* O; const LAS float* qg; const LAS float* kg; const LAS float* rope;
    DEV void operator()(f32x4 (&acc)[2][2][4][2], const GUnit& u, int wr, int wc, int fr, int fq, const LAS unsigned* side) const {
        const int pn = u.pn, seg = u.pm % 9; const bool latent = seg > 0;
        const bool isq = (pn < 2) || (pn == 6) || (pn == 7);
        const bool isk = (pn == 2) || (pn == 3) || (pn == 8 && wc < 2);
        const bool norm = (pn == 6) || (pn == 7) || (pn == 8 && wc < 2);
        const bool isv = (pn == 4) || (pn == 5) || (pn == 8 && wc >= 2);
        if (norm) {
            const LAS float* g = isq ? qg : kg;
            f32x4 gv[2][2];
#pragma unroll
            for (int bj = 0; bj < 2; ++bj)
#pragma unroll
                for (int n = 0; n < 2; ++n) gv[bj][n] = *(const LAS f32x4*)(g + 32 * bj + 16 * n + 4 * fq);
#pragma unroll
            for (int ai = 0; ai < 2; ++ai)
#pragma unroll
                for (int m = 0; m < 4; ++m) {
                    float ss = 0.f;
#pragma unroll
                    for (int bj = 0; bj < 2; ++bj)
#pragma unroll
                        for (int n = 0; n < 2; ++n) { const f32x4 v = acc[ai][bj][m][n]; ss += v.x * v.x + v.y * v.y + v.z * v.z + v.w * v.w; }
                    ss += __shfl_xor(ss, 16); ss += __shfl_xor(ss, 32);
                    const float rstd = rsqrtf(ss * (1.f / 64.f) + EPS);
#pragma unroll
                    for (int bj = 0; bj < 2; ++bj)
#pragma unroll
                        for (int n = 0; n < 2; ++n) acc[ai][bj][m][n] = acc[ai][bj][m][n] * rstd * gv[bj][n];
                }
        }
        if ((isq || isk) && latent) {
            const int s0 = (seg - 1) * 256;
#pragma unroll
            for (int ai = 0; ai < 2; ++ai) {
                const int prow = (s0 + ai * HALF + wr * 64) >> 6;
                const f32x4 r0 = *(const LAS f32x4*)(rope + (prow * 16 + 4 * fq) * 2), r1 = *(const LAS f32x4*)(rope + (prow * 16 + 4 * fq) * 2 + 4);
                const float rc[4] = {r0.x, r0.z, r1.x, r1.z}, rs[4] = {r0.y, r0.w, r1.y, r1.w};
#pragma unroll
                for (int m = 0; m < 4; ++m) {
                    const int pcol = m * 16 + fr;
                    const f32x4 c0 = *(const LAS f32x4*)(rope + (pcol * 16 + 4 * fq) * 2), c1 = *(const LAS f32x4*)(rope + (pcol * 16 + 4 * fq) * 2 + 4);
                    const float cc[4] = {c0.x, c0.z, c1.x, c1.z}, cs[4] = {c0.y, c0.w, c1.y, c1.w};
#pragma unroll
                    for (int q = 0; q < 4; ++q) {
                        const float a = acc[ai][0][m][0][q], b = acc[ai][0][m][1][q]; acc[ai][0][m][0][q] = a * rc[q] - b * rs[q]; acc[ai][0][m][1][q] = a * rs[q] + b * rc[q];
                        const float a2 = acc[ai][1][m][0][q], b2 = acc[ai][1][m][1][q]; acc[ai][1][m][0][q] = a2 * cc[q] - b2 * cs[q]; acc[ai][1][m][1][q] = a2 * cs[q] + b2 * cc[q];
                    }
                }
            }
        }
        const float sc = isq ? QSCALE : 1.f;
#pragma unroll
        for (int ai = 0; ai < 2; ++ai)
#pragma unroll
            for (int m = 0; m < 4; ++m) { f16* rowp = O + (size_t)(u.pm * BM + ai * HALF + wr * 64 + m * 16 + fr) * NIN + pn * BM + wc * 64;
#pragma unroll
                for (int bj = 0; bj < 2; ++bj) { if (isv) store_pair16b(rowp + bj * 32, acc[ai][bj][m][0], acc[ai][bj][m][1], fq); else store_pair16(rowp + bj * 32, acc[ai][bj][m][0] * sc, acc[ai][bj][m][1] * sc, fq); } }
    }
};
struct EpiGU {
    unsigned char* H; const float* wsl;
    DEV void operator()(const f32x4 (&acc)[2][2][4][2], const GUnit& u, int wr, int wc, int fr, int fq, const LAS unsigned* side) const {
#pragma unroll
        for (int ai = 0; ai < 2; ++ai)
#pragma unroll
            for (int m = 0; m < 4; ++m) { const int rl = ai * HALF + wr * 64 + m * 16 + fr, row = u.pm * BM + rl; const float w = __builtin_bit_cast(float, side[rl]) * 4.0f; unsigned char* rowp = H + (size_t)row * EH + u.pn * 128 + wc * 32;
                unsigned d[2];
#pragma unroll
                for (int n = 0; n < 2; ++n) { const f32x4 g = acc[ai][0][m][n], up = acc[ai][1][m][n];
                    int q = __builtin_amdgcn_cvt_pk_fp8_f32(c8(silu_f(g.x) * up.x * w), c8(silu_f(g.y) * up.y * w), 0, false); q = __builtin_amdgcn_cvt_pk_fp8_f32(c8(silu_f(g.z) * up.z * w), c8(silu_f(g.w) * up.w * w), q, true); d[n] = (unsigned)q; }
                swap16(d[0], d[1]);
                const int co = (fq & 1) ? 16 + 4 * (fq - 1) : 4 * fq;
                *(uint2*)(rowp + co) = make_uint2(d[0], d[1]); }
    }
};
struct EpiDown {
    unsigned char* Y; const int* pair;
    DEV void operator()(const f32x4 (&acc)[2][2][4][2], const GUnit& u, int wr, int wc, int fr, int fq, const LAS unsigned* side) const {
#pragma unroll
        for (int ai = 0; ai < 2; ++ai)
#pragma unroll
            for (int m = 0; m < 4; ++m) { const int pr = (int)side[ai * HALF + wr * 64 + m * 16 + fr];
                unsigned d[4];
#pragma unroll
                for (int bj = 0; bj < 2; ++bj)
#pragma unroll
                    for (int n = 0; n < 2; ++n) { const f32x4 v = acc[ai][bj][m][n]; int w = __builtin_amdgcn_cvt_pk_fp8_f32(c8(v.x), c8(v.y), 0, false); w = __builtin_amdgcn_cvt_pk_fp8_f32(c8(v.z), c8(v.w), w, true); d[bj * 2 + n] = (unsigned)w; }
                swap32(d[0], d[2]); swap32(d[1], d[3]); swap16(d[0], d[1]); swap16(d[2], d[3]);
                if (pr >= 0) *(uint4*)(Y + (size_t)pr * DM + u.pn * BM + wc * 64 + 16 * fq) = make_uint4(d[0], d[1], d[2], d[3]); }
    }
};
struct SchedInProj {
    const char* A; const char* B; int v, G;
    static constexpr bool HAS_E = false;
    DEV bool next(int i, GUnit& u) const {
        const int L = i * G + v; if (L >= 2304 + 160) return false;
        if (L < 2304) { const int pl = L / 9; u.pn = L % 9; u.pm = (pl >> 3) * 9 + 1 + (pl & 7); }
        else { const int Lc = L - 2304, q = Lc % 5; u.pm = (Lc / 5) * 9; u.pn = q < 4 ? 2 + q : 8; }
        u.A = A + (size_t)u.pm * 256 * DM * 2; u.B = B + (size_t)u.pn * 256 * DM * 2; u.aux = 0; return true;
    }
    DEV const int* eptr(const GUnit&) const { return nullptr; }
    DEV const char* bptr(const GUnit& u, int) const { return u.B; }
};
struct SchedDense {
    const char* A; const char* B; int v, G, nunits, ntn, K;
    static constexpr bool HAS_E = false;
    DEV bool next(int i, GUnit& u) const {
        const int L = i * G + v; if (L >= nunits) return false;
        u.pm = L / ntn; u.pn = L % ntn; u.A = A + (size_t)u.pm * 256 * K * 2; u.B = B + (size_t)u.pn * 256 * K * 2; u.aux = 0; return true;
    }
    DEV const int* eptr(const GUnit&) const { return nullptr; }
    DEV const char* bptr(const GUnit& u, int) const { return u.B; }
};
struct SchedGrouped {
    const char* A; const char* B; const int* blke; int v, G, nunits, ntn, K; size_t estride; int seq;
    static constexpr bool HAS_E = true;
    DEV bool next(int i, GUnit& u) const {
        if (seq) {
            const int nb = nunits / ntn, rf = nb / G, nf = rf * ntn;
            if (i < nf) { u.pm = (i / ntn) * G + v; u.pn = i % ntn; }
            else { const int L = (i - nf) * G + v; if (L >= (nb - rf * G) * ntn) return false; u.pm = rf * G + L / ntn; u.pn = L % ntn; }
        } else { const int L = i * G + v; if (L >= nunits) return false; u.pm = L / ntn; u.pn = L % ntn; }
        u.aux = 0; u.A = A + (size_t)u.pm * 256 * K * 2; u.B = nullptr; return true;
    }
    DEV const int* eptr(const GUnit& u) const { return blke + u.pm; }
    DEV const char* bptr(const GUnit& u, int e) const { return B + (size_t)e * estride + (size_t)u.pn * 256 * K * 2; }
};
}

namespace attn_body {
using bf16=_Float16;
using bf16x8=__attribute__((ext_vector_type(8)))short;
using s16x4=__attribute__((ext_vector_type(4)))short;
using f32x16=__attribute__((ext_vector_type(16)))float;
using u32x4=__attribute__((ext_vector_type(4)))unsigned;
using h16x8=__attribute__((ext_vector_type(8)))_Float16;
__device__ __forceinline__ f32x16 mf16(bf16x8 a,bf16x8 b,f32x16 c,int,int,int){return __builtin_amdgcn_mfma_f32_32x32x16_f16(__builtin_bit_cast(h16x8,a),__builtin_bit_cast(h16x8,b),c,0,0,0);}
constexpr int D=64,DM=2304;
constexpr int NW=8,QBLK=32,QB=QBLK*NW,KVBLK=64;
__device__ __forceinline__ int crow(int r,int hi){return (r&3)+8*(r>>2)+4*hi;}
#define SBAR() __builtin_amdgcn_sched_barrier(0)
__device__ __forceinline__ void cmask(f32x16&p0,f32x16&p1,int jb,int qrel,int hi){
  const float NEG=-INFINITY; int kb=64*jb+4*hi;
  #pragma unroll
  for(int r=0;r<16;++r){int kv=kb+(r&3)+8*(r>>2); if(kv>qrel)p0[r]=NEG; if(kv+32>qrel)p1[r]=NEG;}
}

constexpr int NSLOT=3, SLOTB=8192;
constexpr int LDS_K=0, LDS_V=NSLOT*SLOTB, LDS_WS=2*NSLOT*SLOTB, LDS_OST=LDS_WS+NW*64*4, LDS_BYTES=LDS_OST+NW*4096;
constexpr float C2=0.125f*1.4426950408889634f;
__device__ __forceinline__ void glds16(const void*gsrc,unsigned lds_dst){unsigned keep;
  asm volatile("s_mov_b32 %0, m0\n\ts_mov_b32 m0, %2\n\ts_nop 0\n\tglobal_load_lds_dwordx4 %1, off\n\ts_mov_b32 m0, %0":"=&s"(keep):"v"(gsrc),"s"(lds_dst):"memory");}
__device__ __forceinline__ float max3f(float a,float b,float c){float r;asm("v_max3_f32 %0, %1, %2, %3":"=v"(r):"v"(a),"v"(b),"v"(c));return r;}
__device__ __forceinline__ float max2f(float a,float b){float r;asm("v_max_f32_e32 %0, %1, %2":"=v"(r):"v"(a),"v"(b));return r;}
__device__ __forceinline__ float fadd_s(float a,float b){float r;asm("v_add_f32_e32 %0, %1, %2":"=v"(r):"v"(a),"v"(b));return r;}
__device__ __forceinline__ float fsub_s(float a,float b){float r;asm("v_sub_f32_e32 %0, %1, %2":"=v"(r):"v"(a),"v"(b));return r;}
typedef float f32x2_t __attribute__((ext_vector_type(2))); typedef _Float16 bf16x2_t __attribute__((ext_vector_type(2)));
__device__ __forceinline__ unsigned cvtpk_s(float lo,float hi){f32x2_t v={lo,hi};bf16x2_t b=__builtin_convertvector(v,bf16x2_t);return __builtin_bit_cast(unsigned,b);}
typedef __bf16 rbf16x2_t __attribute__((ext_vector_type(2))); typedef __bf16 rbf16x8_t __attribute__((ext_vector_type(8)));
__device__ __forceinline__ unsigned cvtpk_b(float lo,float hi){f32x2_t v={lo,hi};rbf16x2_t b=__builtin_convertvector(v,rbf16x2_t);return __builtin_bit_cast(unsigned,b);}
__device__ __forceinline__ f32x16 mfb16(bf16x8 a,bf16x8 b,f32x16 c,int,int,int){return __builtin_amdgcn_mfma_f32_32x32x16_bf16(__builtin_bit_cast(rbf16x8_t,a),__builtin_bit_cast(rbf16x8_t,b),c,0,0,0);}
#define WAIT_BAR(N) asm volatile("s_waitcnt vmcnt(" #N ") lgkmcnt(0)\n\ts_barrier":::"memory")

__device__ __forceinline__ void qkt(f32x16&p0,f32x16&p1,const char*Kslot,const bf16x8*qr,const f32x16&negm,int r32,int hi){
  const char*kb=Kslot+hi*1024+r32*16;
  #pragma unroll
  for(int d0=0;d0<4;++d0){
    const bf16x8 b0=*reinterpret_cast<const bf16x8*>(kb+d0*2048);
    const bf16x8 b1=*reinterpret_cast<const bf16x8*>(kb+d0*2048+512);
    if(d0==0){p0=mf16(b0,qr[0],negm,0,0,0);p1=mf16(b1,qr[0],negm,0,0,0);}
    else{p0=mf16(b0,qr[d0],p0,0,0,0);p1=mf16(b1,qr[d0],p1,0,0,0);}}
}
typedef __attribute__((address_space(3))) const char* lds_cptr;
typedef short v4i16_t __attribute__((ext_vector_type(4)));
__device__ __forceinline__ void kload8(bf16x8*kf,lds_cptr kp){
  kf[0]=*(const __attribute__((address_space(3))) bf16x8*)(kp);      kf[1]=*(const __attribute__((address_space(3))) bf16x8*)(kp+512);
  kf[2]=*(const __attribute__((address_space(3))) bf16x8*)(kp+2048); kf[3]=*(const __attribute__((address_space(3))) bf16x8*)(kp+2560);
  kf[4]=*(const __attribute__((address_space(3))) bf16x8*)(kp+4096); kf[5]=*(const __attribute__((address_space(3))) bf16x8*)(kp+4608);
  kf[6]=*(const __attribute__((address_space(3))) bf16x8*)(kp+6144); kf[7]=*(const __attribute__((address_space(3))) bf16x8*)(kp+6656);
}
__device__ __forceinline__ void kload2(bf16x8*kf,lds_cptr kp,int j){ kf[2*j]=*(const __attribute__((address_space(3))) bf16x8*)(kp+j*2048); kf[2*j+1]=*(const __attribute__((address_space(3))) bf16x8*)(kp+j*2048+512); }
__device__ __forceinline__ s16x4 vtr(lds_cptr p){ return __builtin_bit_cast(s16x4,__builtin_amdgcn_ds_read_tr16_b64_v4i16((__attribute__((address_space(3))) v4i16_t*)p)); }
__device__ __forceinline__ float rowmax(const f32x16&p0,const f32x16&p1){
  float a=max3f(p0[0],p0[1],p1[0]),b=max3f(p0[2],p0[3],p1[1]);a=max3f(a,p1[2],p1[3]);
  #pragma unroll
  for(int r=4;r<16;r+=4){a=max3f(a,p0[r],p0[r+1]);b=max3f(b,p0[r+2],p0[r+3]);a=max3f(a,p1[r],p1[r+1]);b=max3f(b,p1[r+2],p1[r+3]);}
  const float m=max2f(a,b);
  auto rr=__builtin_amdgcn_permlane32_swap(__float_as_uint(m),__float_as_uint(m),false,false);
  return max2f(__uint_as_float(rr[0]),__uint_as_float(rr[1]));
}
__device__ __forceinline__ void pv(f32x16*o,int vb,bf16x8 pa0,bf16x8 pa1,bf16x8 pa2,bf16x8 pa3){
  #pragma unroll
  for(int d0=0;d0<2;++d0){s16x4 lo[4],hi[4];
    #pragma unroll
    for(int ks=0;ks<4;++ks){
      asm volatile("ds_read_b64_tr_b16 %0,%1 offset:%c2":"=&v"(lo[ks]):"v"(vb),"i"(d0*4096+ks*1024):"memory");
      asm volatile("ds_read_b64_tr_b16 %0,%1 offset:%c2":"=&v"(hi[ks]):"v"(vb),"i"(d0*4096+ks*1024+512):"memory");}
    asm volatile("s_waitcnt lgkmcnt(0)":::"memory");SBAR();
    #define PK(k) (bf16x8){lo[k][0],lo[k][1],lo[k][2],lo[k][3],hi[k][0],hi[k][1],hi[k][2],hi[k][3]}
    o[d0]=mfb16(pa0,PK(0),o[d0],0,0,0);
    o[d0]=mfb16(pa1,PK(1),o[d0],0,0,0);
    o[d0]=mfb16(pa2,PK(2),o[d0],0,0,0);
    o[d0]=mfb16(pa3,PK(3),o[d0],0,0,0);
    #undef PK
  }
}

#ifndef ATTN_STORE16
#define ATTN_STORE16(p,v) (*(u32x4*)(p)=(v))
#endif
template<int THRL> __device__ __forceinline__ void attn_unit(const bf16*Qu,const bf16*__restrict__ Kh,const bf16*__restrict__ Vh,bf16*Ou,int opitch,char*shm){
  const int tid=threadIdx.x,lane=tid&63,r32=lane&31,hi=lane>>5; const int wid=__builtin_amdgcn_readfirstlane(tid>>6);
  const bf16*Qw=Qu+(long)(wid*QBLK)*DM;
  const unsigned lds0=(unsigned)(uintptr_t)shm;
  float*wsf=(float*)(shm+LDS_WS)+wid*64;
  const bf16*ksrc=Kh+(long)lane*DM+wid*8;
  const bf16*vsrc=Vh+(long)(16*(wid&3)+(lane>>2))*DM+(wid>>2)*32+(lane&3)*8;
  const unsigned kdst=lds0+LDS_K+wid*1024, vdst=lds0+LDS_V+wid*1024;
  #define DMA_K(t,slot) glds16(ksrc+(long)(t)*KVBLK*DM,(unsigned)__builtin_amdgcn_readfirstlane(kdst+(slot)))
  #define DMA_V(t,slot) glds16(vsrc+(long)(t)*KVBLK*DM,(unsigned)__builtin_amdgcn_readfirstlane(vdst+(slot)))
  const int vb0=(int)(lds0+LDS_V)+((lane>>4)&1)*32+(lane&3)*8+(4*hi+((lane&15)>>2))*64;
  const char*Kbase=shm+LDS_K; bf16x8 kf[8];
  const lds_cptr shm3=(lds_cptr)shm; const lds_cptr kp0=shm3+LDS_K+hi*1024+r32*16; const lds_cptr vp0=shm3+LDS_V+((lane>>4)&1)*32+(lane&3)*8+(4*hi+((lane&15)>>2))*64;
  constexpr int NT=36;
  DMA_K(0,0);DMA_V(0,0);DMA_K(1,SLOTB);
  bf16x8 qr[4];
  #pragma unroll
  for(int d0=0;d0<4;++d0)qr[d0]=*reinterpret_cast<const bf16x8*>(&Qw[(long)r32*DM+d0*16+hi*8]);
  float l_reg=0.f;f32x16 o[2];o[0]=f32x16{};o[1]=f32x16{};
  #define CMASK(P0,P1,t) do{}while(0)
  #define START(P0,P1) do{ _Pragma("unroll") for(int r=0;r<16;++r)P0[r]=__builtin_amdgcn_exp2f(P0[r]); }while(0)
  #define RESC() do{}while(0)
  f32x16 pA0,pA1,pB0,pB1;
  int sl_prev=0,sl_cur=0,sl_next=SLOTB;
  #define ROT() do{sl_prev=sl_cur;sl_cur=sl_next;sl_next=(sl_next==(NSLOT-1)*SLOTB)?0:sl_next+SLOTB;}while(0)
  DMA_K(2,2*SLOTB);
  WAIT_BAR(3);
  qkt(pA0,pA1,Kbase,qr,f32x16{},r32,hi);asm volatile("s_nop 15\n\ts_nop 7":"+v"(pA0),"+v"(pA1));CMASK(pA0,pA1,0);
  START(pA0,pA1);
  _Pragma("unroll") for(int r=0;r<16;++r)pA1[r]=__builtin_amdgcn_exp2f(pA1[r]);
  WAIT_BAR(0);
  DMA_K(3,0);DMA_V(1,SLOTB);
  ROT();
  kload8(kf,kp0+sl_cur);
  WAIT_BAR(2);
  s16x4 vlo[8],vhi[8]; u32x4 pw0,pw1,pw2,pw3;
  #define PKW(P,B) cvtpk_b(P[B],P[B+1])
  #define PAF(k) __builtin_bit_cast(bf16x8,pw##k)
  #define VFR(i) (bf16x8){vlo[i][0],vlo[i][1],vlo[i][2],vlo[i][3],vhi[i][0],vhi[i][1],vhi[i][2],vhi[i][3]}
  #define PIN(x) asm volatile("":"+v"(x))
  #define MX3(a,b,c) __builtin_fmaxf(__builtin_fmaxf((a),(b)),(c))
  #define GAPA(MF,A0,A1,A2,A3,W0,W1,PW) do{ MF; sacc+=A0; sacc+=A1; sacc+=A2; sacc+=A3; PIN(sacc); W0; W1; PIN(PW); SBAR(); }while(0)
  #define EX(v) __builtin_amdgcn_exp2f(v)
  #define GAPB(MF,X,B) do{ MF; X[B]=EX(X[B]); X[B+1]=EX(X[B+1]); X[B+2]=EX(X[B+2]); X[B+3]=EX(X[B+3]); PIN(X); SBAR(); }while(0)
  #define VRD(i) do{ vlo[i]=vtr(vp_+(((i)>>2)*4096+((i)&3)*1024)); vhi[i]=vtr(vp_+(((i)>>2)*4096+((i)&3)*1024+512)); }while(0)
  #define KRD(G,j) do{ if(G){ kload2(kf,kp0+sl_next,j); SBAR(); } }while(0)
  #define STEP(C0,C1,P0,P1,t,GK,GV,GL) do{ SBAR(); \
    const lds_cptr vp_=vp0+sl_prev; \
    VRD(0); SBAR(); float sacc=(P0[0]+P0[1]); \
    GAPA(C0=mf16(kf[0],qr[0],f32x16{},0,0,0), P0[2],P0[3],P0[4],P0[5],     pw0[0]=PKW(P0,0), pw0[1]=PKW(P0,2), pw0); \
    VRD(4); SBAR(); GAPA(C1=mf16(kf[1],qr[0],f32x16{},0,0,0), P0[6],P0[7],P0[8],P0[9],     pw0[2]=PKW(P0,4), pw0[3]=PKW(P0,6), pw0); \
    VRD(1); SBAR(); GAPA(C0=mf16(kf[2],qr[1],C0,0,0,0),   P0[10],P0[11],P0[12],P0[13], pw1[0]=PKW(P0,8), pw1[1]=PKW(P0,10), pw1); \
    VRD(5); SBAR(); GAPA(C1=mf16(kf[3],qr[1],C1,0,0,0),   P0[14],P0[15],P1[0],P1[1],   pw1[2]=PKW(P0,12),pw1[3]=PKW(P0,14), pw1); \
    VRD(2); SBAR(); GAPA(C0=mf16(kf[4],qr[2],C0,0,0,0),   P1[2],P1[3],P1[4],P1[5],     pw2[0]=PKW(P1,0), pw2[1]=PKW(P1,2), pw2); \
    VRD(6); SBAR(); GAPA(C1=mf16(kf[5],qr[2],C1,0,0,0),   P1[6],P1[7],P1[8],P1[9],     pw2[2]=PKW(P1,4), pw2[3]=PKW(P1,6), pw2); \
    VRD(3); SBAR(); GAPA(C0=mf16(kf[6],qr[3],C0,0,0,0),   P1[10],P1[11],P1[12],P1[13], pw3[0]=PKW(P1,8), pw3[1]=PKW(P1,10), pw3); \
    VRD(7); SBAR(); GAPA(C1=mf16(kf[7],qr[3],C1,0,0,0),   P1[14],P1[15],0.f,0.f,       pw3[2]=PKW(P1,12),pw3[3]=PKW(P1,14), pw3); \
    l_reg+=sacc; \
    if(GK){DMA_K((t)+3,sl_cur);} if(GV){DMA_V((t)+1,sl_next);} \
    SBAR(); \
    GAPB(o[0]=mfb16(PAF(0),VFR(0),o[0],0,0,0), C0,0); \
    GAPB(o[1]=mfb16(PAF(0),VFR(4),o[1],0,0,0), C0,4); \
    KRD(GL,0); GAPB(o[0]=mfb16(PAF(1),VFR(1),o[0],0,0,0), C0,8); \
    KRD(GL,1); GAPB(o[1]=mfb16(PAF(1),VFR(5),o[1],0,0,0), C0,12); \
    KRD(GL,2); GAPB(o[0]=mfb16(PAF(2),VFR(2),o[0],0,0,0), C1,0); \
    KRD(GL,3); GAPB(o[1]=mfb16(PAF(2),VFR(6),o[1],0,0,0), C1,4); \
    GAPB(o[0]=mfb16(PAF(3),VFR(3),o[0],0,0,0), C1,8); \
    GAPB(o[1]=mfb16(PAF(3),VFR(7),o[1],0,0,0), C1,12); \
    }while(0)
  int t=1;
  #undef CMASK
  #define CMASK(P0,P1,t) do{}while(0)
  for(;t+5<NT;t+=2){
    STEP(pB0,pB1,pA0,pA1,t,true,true,true);     WAIT_BAR(2); RESC(); ROT();
    STEP(pA0,pA1,pB0,pB1,t+1,true,true,true);   WAIT_BAR(2); RESC(); ROT();
  }
  #undef CMASK
  #define CMASK(P0,P1,t) do{}while(0)
  #define ENDW(tt) do{ if((tt)+3<NT){WAIT_BAR(2);} else if((tt)+2<NT){WAIT_BAR(1);} else {WAIT_BAR(0);} }while(0)
  for(;t+1<NT;t+=2){
    STEP(pB0,pB1,pA0,pA1,t,(t+3<NT),(t+1<NT),(t+1<NT));       ENDW(t);   RESC(); ROT();
    STEP(pA0,pA1,pB0,pB1,t+1,(t+4<NT),(t+2<NT),(t+2<NT));     ENDW(t+1); RESC(); ROT();
  }
  STEP(pB0,pB1,pA0,pA1,NT-1,false,false,false); RESC();
  { float sacc=pB0[0]+pB0[1]; _Pragma("unroll") for(int r=2;r<16;++r)sacc+=pB0[r]; _Pragma("unroll") for(int r=0;r<16;++r)sacc+=pB1[r]; l_reg+=sacc;
    pw0=(u32x4){PKW(pB0,0),PKW(pB0,2),PKW(pB0,4),PKW(pB0,6)};pw1=(u32x4){PKW(pB0,8),PKW(pB0,10),PKW(pB0,12),PKW(pB0,14)};pw2=(u32x4){PKW(pB1,0),PKW(pB1,2),PKW(pB1,4),PKW(pB1,6)};pw3=(u32x4){PKW(pB1,8),PKW(pB1,10),PKW(pB1,12),PKW(pB1,14)};
    SBAR(); pv(o,vb0+sl_cur,PAF(0),PAF(1),PAF(2),PAF(3)); }
  #undef PKW
  #undef PAF
  #undef VFR
  #undef PIN
  #undef MX3
  #undef GAPA
  #undef GAPB
  #undef EX
  #undef VRD
  #undef KRD
  #undef STEP
  #undef ENDW
  {auto rr=__builtin_amdgcn_permlane32_swap(__float_as_uint(l_reg),__float_as_uint(l_reg),false,false);l_reg=__uint_as_float(rr[0])+__uint_as_float(rr[1]);}
  if(hi==0)wsf[32+r32]=l_reg;asm volatile("s_waitcnt lgkmcnt(0)":::"memory");
  float rli[16];
  #pragma unroll
  for(int r=0;r<16;++r)rli[r]=__builtin_amdgcn_rcpf(wsf[32+crow(r,hi)]);
  bf16*Ow=Ou+(long)(wid*QBLK)*opitch;
  { bf16*stg=(bf16*)(shm+LDS_OST)+wid*2048;
    #pragma unroll
    for(int r=0;r<16;++r){const int orow=crow(r,hi);
      #pragma unroll
      for(int d0=0;d0<2;++d0)stg[orow*64+d0*32+r32]=(bf16)(o[d0][r]*rli[r]);}
    asm volatile("s_waitcnt lgkmcnt(0)":::"memory");
    #pragma unroll
    for(int i=0;i<4;++i){const int row=i*8+(lane>>3),ch=lane&7; const u32x4 v=*(const u32x4*)(stg+row*64+ch*8); ATTN_STORE16(Ow+(long)row*opitch+ch*8,v);} }
  asm volatile("s_waitcnt lgkmcnt(0)\n\ts_barrier":::"memory");
  #undef DMA_K
  #undef DMA_V
  #undef CMASK
  #undef START
  #undef RESC
  #undef ROT
}

constexpr int U_SLOTK=8192,U_LDS_K=0,U_LDS_V=3*U_SLOTK,U_LDS_WS=U_LDS_V+3*16384,U_LDS_OST=U_LDS_WS+2048,U_LDS_Q=U_LDS_OST+NW*4096,U_LDS_BYTES=U_LDS_Q+NW*4096;
template<int THRL> __device__ __forceinline__ void attn_unit128(const bf16*Qu,const bf16*__restrict__ Kh,const bf16*__restrict__ Vh,bf16*Ou,int opitch,char*shm){
  const int tid=threadIdx.x,lane=tid&63,r32=lane&31,hi=lane>>5; const int wid=__builtin_amdgcn_readfirstlane(tid>>6);
  const bf16*Qw=Qu+(long)(wid*QBLK)*DM;
  const unsigned lds0=(unsigned)(uintptr_t)shm;
  float*wsf=(float*)(shm+U_LDS_WS)+wid*64;
  const bf16*ksrc=Kh+(long)lane*DM+wid*8;
  const bf16*vsrc=Vh+(long)(16*(wid&3)+(lane>>2))*DM+(wid>>2)*32+(lane&3)*8;
  const unsigned kdst=lds0+U_LDS_K+wid*1024, vdst=lds0+U_LDS_V+wid*1024;
  #define DMA_K(t,slot) glds16(ksrc+(long)(t)*KVBLK*DM,(unsigned)__builtin_amdgcn_readfirstlane(kdst+(slot)))
  #define DMA_V(t,slot) do{ glds16(vsrc+(long)(t)*KVBLK*DM,(unsigned)__builtin_amdgcn_readfirstlane(vdst+2*(slot))); glds16(vsrc+(long)(t)*KVBLK*DM+64,(unsigned)__builtin_amdgcn_readfirstlane(vdst+2*(slot)+8192)); }while(0)
  const int vb0=(int)(lds0+U_LDS_V)+((lane>>4)&1)*32+(lane&3)*8+(4*hi+((lane&15)>>2))*64;
  bf16x8 kf[8];
  const lds_cptr shm3=(lds_cptr)shm; const lds_cptr kp0=shm3+U_LDS_K+hi*1024+r32*16; const lds_cptr vp0=shm3+U_LDS_V+((lane>>4)&1)*32+(lane&3)*8+(4*hi+((lane&15)>>2))*64;
  constexpr int NT=36;
  DMA_K(0,0);DMA_V(0,0);DMA_K(1,U_SLOTK);
  const lds_cptr qp0=shm3+U_LDS_Q+tid*16;
  { bf16x8 qr[4];
    #pragma unroll
    for(int d0=0;d0<4;++d0)qr[d0]=*reinterpret_cast<const bf16x8*>(&Qw[(long)r32*DM+d0*16+hi*8]);
    #pragma unroll
    for(int d0=0;d0<4;++d0)*(__attribute__((address_space(3))) bf16x8*)(qp0+d0*8192)=qr[d0]; }
  #define QF(d0) (*(const __attribute__((address_space(3))) bf16x8*)(qp0+(d0)*8192))
  float l_reg=0.f;f32x16 o[4];o[0]=f32x16{};o[1]=f32x16{};o[2]=f32x16{};o[3]=f32x16{};
  #define RESC() do{}while(0)
  f32x16 pA0,pA1,pB0,pB1;
  int sl_prev=0,sl_cur=0,sl_next=U_SLOTK;
  #define ROT() do{sl_prev=sl_cur;sl_cur=sl_next;sl_next=(sl_next==2*U_SLOTK)?0:sl_next+U_SLOTK;}while(0)
  DMA_K(2,2*U_SLOTK);
  WAIT_BAR(4);
  { kload8(kf,kp0);
    { const bf16x8 q0=QF(0),q1=QF(1),q2=QF(2),q3=QF(3);
    pA0=mf16(kf[0],q0,f32x16{},0,0,0);pA1=mf16(kf[1],q0,f32x16{},0,0,0);pA0=mf16(kf[2],q1,pA0,0,0,0);pA1=mf16(kf[3],q1,pA1,0,0,0);
    pA0=mf16(kf[4],q2,pA0,0,0,0);pA1=mf16(kf[5],q2,pA1,0,0,0);pA0=mf16(kf[6],q3,pA0,0,0,0);pA1=mf16(kf[7],q3,pA1,0,0,0); }
    asm volatile("s_nop 15\n\ts_nop 7":"+v"(pA0),"+v"(pA1));
    _Pragma("unroll") for(int r=0;r<16;++r){pA0[r]=__builtin_amdgcn_exp2f(pA0[r]);pA1[r]=__builtin_amdgcn_exp2f(pA1[r]);} }
  WAIT_BAR(0);
  DMA_K(3,0);DMA_V(1,U_SLOTK);
  ROT();
  kload8(kf,kp0+sl_cur);
  WAIT_BAR(3);
  s16x4 vrl[4],vrh[4]; u32x4 pw0,pw1,pw2,pw3;
  #define PKW(P,B) cvtpk_b(P[B],P[B+1])
  #define PAF(k) __builtin_bit_cast(bf16x8,pw##k)
  #define FID(g) ((((g)&3)<<2)+((g)>>2))
  #define VF(g) (bf16x8){vrl[(g)&3][0],vrl[(g)&3][1],vrl[(g)&3][2],vrl[(g)&3][3],vrh[(g)&3][0],vrh[(g)&3][1],vrh[(g)&3][2],vrh[(g)&3][3]}
  #define VRDR(g) do{ vrl[(g)&3]=vtr(vp_+((FID(g)>>2)*4096+(FID(g)&3)*1024)); vrh[(g)&3]=vtr(vp_+((FID(g)>>2)*4096+(FID(g)&3)*1024+512)); }while(0)
  #define PIN(x) asm volatile("":"+v"(x))
  #define MX3(a,b,c) __builtin_fmaxf(__builtin_fmaxf((a),(b)),(c))
  #define EX(v) __builtin_amdgcn_exp2f(v)
  { float s0=pA0[0]+pA0[1]; _Pragma("unroll") for(int r=2;r<16;++r)s0+=pA0[r]; _Pragma("unroll") for(int r=0;r<16;++r)s0+=pA1[r]; l_reg+=s0;
    pw0=(u32x4){PKW(pA0,0),PKW(pA0,2),PKW(pA0,4),PKW(pA0,6)};pw1=(u32x4){PKW(pA0,8),PKW(pA0,10),PKW(pA0,12),PKW(pA0,14)};pw2=(u32x4){PKW(pA1,0),PKW(pA1,2),PKW(pA1,4),PKW(pA1,6)}; pw3=(u32x4){0u,0u,0u,0u}; }
  #define GAPA(MF,W) do{ MF; W; SBAR(); }while(0)
  #define GAPB(g,KS,X,B,PKSTMT) do{ o[(g)&3]=mfb16(PAF(KS),VF(g),o[(g)&3],0,0,0); if((g)+4<16){VRDR((g)+4);} X[B]=EX(X[B]); X[B+1]=EX(X[B+1]); sacc+=X[B]; sacc+=X[B+1]; PIN(sacc); PKSTMT; PIN(X); SBAR(); }while(0)
  #define KRD(G,j) do{ if(G){ kload2(kf,kp0+sl_next,j); SBAR(); } }while(0)
  #define STEP(C0,C1,P0,P1,t,GK,GV,GL) do{ SBAR(); \
    const lds_cptr vp_=vp0+2*sl_prev; \
    bf16x8 qa=QF(0),qb=QF(1); SBAR(); \
    GAPA(C0=mf16(kf[0],qa,f32x16{},0,0,0), pw3[0]=PKW(P1,8)); \
    GAPA(C1=mf16(kf[1],qa,f32x16{},0,0,0), pw3[1]=PKW(P1,10)); \
    qa=QF(2); SBAR(); \
    GAPA(C0=mf16(kf[2],qb,C0,0,0,0),       pw3[2]=PKW(P1,12)); \
    GAPA(C1=mf16(kf[3],qb,C1,0,0,0),       pw3[3]=PKW(P1,14); PIN(pw3)); \
    qb=QF(3); SBAR(); \
    VRDR(0); SBAR(); GAPA(C0=mf16(kf[4],qa,C0,0,0,0), (void)0); \
    VRDR(1); SBAR(); GAPA(C1=mf16(kf[5],qa,C1,0,0,0), (void)0); \
    VRDR(2); SBAR(); GAPA(C0=mf16(kf[6],qb,C0,0,0,0), (void)0); \
    VRDR(3); SBAR(); GAPA(C1=mf16(kf[7],qb,C1,0,0,0), (void)0); \
    if(GK){DMA_K((t)+3,sl_cur);} if(GV){DMA_V((t)+1,sl_next);} \
    float sacc=0.f; \
    SBAR(); \
    GAPB(0,0,C0,0,(void)0);  GAPB(1,0,C0,2,(void)0);  GAPB(2,0,C0,4,(void)0);  GAPB(3,0,C0,6,(void)0); \
    KRD(GL,0); GAPB(4,1,C0,8,pw0[0]=PKW(C0,0));  KRD(GL,1); GAPB(5,1,C0,10,pw0[1]=PKW(C0,2)); KRD(GL,2); GAPB(6,1,C0,12,pw0[2]=PKW(C0,4)); KRD(GL,3); GAPB(7,1,C0,14,pw0[3]=PKW(C0,6); PIN(pw0)); \
    GAPB(8,2,C1,0,pw1[0]=PKW(C0,8));  GAPB(9,2,C1,2,pw1[1]=PKW(C0,10)); GAPB(10,2,C1,4,pw1[2]=PKW(C0,12)); GAPB(11,2,C1,6,pw1[3]=PKW(C0,14); PIN(pw1)); \
    GAPB(12,3,C1,8,pw2[0]=PKW(C1,0)); GAPB(13,3,C1,10,pw2[1]=PKW(C1,2));GAPB(14,3,C1,12,pw2[2]=PKW(C1,4));GAPB(15,3,C1,14,pw2[3]=PKW(C1,6); PIN(pw2)); \
    l_reg+=sacc; \
    }while(0)
  int t=1;
  for(;t+5<NT;t+=2){
    STEP(pB0,pB1,pA0,pA1,t,true,true,true);     WAIT_BAR(3); RESC(); ROT();
    STEP(pA0,pA1,pB0,pB1,t+1,true,true,true);   WAIT_BAR(3); RESC(); ROT();
  }
  #define ENDW(tt) do{ if((tt)+3<NT){WAIT_BAR(3);} else if((tt)+2<NT){WAIT_BAR(2);} else {WAIT_BAR(0);} }while(0)
  for(;t+1<NT;t+=2){
    STEP(pB0,pB1,pA0,pA1,t,(t+3<NT),(t+1<NT),(t+1<NT));       ENDW(t);   RESC(); ROT();
    STEP(pA0,pA1,pB0,pB1,t+1,(t+4<NT),(t+2<NT),(t+2<NT));     ENDW(t+1); RESC(); ROT();
  }
  STEP(pB0,pB1,pA0,pA1,NT-1,false,false,false); RESC();
  { pw3=(u32x4){PKW(pB1,8),PKW(pB1,10),PKW(pB1,12),PKW(pB1,14)};
    SBAR(); pv(o,vb0+2*sl_cur,PAF(0),PAF(1),PAF(2),PAF(3)); pv(o+2,vb0+2*sl_cur+8192,PAF(0),PAF(1),PAF(2),PAF(3)); }
  #undef PKW
  #undef PAF
  #undef FID
  #undef VF
  #undef VRDR
  #undef PIN
  #undef MX3
  #undef GAPA
  #undef GAPB
  #undef EX
  #undef KRD
  #undef STEP
  #undef ENDW
  {auto rr=__builtin_amdgcn_permlane32_swap(__float_as_uint(l_reg),__float_as_uint(l_reg),false,false);l_reg=__uint_as_float(rr[0])+__uint_as_float(rr[1]);}
  if(hi==0)wsf[32+r32]=l_reg;asm volatile("s_waitcnt lgkmcnt(0)":::"memory");
  float rli[16];
  #pragma unroll
  for(int r=0;r<16;++r)rli[r]=__builtin_amdgcn_rcpf(wsf[32+crow(r,hi)]);
  { bf16*stg=(bf16*)(shm+U_LDS_OST)+wid*2048;
    bf16*Ow=Ou+(long)(wid*QBLK)*opitch;
    #pragma unroll
    for(int hf=0;hf<2;++hf){
      #pragma unroll
      for(int r=0;r<16;++r){const int orow=crow(r,hi);
        #pragma unroll
        for(int d0=0;d0<2;++d0)stg[orow*64+d0*32+r32]=(bf16)(o[2*hf+d0][r]*rli[r]);}
      asm volatile("s_waitcnt lgkmcnt(0)":::"memory");
      #pragma unroll
      for(int i=0;i<4;++i){const int row=i*8+(lane>>3),ch=lane&7; const u32x4 v=*(const u32x4*)(stg+row*64+ch*8); *(u32x4*)(Ow+(long)row*opitch+hf*64+ch*8)=v;}
      asm volatile("s_waitcnt lgkmcnt(0)":::"memory"); } }
  asm volatile("s_waitcnt lgkmcnt(0)\n\ts_barrier":::"memory");
  #undef DMA_K
  #undef DMA_V
  #undef RESC
  #undef ROT
  #undef QF
}

__device__ __forceinline__ void diff_combine_unit(const bf16*O0u,const bf16*O1u,int opitch,float lam,const float*subg,bf16*Mx){
  const int tid=threadIdx.x,lane=tid&63; const int wid=__builtin_amdgcn_readfirstlane(tid>>6);
  asm volatile("s_waitcnt vmcnt(0)":::"memory");
  const bf16*O0w=O0u+(long)(wid*QBLK)*opitch; const bf16*O1w=O1u+(long)(wid*QBLK)*opitch; bf16*Mw=Mx+(long)(wid*QBLK)*1024;
  float sg[16];
  #pragma unroll
  for(int j=0;j<16;++j)sg[j]=subg[(j>>3)*64+(lane&7)*8+(j&7)];
  #pragma unroll
  for(int i=0;i<4;++i){const int row=i*8+(lane>>3),ch=lane&7;
    float d[16]; float ss=0.f;
    #pragma unroll
    for(int hf=0;hf<2;++hf){ const h16x8 v0=*(const h16x8*)(O0w+(long)row*opitch+hf*64+ch*8); const h16x8 v1=*(const h16x8*)(O1w+(long)row*opitch+hf*64+ch*8);
      #pragma unroll
      for(int j=0;j<8;++j){d[hf*8+j]=(float)v0[j]-lam*(float)v1[j];ss+=d[hf*8+j]*d[hf*8+j];} }
    ss+=__shfl_xor(ss,1);ss+=__shfl_xor(ss,2);ss+=__shfl_xor(ss,4);
    const float rs=__builtin_amdgcn_rsqf(ss*(1.f/128.f)+1e-6f)*0.8f;
    #pragma unroll
    for(int hf=0;hf<2;++hf){ h16x8 ov;
      #pragma unroll
      for(int j=0;j<8;++j)ov[j]=(_Float16)(d[hf*8+j]*rs*sg[hf*8+j]);
      *(h16x8*)(Mw+(long)row*1024+hf*64+ch*8)=ov; } }
}
constexpr int ATTN_LDS_BYTES=LDS_BYTES;
#undef SBAR
#undef WAIT_BAR
}

DEV void ph_attn(const Frame& F, int vcu) {
    const f16* qkv = WSP(f16, WS_QKV); f16* sdiff = WSP(f16, WS_SDIFF); f16* mixed = WSP(f16, WS_MIXED);
    const int spr = F.G >> 3, qb = vcu & 7;
#pragma unroll 1
    for (int i = 0;; ++i) {
        const int L = i * spr + (vcu >> 3); if (L >= NB * 4) break;
        const int b = L >> 2, h = L & 3;
        const size_t trow = (size_t)b * SEQ + qb * 256;
        const f16* base = qkv + (size_t)b * RB * NIN;
        const f16* qrow = base + (size_t)(CL + qb * 256) * NIN;
        f16* o0 = sdiff + trow * 512 + h * 128;
#pragma unroll 1
        for (int mp = 0; mp < 2; ++mp)
            attn_body::attn_unit128<8>(qrow + h * 128 + mp * 64, base + 512 + h * 128 + mp * 64, base + 1024 + h * 128, o0 + (size_t)mp * NT * 512, 512, (char*)F.lds);
        attn_body::diff_combine_unit(o0, o0 + (size_t)NT * 512, 512, WSP(float, WS_MISC)[0], F.in[15], mixed + trow * DM + h * 128);
    }
#pragma unroll 1
    for (int i = 0;; ++i) {
        const int L = i * spr + (vcu >> 3); if (L >= NB * 8) break;
        const int b = L >> 3, g = L & 7;
        const size_t trow = (size_t)b * SEQ + qb * 256;
        const f16* base = qkv + (size_t)b * RB * NIN;
        attn_body::attn_unit<8>(base + (size_t)(CL + qb * 256) * NIN + 1536 + g * 64, base + 2048 + (g >> 2) * 64, base + 2176 + (g >> 2) * 64, mixed + trow * DM + 512 + g * 64, DM, (char*)F.lds);
    }
}

DEV void ph_rowpass(const Frame& F) {
    const float* x = F.in[0]; const f16* y1 = WSP(f16, WS_Y1); const float* mod = WSP(float, WS_MOD); const float* gpost = F.in[7]; const float* gpre = F.in[17];
    const float* wr = F.in[19]; const float* rbias = F.in[20]; float* x1out = F.out; unsigned char* h2 = F.ws + WS_H2;
    int* idx = WSP(int, WS_IDX); int* rank = WSP(int, WS_RANK); float* gw = WSP(float, WS_GW); int* cnt = WSP(int, WS_CNT);
    constexpr int AROW = 2064;
    LAS unsigned char* Ahi = (LAS unsigned char*)F.lds; LAS unsigned char* Alo = Ahi + 16 * AROW; LAS float* part = (LAS float*)(Ahi + 32 * AROW);
    LAS int* lcnt = (LAS int*)(Ahi + 32 * AROW + 32768);
    if (F.tid < 64) lcnt[F.tid] = 0;
    const int wave = F.wave, lane = F.lane, fr = lane & 15, fq = lane >> 4;
    f16x8 Bh[4][4];
#pragma unroll
    for (int ks = 0; ks < 4; ++ks)
#pragma unroll
        for (int n = 0; n < 4; ++n) { const int k0 = wave * 128 + ks * 32 + fq * 8, e = n * 16 + fr;
#pragma unroll
            for (int j = 0; j < 8; ++j) Bh[ks][n][j] = (f16)wr[(k0 + j) * NE + e]; }
    const float rb = rbias[lane];
    f32x4 X[2][4]; f16x4 Y[2][4];
#define RP_LOAD(T0) do { _Pragma("unroll") for (int u = 0; u < 2; ++u) { const size_t t_ = (size_t)(T0) + wave * 2 + u; \
        _Pragma("unroll") for (int j = 0; j < 4; ++j) { const int c0 = j * 256 + lane * 4; X[u][j] = *(const f32x4*)(x + t_ * DM + c0); Y[u][j] = *(const f16x4*)(y1 + t_ * DM + c0); } } } while (0)
    constexpr int NBLK = NT / 256;
    if (F.bid < NBLK) RP_LOAD(F.bid * 256);
#pragma unroll 1
    for (int blk = F.bid; blk < NBLK; blk += F.G) {
      f32x4 A1[4], G2[4]; const float* const mb = mod + (size_t)(blk / (SEQ / 256)) * NMOD;
      { const float* m = mb;
#pragma unroll
        for (int j = 0; j < 4; ++j) { const int c0 = j * 256 + lane * 4; A1[j] = *(const f32x4*)(m + 2048 + c0) * *(const f32x4*)(gpost + c0); G2[j] = *(const f32x4*)(gpre + c0) * (*(const f32x4*)(m + 4096 + c0) + 1.f); } }
#pragma unroll 1
      for (int st = 0; st < 16; ++st) {
        const int t0 = blk * 256 + st * 16;
#pragma unroll
        for (int u = 0; u < 2; ++u) {
            const int r = wave * 2 + u; const size_t t = (size_t)t0 + r;
            float ss = 0.f;
#pragma unroll
            for (int j = 0; j < 4; ++j)
#pragma unroll
                for (int i = 0; i < 4; ++i) { const float yv = (float)Y[u][j][i]; ss += yv * yv; }
            const float rstd1 = rsqrtf(wave_sum(ss) * (1.f / DM) + EPS);
            float s2 = 0.f;
#pragma unroll
            for (int j = 0; j < 4; ++j) { const int c0 = j * 256 + lane * 4; f16x4 oh;
#pragma unroll
                for (int i = 0; i < 4; ++i) { const float v = X[u][j][i] + A1[j][i] * ((float)Y[u][j][i] * rstd1); X[u][j][i] = v; oh[i] = (f16)v; s2 += v * v; }
                *(f16x4*)((f16*)(x1out + t * DM) + c0) = oh; }
            const float rstd2 = rsqrtf(wave_sum(s2) * (1.f / DM) + EPS);
#pragma unroll
            for (int j = 0; j < 4; ++j) { const int c0 = j * 256 + lane * 4; const f32x4 sh = *(const f32x4*)(mb + 3072 + c0); f16x4 o, ol;
#pragma unroll
                for (int i = 0; i < 4; ++i) { const float v = X[u][j][i] * rstd2 * G2[j][i] + sh[i]; o[i] = (f16)v; ol[i] = (f16)(v - (float)o[i]); }
                { int q8 = __builtin_amdgcn_cvt_pk_fp8_f32(c8((float)o.x + (float)ol.x), c8((float)o.y + (float)ol.y), 0, false); q8 = __builtin_amdgcn_cvt_pk_fp8_f32(c8((float)o.z + (float)ol.z), c8((float)o.w + (float)ol.w), q8, true); *(int*)(h2 + t * DM + c0) = q8; }
                *(LAS f16x4*)(Ahi + r * AROW + c0 * 2) = o; *(LAS f16x4*)(Alo + r * AROW + c0 * 2) = ol; }
        }
        if (st < 15) RP_LOAD(t0 + 16); else if (blk + F.G < NBLK) RP_LOAD((blk + F.G) * 256);
        __syncthreads();
        { f32x4 acc[4];
#pragma unroll
          for (int n = 0; n < 4; ++n) acc[n] = (f32x4){0.f, 0.f, 0.f, 0.f};
#pragma unroll
          for (int ks = 0; ks < 4; ++ks) { const int off = fr * AROW + (wave * 128 + ks * 32 + fq * 8) * 2;
              const f16x8 ah = *(const LAS f16x8*)(Ahi + off), al = *(const LAS f16x8*)(Alo + off);
#pragma unroll
              for (int n = 0; n < 4; ++n) { acc[n] = __builtin_amdgcn_mfma_f32_16x16x32_f16(ah, Bh[ks][n], acc[n], 0, 0, 0); acc[n] = __builtin_amdgcn_mfma_f32_16x16x32_f16(al, Bh[ks][n], acc[n], 0, 0, 0); } }
#pragma unroll
          for (int n = 0; n < 4; ++n)
#pragma unroll
              for (int q = 0; q < 4; ++q) part[(wave * 16 + 4 * fq + q) * 64 + n * 16 + fr] = acc[n][q]; }
        __syncthreads();
#pragma unroll 1
        for (int rr = 0; rr < 2; ++rr) {
            const int r = wave * 2 + rr; const size_t t = (size_t)t0 + r; const int e = lane;
            float lgt = 0.f;
#pragma unroll
            for (int p = 0; p < 8; ++p) lgt += part[(p * 16 + r) * 64 + e];
            const float s = 1.f / (1.f + expf(-lgt)); const float sel = s + rb;
            int rk = 0;
#pragma unroll
            for (int d = 1; d < 8; ++d) { const float o = __shfl_xor(sel, d); rk += (o > sel || (o == sel && (e ^ d) < e)) ? 1 : 0; }
            float gs = rk < 2 ? sel : 0.f; gs += __shfl_xor(gs, 1); gs += __shfl_xor(gs, 2); gs += __shfl_xor(gs, 4);
            int grk = 0; const int g = e >> 3;
#pragma unroll
            for (int d = 1; d < 8; ++d) { const float o = __shfl_xor(gs, d * 8); grk += (o > gs || (o == gs && (g ^ d) < g)) ? 1 : 0; }
            const bool gsel = grk < 4;
            const float v = gsel ? sel : -INFINITY;
            int r8 = 0;
#pragma unroll
            for (int j = 0; j < 64; ++j) { const float o = __builtin_bit_cast(float, __builtin_amdgcn_readlane(__builtin_bit_cast(int, v), j)); r8 += (o > v || (o == v && j < e)) ? 1 : 0; }
            const bool chosen = gsel && r8 < 8;
            const float tot = wave_sum(chosen ? s : 0.f);
            if (chosen) { idx[t * 8 + r8] = e; gw[t * 8 + r8] = s / tot * 2.5f; rank[t * 8 + r8] = __hip_atomic_fetch_add(&lcnt[e], 1, __ATOMIC_RELAXED, __HIP_MEMORY_SCOPE_WORKGROUP); }
        }
      }
    }
#undef RP_LOAD
    __syncthreads();
    if (F.tid < 64) WSP(int, WS_WGB)[F.bid * 64 + F.tid] = atomicAdd(&cnt[F.tid * 64], lcnt[F.tid]);
    __syncthreads();
}

DEV void ph_dispatch(const Frame& F) {
    const int* idx = WSP(int, WS_IDX); const int* rank = WSP(int, WS_RANK); const float* gw = WSP(float, WS_GW); const int* cnt = WSP(int, WS_CNT); const int* wgb = WSP(int, WS_WGB);
    int* tok = WSP(int, WS_TOK); int* pair = WSP(int, WS_PAIR); float* wsl = WSP(float, WS_WSL); int* blke = WSP(int, WS_BLKE); int* nblk = WSP(int, WS_CTL) + 64;
    int* pst = (int*)F.lds;
    const int tid = F.tid;
    if (tid < 64) { const int pc = ((cnt[tid * 64] + 255) >> 8) << 8; int incl = pc;
#pragma unroll
        for (int o = 1; o < 64; o <<= 1) { const int n = __shfl_up(incl, o); if (tid >= o) incl += n; }
        pst[tid] = incl - pc; if (tid == 63) pst[64] = incl; }
    __syncthreads();
    for (int gid = F.bid * NTHR + tid; gid < NT * 8; gid += F.G * NTHR) {
        const int e = idx[gid]; const int t = gid >> 3, k = gid & 7; const int slot = NT + pst[e] + wgb[((t >> 8) % F.G) * 64 + e] + rank[gid]; tok[slot] = t; pair[slot] = t * NSLOTK + k; wsl[slot] = gw[gid];
        if (gid < NT) { tok[gid] = gid; pair[gid] = gid * NSLOTK + 8; wsl[gid] = 1.f; }
    }
    for (int e = F.bid; e < 64; e += F.G) {
        for (int s = NT + pst[e] + cnt[e * 64] + tid; s < NT + pst[e + 1]; s += NTHR) { tok[s] = 0; pair[s] = -1; wsl[s] = 0.f; }
    }
    if (F.bid == 0) {
        const int nb = SH_BLKS + (pst[64] >> 8);
        if (tid == 0) *nblk = nb;
        for (int bk = tid; bk < MAX_BLKS; bk += NTHR) {
            int e = 64;
            if (bk >= SH_BLKS) { const int off = (bk - SH_BLKS) << 8; e = 0; for (int q = 0; q < 64; ++q) if (off >= pst[q] && off < pst[q + 1]) e = q; }
            blke[bk] = e;
        }
    }
    __syncthreads();
}

DEV void ph_combine(const Frame& F, float* dst) {
    const unsigned char* yp = F.ws + WS_YP; const float* mod = WSP(float, WS_MOD); const float* gpf = F.in[18]; float* out = F.out;
    const int lane = F.lane;
    for (int blk = F.bid; blk < NT / 256; blk += F.G) {
      float A2[16];
      { const float* m = mod + (size_t)(blk / (SEQ / 256)) * NMOD + 5120;
#pragma unroll
        for (int i = 0; i < 4; ++i) { const int c0 = lane * 16 + i * 4; const f32x4 g = *(const f32x4*)(gpf + c0), gt = *(const f32x4*)(m + c0);
#pragma unroll
            for (int j = 0; j < 4; ++j) A2[i * 4 + j] = g[j] * gt[j]; } }
#pragma unroll 1
      for (int st = 0; st < 16; ++st) { const size_t t0 = (size_t)blk * 256 + st * 16 + F.wave * 2;
        f16x8 xa[2], xb[2]; uint4 w[2][NSLOTK];
#pragma unroll
        for (int u = 0; u < 2; ++u) { const size_t t = t0 + u;
            xa[u] = *(const f16x8*)((const f16*)(out + t * DM) + lane * 16); xb[u] = *(const f16x8*)((const f16*)(out + t * DM) + lane * 16 + 8);
#pragma unroll
            for (int k = 0; k < NSLOTK; ++k) w[u][k] = *(const uint4*)(yp + (t * NSLOTK + k) * DM + lane * 16); }
#pragma unroll
        for (int u = 0; u < 2; ++u) { const size_t t = t0 + u;
            float acc[16];
#pragma unroll
            for (int i = 0; i < 16; ++i) acc[i] = 0.f;
#pragma unroll
            for (int k = 0; k < NSLOTK; ++k) {
                const unsigned ww[4] = {w[u][k].x, w[u][k].y, w[u][k].z, w[u][k].w};
#pragma unroll
                for (int i = 0; i < 4; ++i) { const f32x2 lo = __builtin_amdgcn_cvt_pk_f32_fp8((int)ww[i], false), hi = __builtin_amdgcn_cvt_pk_f32_fp8((int)ww[i], true);
                    acc[i * 4] += lo.x; acc[i * 4 + 1] += lo.y; acc[i * 4 + 2] += hi.x; acc[i * 4 + 3] += hi.y; }
            }
            float ss = 0.f;
#pragma unroll
            for (int i = 0; i < 16; ++i) { acc[i] *= (1.f / YSCALE); ss += acc[i] * acc[i]; }
            const float rstd = rsqrtf(wave_sum(ss) * (1.f / DM) + EPS);
#pragma unroll
            for (int i = 0; i < 4; ++i) { const int c0 = lane * 16 + i * 4; f32x4 o;
#pragma unroll
                for (int j = 0; j < 4; ++j) { const int q = i * 4 + j; const float x1 = (float)(q < 8 ? xa[u][q & 7] : xb[u][q & 7]); o[j] = x1 + A2[q] * (acc[q] * rstd); }
                *(f32x4*)(dst + t * DM + c0) = o; }
        }
      }
    }
}

#define XB_TMO      128
#define XB_XCNT(j)  (256  + 64 * (j))
#define XB_XSUB(j)  (1280 + 64 * (j))
#define XB_XGEN(j)  (2304 + 64 * (j))
#define XB_TOP      3328
#define XB_TOPGEN   3392
#define XCD_BAR_WORDS 3456
#define XB_SPIN_CAP (1u << 20)
DEV unsigned xb_ld(unsigned* p)              { return __hip_atomic_load(p, __ATOMIC_RELAXED, __HIP_MEMORY_SCOPE_AGENT); }
DEV unsigned xb_add(unsigned* p, unsigned v) { return __hip_atomic_fetch_add(p, v, __ATOMIC_RELAXED, __HIP_MEMORY_SCOPE_AGENT); }
DEV unsigned xb_xcc_id() { return (unsigned)__builtin_amdgcn_s_getreg((3 << 11) | 20) & 0xFu; }
#define XB_SPIN(cond, bar) do { unsigned _sp = 0; while (cond) { __builtin_amdgcn_s_sleep(1); \
    if ((++_sp & 255u) == 0u) { if (xb_ld(&(bar)[XB_TMO])) break; if (_sp > XB_SPIN_CAP) { atomicAdd(&(bar)[XB_TMO], 1u); break; } } } } while (0)
struct XcdBarrier { unsigned* bar; unsigned x; volatile LAS unsigned* st; };
DEV XcdBarrier xcd_barrier_post(unsigned* bar, volatile LAS unsigned* st) {
    XcdBarrier b; b.bar = bar; b.x = xb_xcc_id(); b.st = st;
    if (threadIdx.x == 0) (void)xb_add(&bar[XB_XCNT(b.x)], 1u);
    return b;
}
DEV void xcd_barrier_complete(unsigned* bar, unsigned x, unsigned& nloc, unsigned& nx) {
    const unsigned G = gridDim.x * gridDim.y * gridDim.z;
    unsigned sum, cnt, mine, sp = 0u;
    for (;;) {
        sum = 0u; cnt = 0u; mine = 0u;
#pragma unroll
        for (unsigned j = 0; j < 16; ++j) { const unsigned c = xb_ld(&bar[XB_XCNT(j)]); sum += c; cnt += (c > 0u) ? 1u : 0u; mine = (j == x) ? c : mine; }
        if (sum == G) break;
        __builtin_amdgcn_s_sleep(1);
        if ((++sp & 255u) == 0u) { if (xb_ld(&bar[XB_TMO])) break; if (sp > XB_SPIN_CAP) { atomicAdd(&bar[XB_TMO], 1u); break; } }
    }
    nloc = mine > 0u ? mine : 1u; nx = cnt > 0u ? cnt : 1u;
}
DEV void xcd_barrier(const XcdBarrier& b) {
    asm volatile("s_waitcnt vmcnt(0)" ::: "memory");
    __syncthreads();
    if (threadIdx.x == 0) {
        unsigned* bar = b.bar;
        __builtin_amdgcn_s_waitcnt(0);
        unsigned nloc = b.st[0], nx = b.st[1];
        if (nloc == 0u) { xcd_barrier_complete(bar, b.x, nloc, nx); b.st[0] = nloc; b.st[1] = nx; }
        const unsigned old = xb_add(&bar[XB_XSUB(b.x)], 1u);
        const unsigned gen = old / nloc;
        if (old + 1u == (gen + 1u) * nloc) {
            __builtin_amdgcn_fence(__ATOMIC_RELEASE, "agent");
            asm volatile("s_waitcnt vmcnt(0)" ::: "memory");
            const unsigned og = xb_add(&bar[XB_TOP], 1u);
            const unsigned tg = og / nx;
            if (og + 1u == (tg + 1u) * nx) xb_add(&bar[XB_TOPGEN], 1u);
            else XB_SPIN(xb_ld(&bar[XB_TOPGEN]) == tg, bar);
            __builtin_amdgcn_fence(__ATOMIC_ACQUIRE, "agent");
            xb_add(&bar[XB_XGEN(b.x)], 1u);
            asm volatile("s_waitcnt vmcnt(0)" ::: "memory");
        } else {
            XB_SPIN(xb_ld(&bar[XB_XGEN(b.x)]) == gen, bar);
            __builtin_amdgcn_fence(__ATOMIC_ACQUIRE, "agent");
            asm volatile("s_waitcnt vmcnt(0)" ::: "memory");
        }
    }
    __syncthreads();
}

#ifndef PROBE_DUP
#define PROBE_DUP -1
#endif
constexpr int NPHASE = 11;
__global__ void __launch_bounds__(NTHR, 2) mega(Args a) {
    extern __shared__ __attribute__((aligned(16))) unsigned char lds[];
    cg::grid_group grid = cg::this_grid();
    Frame F;
    F.lds = lds; F.tid = threadIdx.x; F.lane = F.tid & 63; F.wave = __builtin_amdgcn_readfirstlane(F.tid >> 6); F.bid = blockIdx.x; F.G = gridDim.x;
    F.gw = F.bid * NWAVE + F.wave; F.NGW = F.G * NWAVE; F.in = a.in; F.out = a.out; F.ws = a.ws;
    const int lo = a.ph_lo, hi = a.ph_hi;
#ifndef ONLY_PHASE
#define ONLY_PHASE -1
#endif
#define IN(k) (lo <= (k) && (k) < hi && (ONLY_PHASE < 0 || (k) == ONLY_PHASE))
    volatile LAS unsigned* xst = (volatile LAS unsigned*)((LAS unsigned char*)lds + LDS_BYTES - 128);
    if (F.tid < 2) xst[F.tid] = 0u;
    __syncthreads();
    const XcdBarrier xbar = xcd_barrier_post((unsigned*)(a.ws + WS_BAR), xst);
#define SEAM(k) do { if (IN(k) && IN((k) + 1)) { if (hi > 64) grid.sync(); else xcd_barrier(xbar); } } while (0)
#define RUN(k, ...) do { if (IN(k)) { __VA_ARGS__; if (PROBE_DUP == (k) && (k) != 10) { xcd_barrier(xbar); __VA_ARGS__; } } } while (0)
    const int vcu = (F.G % 8 == 0) ? (F.bid % 8) * (F.G / 8) + F.bid / 8 : F.bid;
    LAS unsigned char* lds3 = (LAS unsigned char*)lds;
    RUN(0, { ph_mod(F); ph_wconv(F); }); SEAM(0);
    RUN(1, ph_prenorm(F)); SEAM(1);
    RUN(2, { pg8::SchedInProj S{(const char*)WSP(f16, WS_HALL), (const char*)WSP(f16, WS_WIN), vcu, F.G};
        LAS float* tabs = (LAS float*)(lds3 + pg8::STAGE_BYTES + 4608);
        for (int i = F.tid; i < 2048; i += NTHR) tabs[i] = WSP(float, WS_ROPE)[i];
        if (F.tid < 64) { tabs[2048 + F.tid] = F.in[9][F.tid]; tabs[2112 + F.tid] = F.in[10][F.tid]; }
        __syncthreads();
        pg8::EpiInProj E{WSP(f16, WS_QKV), tabs + 2048, tabs + 2112, tabs};
        pg8::gemm_phase<pg8::EpiInProj, pg8::SchedInProj, false>(lds3, DM * 2, S, E, nullptr, nullptr, nullptr); }); SEAM(2);
    RUN(3, ph_attn(F, vcu)); if (IN(3) && IN(5)) xcd_barrier(xbar);
    RUN(5, { pg8::SchedDense S{(const char*)WSP(f16, WS_MIXED), (const char*)WSP(f16, WS_WOUT), vcu, F.G, (NT / 256) * 4, 4, DM};
        pg8::EpiPlain E{WSP(f16, WS_Y1), DM};
        pg8::gemm_phase<pg8::EpiPlain, pg8::SchedDense, false>(lds3, DM * 2, S, E, nullptr, nullptr, nullptr); }); SEAM(5);
    RUN(6, ph_rowpass(F)); SEAM(6);
    RUN(7, ph_dispatch(F)); SEAM(7);
    RUN(8, { const int nb = *(WSP(int, WS_CTL) + 64);
        pg8::SchedGrouped S{nullptr, (const char*)(F.ws + WS_WGU), WSP(int, WS_BLKE), vcu, F.G, nb * 2, 2, DM / 2, (size_t)512 * DM, 1};
        pg8::EpiGU E{F.ws + WS_H, WSP(float, WS_WSL)};
        pg8::gemm_phase<pg8::EpiGU, pg8::SchedGrouped, true, true>(lds3, DM, S, E, WSP(int, WS_TOK), (const char*)(F.ws + WS_H2), WSP(unsigned, WS_WSL), 0x79797979, 0x7F7F7F7F); }); SEAM(8);
    RUN(9, { const int nb = *(WSP(int, WS_CTL) + 64);
        pg8::SchedGrouped S{(const char*)(F.ws + WS_H), (const char*)(F.ws + WS_WD), WSP(int, WS_BLKE), vcu, F.G, nb * 4, 4, EH / 2, (size_t)DM * EH, 1};
        pg8::EpiDown E{F.ws + WS_YP, WSP(int, WS_PAIR)};
        pg8::gemm_phase<pg8::EpiDown, pg8::SchedGrouped, false, true, true>(lds3, EH, S, E, nullptr, nullptr, WSP(unsigned, WS_PAIR), 0x79797979, 0x80808080  ); }); SEAM(9);
    RUN(10, ph_combine(F, F.out));
}

extern "C" void kernel_launch(void* const* d_in, const int* in_sizes, int n_in, void* d_out, int out_size, void* d_ws, size_t ws_size, hipStream_t stream) {
    (void)in_sizes; (void)out_size;
    static int grid = 0;
    if (grid == 0) {
        if (n_in != 27 || ws_size < WS_END) { fprintf(stderr, "kernel_launch: unexpected n_in %d / ws_size %zu (need %zu)\n", n_in, ws_size, (size_t)WS_END); grid = -1; return; }
        int dev = 0, cus = 0, per_cu = 0;
        (void)hipGetDevice(&dev); (void)hipDeviceGetAttribute(&cus, hipDeviceAttributeMultiprocessorCount, dev);
        if (hipFuncSetAttribute((const void*)mega, hipFuncAttributeMaxDynamicSharedMemorySize, LDS_BYTES) != hipSuccess) { fprintf(stderr, "kernel_launch: hipFuncSetAttribute failed\n"); grid = -1; return; }
        if (hipOccupancyMaxActiveBlocksPerMultiprocessor(&per_cu, (const void*)mega, NTHR, LDS_BYTES) != hipSuccess || per_cu < 1) { fprintf(stderr, "kernel_launch: occupancy query failed (%d)\n", per_cu); (void)hipGetLastError(); per_cu = 1; }
        grid = cus * (per_cu > 1 ? 1 : per_cu);
        if (grid <= 0) grid = 256;
    }
    if (grid < 0) return;
    (void)hipMemsetAsync((unsigned char*)d_ws + WS_CTL, 0, 64 * 1024, stream);
    Args a{};
    for (int i = 0; i < 27; ++i) a.in[i] = (const float*)d_in[i];
    a.out = (float*)d_out; a.ws = (unsigned char*)d_ws; a.ph_lo = 0; a.ph_hi = NPHASE;
    void* args[] = {&a};
    hipError_t e = hipLaunchCooperativeKernel((const void*)mega, dim3(grid), dim3(NTHR), args, LDS_BYTES, stream);
    if (e != hipSuccess) fprintf(stderr, "kernel_launch: cooperative launch failed: %s (grid %d)\n", hipGetErrorString(e), grid);
}
```

```cpp
#include <hip/hip_runtime.h>
#include <hip/hip_cooperative_groups.h>
#include <stdint.h>
#include <math.h>
#include <cstdio>
namespace cg = cooperative_groups;

typedef _Float16 f16;
typedef _Float16 f16x8 __attribute__((ext_vector_type(8)));
typedef _Float16 f16x4 __attribute__((ext_vector_type(4)));
typedef float f32x4 __attribute__((ext_vector_type(4)));
typedef float f32x2 __attribute__((ext_vector_type(2)));
#define DEV __device__ __forceinline__
#define LAS __attribute__((address_space(3)))

constexpr int NB = 32, SEQ = 2048, DM = 1024, NT = NB * SEQ, CL = 256, RB = SEQ + CL, RALL = NB * RB;
constexpr int NIN = 2304, NMOD = 6144, NE = 64, EH = 256, TOPK = 8, NSLOTK = 9;
constexpr int SH_BLKS = NT / 256;
constexpr int MAX_BLKS = SH_BLKS + (NT * TOPK) / 256 + NE;
constexpr int MAX_SLOTS = MAX_BLKS * 256;
constexpr float EPS = 1e-6f;
constexpr float QSCALE = 0.125f * 1.4426950408889634f;
constexpr float YSCALE = 8.0f;
constexpr int NTHR = 512, NWAVE = 8;
constexpr int LDS_BYTES = 147456;

constexpr size_t MiB = 1ull << 20;
constexpr size_t WS_CTL = 0;
constexpr size_t WS_CNT = 32768;
constexpr size_t WS_BAR = 4096;
constexpr size_t WS_MOD = 64 * 1024;
constexpr size_t WS_ROPE = 1 * MiB;
constexpr size_t WS_MISC = 1 * MiB + 64 * 1024;
constexpr size_t WS_BLKE = 1 * MiB + 128 * 1024;
constexpr size_t WS_WIN = 4 * MiB;
constexpr size_t WS_WOUT = WS_WIN + (size_t)NIN * DM * 2;
constexpr size_t WS_WGU = WS_WOUT + (size_t)DM * DM * 2;
constexpr size_t WS_WD = WS_WGU + (size_t)65 * 512 * DM * 2;
constexpr size_t WS_WEND = WS_WD + (size_t)65 * DM * EH * 2;
static_assert(WS_WEND <= 108 * MiB, "weights");
constexpr size_t WS_HALL = 108 * MiB;
constexpr size_t WS_MIXED = 108 * MiB;
constexpr size_t WS_QKV = 252 * MiB;
constexpr size_t WS_SDIFF = 576 * MiB;
constexpr size_t WS_Y1 = 704 * MiB;
constexpr size_t WS_H = 108 * MiB;
constexpr size_t WS_YP = 404 * MiB;
constexpr size_t WS_H2 = 404 * MiB;
constexpr size_t WS_TAB = 980 * MiB;
constexpr size_t WS_IDX = WS_TAB;
constexpr size_t WS_RANK = WS_IDX + (size_t)NT * 8 * 4;
constexpr size_t WS_GW = WS_RANK + (size_t)NT * 8 * 4;
constexpr size_t WS_TOK = WS_GW + (size_t)NT * 8 * 4;
constexpr size_t WS_PAIR = WS_TOK + (size_t)MAX_SLOTS * 4;
constexpr size_t WS_WSL = WS_PAIR + (size_t)MAX_SLOTS * 4;
constexpr size_t WS_WGB = WS_WSL + (size_t)MAX_SLOTS * 4;
constexpr size_t WS_END = WS_WGB + (size_t)1024 * 64 * 4;
static_assert(WS_END <= 1024 * MiB, "ws");

DEV float wave_sum(float v) {
#pragma unroll
    for (int o = 32; o > 0; o >>= 1) v += __shfl_xor(v, o);
    return v;
}
DEV float silu(float v) { return v / (1.f + __expf(-v)); }
DEV float silu_f(float v) { return v * __builtin_amdgcn_rcpf(1.f + __builtin_amdgcn_exp2f(v * -1.44269504f)); }
DEV float c8(float v) { return __builtin_amdgcn_fmed3f(v, -448.f, 448.f); }
DEV unsigned char f2fp8(float v) { const int r = __builtin_amdgcn_cvt_pk_fp8_f32(v, v, 0, false); return (unsigned char)(r & 0xff); }

struct Args { const float* in[27]; float* out; unsigned char* ws; int ph_lo, ph_hi; };
struct Frame {
    unsigned char* lds; int tid, lane, wave, bid, G, gw, NGW;
    const float* const* in; float* out; unsigned char* ws;
};
#define WSP(T, off) ((T*)(F.ws + (off)))

DEV void ph_mod(const Frame& F) {
    const float* c = F.in[1]; const float* c_ctx = F.in[3]; const float* w_mod = F.in[4]; const float* b_mod = F.in[5];
    float* mod = WSP(float, WS_MOD);
    if (F.bid == 0) {
        if (F.tid < 64) { float a = F.in[11][F.tid] * F.in[12][F.tid], b = F.in[13][F.tid] * F.in[14][F.tid]; a = wave_sum(a); b = wave_sum(b); if (F.tid == 0) WSP(float, WS_MISC)[0] = expf(a) - expf(b) + 0.2f; }
        float* rope = WSP(float, WS_ROPE);
        for (int i = F.tid; i < 64 * 16; i += NTHR) { const int pos = i >> 4, j = i & 15; const float ang = (float)pos * powf(10000.0f, -(float)j / 16.0f); rope[i * 2] = cosf(ang); rope[i * 2 + 1] = sinf(ang); }
    }
    constexpr int MC = 24;
    if (F.bid >= NMOD / MC) return;
    float* sc = (float*)F.lds;
    const int c0 = F.bid * MC, kh = F.lane / MC, col = F.lane - kh * MC;
    const float* wp = w_mod + (size_t)(F.wave * 128 + kh) * NMOD + c0 + col;
    float wa[8], wb[8];
#define MOD_LOAD(W, IT0) do { if (kh < 2) { _Pragma("unroll") for (int u = 0; u < 8; ++u) W[u] = wp[(size_t)((IT0) + u) * 2 * NMOD]; } } while (0)
#define MOD_FMA(W, IT0) do { if (kh < 2) { _Pragma("unroll") for (int u = 0; u < 8; ++u) { const int k = F.wave * 128 + ((IT0) + u) * 2 + kh; _Pragma("unroll") for (int r = 0; r < 33; ++r) acc[r] += sc[r * DM + k] * W[u]; } } } while (0)
    MOD_LOAD(wa, 0);
    for (int i = F.tid; i < 33 * DM; i += NTHR) { const int r = i >> 10, k = i & 1023; sc[i] = silu_f(r < 32 ? c[r * DM + k] : c_ctx[k]); }
    __syncthreads();
    float acc[33];
#pragma unroll
    for (int r = 0; r < 33; ++r) acc[r] = 0.f;
#pragma unroll 1
    for (int it0 = 0; it0 < 64; it0 += 16) {
        MOD_LOAD(wb, it0 + 8); MOD_FMA(wa, it0);
        if (it0 + 16 < 64) MOD_LOAD(wa, it0 + 16);
        MOD_FMA(wb, it0 + 8);
    }
#undef MOD_LOAD
#undef MOD_FMA
#pragma unroll
    for (int r = 0; r < 33; ++r) acc[r] += __shfl_down(acc[r], MC);
    __syncthreads();
    float* red = (float*)F.lds;
    if (F.lane < MC) {
#pragma unroll
        for (int r = 0; r < 33; ++r) red[(F.wave * 33 + r) * MC + col] = acc[r];
    }
    __syncthreads();
    for (int i = F.tid; i < 33 * MC; i += NTHR) { const int r = i / MC, cc = i - r * MC; float s = b_mod[c0 + cc];
#pragma unroll
        for (int w = 0; w < 8; ++w) s += red[(w * 33 + r) * MC + cc];
        mod[(size_t)r * NMOD + c0 + cc] = s; }
    __syncthreads();
}

struct WItem { const float* W; unsigned char* WT; int K, N, rowmode, f8, item; };
DEV void wconv_load(const WItem& d, int lane, f32x4 (&t)[8]) {
    const int nblk = d.N / 32, kb = d.item / nblk, nb = d.item % nblk, k0 = 64 * kb, n0 = 32 * nb;
#pragma unroll
    for (int i = 0; i < 8; ++i) t[i] = *(const f32x4*)(d.W + (size_t)(k0 + i * 8 + (lane >> 3)) * d.N + n0 + (lane & 7) * 4);
}
DEV void wconv_put(const WItem& d, int lane, const f32x4 (&t)[8], float* scr) {
    const int K = d.K, nblk = d.N / 32, kb = d.item / nblk, nb = d.item % nblk, k0 = 64 * kb, n0 = 32 * nb;
#pragma unroll
    for (int i = 0; i < 8; ++i) { float* q = scr + (i * 8 + (lane >> 3)) * 33 + (lane & 7) * 4; q[0] = t[i].x; q[1] = t[i].y; q[2] = t[i].z; q[3] = t[i].w; }
    __builtin_amdgcn_s_waitcnt(0xC07F); asm volatile("" ::: "memory");
    const int c = lane & 7;
#pragma unroll
    for (int j = 0; j < 4; ++j) {
        const int n = (lane >> 3) + 8 * j; const float* sp = scr + (8 * c) * 33 + n;
        const int nn = n0 + n;
        int row;
        if (d.rowmode == 0) row = nn;
        else if (d.rowmode == 3) { const int cc = nn & 255; row = (nn & ~255) + ((cc >> 5) & 1) * 128 + (cc >> 6) * 32 + (cc & 31); }
        else row = (nn >> 7) * 256 + (nn & 127) + (d.rowmode == 2 ? 128 : 0);
        if (d.f8) {
            int lo = __builtin_amdgcn_cvt_pk_fp8_f32(c8(sp[0] * 64.f), c8(sp[33] * 64.f), 0, false); lo = __builtin_amdgcn_cvt_pk_fp8_f32(c8(sp[66] * 64.f), c8(sp[99] * 64.f), lo, true);
            int hi = __builtin_amdgcn_cvt_pk_fp8_f32(c8(sp[132] * 64.f), c8(sp[165] * 64.f), 0, false); hi = __builtin_amdgcn_cvt_pk_fp8_f32(c8(sp[198] * 64.f), c8(sp[231] * 64.f), hi, true);
            *(uint2*)(d.WT + (size_t)row * K + k0 + 8 * c) = make_uint2((unsigned)lo, (unsigned)hi);
        } else {
            f16x8 o;
#pragma unroll
            for (int q = 0; q < 8; ++q) o[q] = (f16)sp[q * 33];
            *(f16x8*)(d.WT + ((size_t)row * K + k0 + 8 * c) * 2) = o;
        }
    }
    __builtin_amdgcn_s_waitcnt(0xC07F); asm volatile("" ::: "memory");
}
DEV void ph_wconv(const Frame& F) {
    float* scr = (float*)(F.lds + F.wave * 16384);
    constexpr int I_IN = (DM / 64) * (NIN / 32), I_OUT = (DM / 64) * (DM / 32), I_E = (DM / 64) * (EH / 32);
    constexpr int NITEMS = I_IN + I_OUT + 65 * 3 * I_E;
    auto decode = [&](int it, WItem& d) {
        int r = it;
        if (r < I_IN) { d = WItem{F.in[8], F.ws + WS_WIN, DM, NIN, 3, 0, r}; return; } r -= I_IN;
        if (r < I_OUT) { d = WItem{F.in[16], F.ws + WS_WOUT, DM, DM, 0, 0, r}; return; } r -= I_OUT;
        const int e = r / (3 * I_E), q = (r % (3 * I_E)) / I_E, ii = r % I_E;
        if (q == 0) d = WItem{e < 64 ? F.in[21] + (size_t)e * DM * EH : F.in[24], F.ws + WS_WGU + (size_t)e * 512 * DM, DM, EH, 1, 1, ii};
        else if (q == 1) d = WItem{e < 64 ? F.in[22] + (size_t)e * DM * EH : F.in[25], F.ws + WS_WGU + (size_t)e * 512 * DM, DM, EH, 2, 1, ii};
        else d = WItem{e < 64 ? F.in[23] + (size_t)e * DM * EH : F.in[26], F.ws + WS_WD + (size_t)e * DM * EH, EH, DM, 3, 1, ii};
    };
    int it = F.gw; if (it >= NITEMS) return;
    WItem cur, nxt; f32x4 ta[8], tb[8];
    decode(it, cur); wconv_load(cur, F.lane, ta);
#pragma unroll 1
    for (;;) {
        const int i1 = it + F.NGW; const bool h1 = i1 < NITEMS;
        if (h1) { decode(i1, nxt); wconv_load(nxt, F.lane, tb); }
        wconv_put(cur, F.lane, ta, scr);
        if (!h1) break;
        const int i2 = i1 + F.NGW; const bool h2 = i2 < NITEMS;
        if (h2) { decode(i2, cur); wconv_load(cur, F.lane, ta); }
        wconv_put(nxt, F.lane, tb, scr);
        if (!h2) break;
        it = i2;
    }
}

DEV void ph_prenorm(const Frame& F) {
    const float* x = F.in[0]; const float* ctx = F.in[2]; const float* g = F.in[6]; const float* mod = WSP(float, WS_MOD); f16* hall = WSP(f16, WS_HALL);
    const int lane = F.lane;
    constexpr int PBLK = 288; static_assert(RB % PBLK == 0 && RALL % PBLK == 0 && PBLK % 32 == 0, "prenorm block");
    f32x4 gg[4];
#pragma unroll
    for (int j = 0; j < 4; ++j) gg[j] = *(const f32x4*)(g + j * 256 + lane * 4);
    for (int blk = F.bid; blk < RALL / PBLK; blk += F.G) {
        int curm = -1; f32x4 G2[4], SH[4];
#pragma unroll 1
        for (int i = F.wave * 4; i < PBLK; i += 32) {
            const int row0 = blk * PBLK + i;
            f32x4 v[4][4]; int mr[4];
#pragma unroll
            for (int u = 0; u < 4; ++u) { const int row = row0 + u; const int b = row / RB, p = row % RB;
                const float* src = p < CL ? ctx + ((size_t)b * CL + p) * DM : x + ((size_t)b * SEQ + (p - CL)) * DM;
                mr[u] = p < CL ? 32 : b;
#pragma unroll
                for (int j = 0; j < 4; ++j) v[u][j] = *(const f32x4*)(src + j * 256 + lane * 4); }
#pragma unroll
            for (int u = 0; u < 4; ++u) {
                if (mr[u] != curm) { curm = mr[u]; const float* mp = mod + (size_t)curm * NMOD;
#pragma unroll
                    for (int j = 0; j < 4; ++j) { const int c0 = j * 256 + lane * 4; const f32x4 sc = *(const f32x4*)(mp + 1024 + c0); SH[j] = *(const f32x4*)(mp + c0); G2[j] = gg[j] * (sc + 1.f); } }
                float ss = 0.f;
#pragma unroll
                for (int j = 0; j < 4; ++j) ss += v[u][j].x * v[u][j].x + v[u][j].y * v[u][j].y + v[u][j].z * v[u][j].z + v[u][j].w * v[u][j].w;
                const float rstd = rsqrtf(wave_sum(ss) * (1.f / DM) + EPS);
#pragma unroll
                for (int j = 0; j < 4; ++j) {
                    const int c0 = j * 256 + lane * 4;
                    f16x4 o;
                    o.x = (f16)(v[u][j].x * rstd * G2[j].x + SH[j].x); o.y = (f16)(v[u][j].y * rstd * G2[j].y + SH[j].y);
                    o.z = (f16)(v[u][j].z * rstd * G2[j].z + SH[j].z); o.w = (f16)(v[u][j].w * rstd * G2[j].w + SH[j].w);
                    *(f16x4*)(hall + (size_t)(row0 + u) * DM + c0) = o;
                }
            }
        }
    }
}


namespace pg8 {
typedef int v8i __attribute__((ext_vector_type(8)));
typedef unsigned u32x4v __attribute__((ext_vector_type(4)));
constexpr int BM = 256, BK = 64, HALF = 128, HTB = HALF * BK * 2  , STAGE_BYTES = 8 * HTB;
DEV int lds_byte(int r, int c) { const int st = (r >> 4) * 2 + (c >> 5), rr = r & 15, cc = c & 31, ob = rr * 64 + cc * 2; return st * 1024 + (ob ^ (((ob >> 9) & 1) << 5)); }
DEV void stage_rc(int b, int& R, int& C) { const int st = b / 1024, sb = b % 1024, swz = sb ^ (((sb >> 9) & 1) << 5); R = (st >> 1) * 16 + swz / 64; C = (st & 1) * 32 + (swz % 64) / 2; }
struct GUnit { const char* A; const char* B; int pm, pn, aux; };
DEV void glds16s(const char* sbase, unsigned voff, unsigned lds_dst) { unsigned keep;
    asm volatile("s_mov_b32 %0, m0\n\ts_mov_b32 m0, %3\n\ts_nop 0\n\tglobal_load_lds_dwordx4 %1, %2\n\ts_mov_b32 m0, %0" : "=&s"(keep) : "v"(voff), "s"(sbase), "s"(lds_dst) : "memory"); }
DEV void stage2(LAS unsigned char* lds, unsigned bufoff, const char* base, unsigned o0, unsigned o1) {
    const unsigned d = (unsigned)__builtin_amdgcn_readfirstlane((int)((unsigned)(uintptr_t)lds + bufoff));
    glds16s(base, o0, d); glds16s(base, o1, d + 8192u);
}
template <class Epi, class Sched, bool GATHER, bool FP8 = false, bool ARES = false>
DEV void gemm_phase(LAS unsigned char* lds, const int PB, const Sched& S, const Epi& E, const int* tok, const char* Ag, const unsigned* rowarg, const int scaleW = 0x7F7F7F7F, const int scaleA = 0x7F7F7F7F) {
    const int tid = threadIdx.x, wid = __builtin_amdgcn_readfirstlane(tid >> 6), lane = tid & 63, wr = wid >> 2, wc = wid & 3, fr = lane & 15, fq = lane >> 4;
    const int nt = PB / 128;
    unsigned voff[2]; int sR[2]; unsigned sC2[2];
#pragma unroll
    for (int i = 0; i < 2; ++i) { int R, C; stage_rc(tid * 16 + i * 8192, R, C); sR[i] = R; sC2[i] = (unsigned)C * 2u; voff[i] = (unsigned)(R * PB) + (unsigned)C * 2u; }
    const size_t kstep = (size_t)(BK * 2), hstep = (size_t)HALF * PB;
    const unsigned ldsw = (unsigned)wid * 1024u;
    const int aoff = FP8 ? lds_byte(wr * 64 + fr, fq * 16) : lds_byte(wr * 64 + fr, fq * 8), boff = FP8 ? lds_byte(wc * 32 + fr, fq * 16) : lds_byte(wc * 32 + fr, fq * 8);
#define PG8_SA(b, h) (((b) * 2 + (h)) * HTB)
#define PG8_SB(b, h) ((4 + (b) * 2 + (h)) * HTB)
#define PG8_STB(bufoff, gbase) stage2(lds, (bufoff) + ldsw, (gbase), voff[0], voff[1])
#define PG8_STA(bufoff, dbase, gko, g0, g1) do { if (GATHER) stage2(lds, (bufoff) + ldsw, Ag + (gko), (g0), (g1)); else stage2(lds, (bufoff) + ldsw, (dbase), voff[0], voff[1]); } while (0)
#define PG8_LDA(dst, b, h) do { if constexpr (FP8) { _Pragma("unroll") for (int m = 0; m < 4; ++m) { const u32x4v lo_ = *(const LAS u32x4v*)(lds + PG8_SA(b, h) + aoff + m * 2048), hi_ = *(const LAS u32x4v*)(lds + PG8_SA(b, h) + aoff + m * 2048 + 16); \
            dst##8[m] = (v8i){(int)lo_.x, (int)lo_.y, (int)lo_.z, (int)lo_.w, (int)hi_.x, (int)hi_.y, (int)hi_.z, (int)hi_.w}; } } \
        else { _Pragma("unroll") for (int m = 0; m < 4; ++m) _Pragma("unroll") for (int k = 0; k < 2; ++k) dst[m][k] = *(const LAS f16x8*)(lds + PG8_SA(b, h) + aoff + m * 2048 + k * 1024); } } while (0)
#define PG8_LDB(dst, b, h) do { if constexpr (FP8) { _Pragma("unroll") for (int n = 0; n < 2; ++n) { const u32x4v lo_ = *(const LAS u32x4v*)(lds + PG8_SB(b, h) + boff + n * 2048), hi_ = *(const LAS u32x4v*)(lds + PG8_SB(b, h) + boff + n * 2048 + 16); \
            dst##8[n] = (v8i){(int)lo_.x, (int)lo_.y, (int)lo_.z, (int)lo_.w, (int)hi_.x, (int)hi_.y, (int)hi_.z, (int)hi_.w}; } } \
        else { _Pragma("unroll") for (int n = 0; n < 2; ++n) _Pragma("unroll") for (int k = 0; k < 2; ++k) dst[n][k] = *(const LAS f16x8*)(lds + PG8_SB(b, h) + boff + n * 2048 + k * 1024); } } while (0)
#define PG8_MMA(ai, bj, At, Bt, Z) do { __builtin_amdgcn_s_setprio(1); if constexpr (FP8) { _Pragma("unroll") for (int m = 0; m < 4; ++m) _Pragma("unroll") for (int n = 0; n < 2; ++n) { \
            if (Z) asm volatile("v_mfma_scale_f32_16x16x128_f8f6f4 %0, %1, %2, 0, %3, %4 op_sel_hi:[0,0,0]" : "=&v"(acc[ai][bj][m][n]) : "v"(Bt##8[n]), "v"(At##8[m]), "v"(scaleW), "v"(scaleA)); \
            else asm volatile("v_mfma_scale_f32_16x16x128_f8f6f4 %0, %1, %2, %0, %3, %4 op_sel_hi:[0,0,0]" : "+v"(acc[ai][bj][m][n]) : "v"(Bt##8[n]), "v"(At##8[m]), "v"(scaleW), "v"(scaleA)); } } \
        else { _Pragma("unroll") for (int m = 0; m < 4; ++m) _Pragma("unroll") for (int n = 0; n < 2; ++n) { \
            acc[ai][bj][m][n] = __builtin_amdgcn_mfma_f32_16x16x32_f16(Bt[n][0], At[m][0], (Z) ? (f32x4){0.f, 0.f, 0.f, 0.f} : acc[ai][bj][m][n], 0, 0, 0); \
            acc[ai][bj][m][n] = __builtin_amdgcn_mfma_f32_16x16x32_f16(Bt[n][1], At[m][1], acc[ai][bj][m][n], 0, 0, 0); } } __builtin_amdgcn_s_setprio(0); } while (0)
#define PG8_WAIT_V(n) asm volatile("s_waitcnt vmcnt(" #n ")" ::: "memory")
#define PG8_WAIT_L(n) asm volatile("s_waitcnt lgkmcnt(" #n ")" ::: "memory")
#define PG8_BAR __builtin_amdgcn_s_barrier()
#define PG8_SCHED __builtin_amdgcn_sched_barrier(0)
    LAS unsigned* const sideR = (LAS unsigned*)(lds + STAGE_BYTES), * const sideE = (LAS unsigned*)(lds + STAGE_BYTES + 2048), * const sideT = (LAS unsigned*)(lds + STAGE_BYTES + 2560);
    GUnit cur, nxt, nn; int ui = 0; bool sc = false;
    if (!S.next(0, cur)) return;
    if constexpr (Sched::HAS_E) cur.B = S.bptr(cur, __builtin_amdgcn_readfirstlane(*S.eptr(cur)));
    unsigned cg0[2] = {0, 0}, cg1[2] = {0, 0}, ng0[2] = {0, 0}, ng1[2] = {0, 0};
    if (GATHER) {
#pragma unroll
        for (int i = 0; i < 2; ++i) { cg0[i] = (unsigned)tok[cur.pm * 256 + sR[i]] * (unsigned)PB + sC2[i]; cg1[i] = (unsigned)tok[cur.pm * 256 + 128 + sR[i]] * (unsigned)PB + sC2[i]; }
    }
#define PG8_SIDE_NEXT(u_, slot_) do { \
        if (Sched::HAS_E && wid == 4) __builtin_amdgcn_global_load_lds((const unsigned*)S.eptr(u_), sideE + (slot_) * 64, 4, 0, 0); \
        if (GATHER && wid >= 4) __builtin_amdgcn_global_load_lds((const unsigned*)tok + (u_).pm * 256 + (wid - 4) * 64 + lane, sideT + (slot_) * 256 + (wid - 4) * 64, 4, 0, 0); } while (0)
    if ((Sched::HAS_E || GATHER) && S.next(1, nxt)) PG8_SIDE_NEXT(nxt, 1);
    f32x4 acc[2][2][4][2];
    f16x8 At[4][2], B0[2][2], B1[2][2]; v8i At8[4], B08[2], B18[2];
    const char* cA = cur.A; const char* cB = cur.B;
    PG8_STB(PG8_SB(0, 0), cB); PG8_STB(PG8_SB(0, 1), cB + hstep); PG8_STA(PG8_SA(0, 0), cA, 0, cg0[0], cg0[1]); PG8_STA(PG8_SA(0, 1), cA + hstep, 0, cg1[0], cg1[1]);
    if (wr == 1) PG8_BAR;
    PG8_WAIT_V(2); PG8_BAR;
    PG8_STB(PG8_SB(1, 0), cB + kstep); PG8_STA(PG8_SA(1, 0), cA + kstep, kstep, cg0[0], cg0[1]); PG8_STB(PG8_SB(1, 1), cB + hstep + kstep);
    PG8_WAIT_V(0); PG8_BAR;
    for (;;) {
        const bool has_next = S.next(ui + 1, nxt);
        if (has_next) {
            if constexpr (Sched::HAS_E) nxt.B = S.bptr(nxt, __builtin_amdgcn_readfirstlane((int)sideE[((ui + 1) & 1) * 64]));
            if (GATHER) {
#pragma unroll
                for (int i = 0; i < 2; ++i) { ng0[i] = sideT[((ui + 1) & 1) * 256 + sR[i]] * (unsigned)PB + sC2[i]; ng1[i] = sideT[((ui + 1) & 1) * 256 + 128 + sR[i]] * (unsigned)PB + sC2[i]; }
            }
        } else { ng0[0] = cg0[0]; ng0[1] = cg0[1]; ng1[0] = cg1[0]; ng1[1] = cg1[1]; }
        if (rowarg != nullptr && wid < 4) __builtin_amdgcn_global_load_lds(rowarg + cur.pm * 256 + wid * 64 + lane, sideR + (ui & 1) * 256 + wid * 64, 4, 0, 0);
        if ((Sched::HAS_E || GATHER) && has_next && S.next(ui + 2, nn)) PG8_SIDE_NEXT(nn, ui & 1);
        const char* nA = has_next ? nxt.A : cA; const char* nB = has_next ? nxt.B : cB;
        const bool sn = ARES && has_next && nxt.pm == cur.pm;
#define PG8_ITER(FIRST) do { \
            const bool last = (t == nt - 2); \
            const size_t ko1 = (size_t)(t + 1) * kstep, ko2 = last ? 0 : (size_t)(t + 2) * kstep, ko3 = ko2 + kstep; \
            const char* a1 = cA + ko1; \
            const char* a2 = (last ? nA : cA) + ko2; const char* b2 = (last ? nB : cB) + ko2; \
            const char* a3 = a2 + kstep; const char* b3 = b2 + kstep; \
            const unsigned g20 = last ? ng0[0] : cg0[0], g21 = last ? ng0[1] : cg0[1], h20 = last ? ng1[0] : cg1[0], h21 = last ? ng1[1] : cg1[1]; \
              \
            PG8_LDB(B0, 0, 0); PG8_LDB(B1, 0, 1); PG8_SCHED; PG8_LDA(At, 0, 0); if (!(ARES && sc)) PG8_STA(PG8_SA(1, 1), a1 + hstep, ko1, cg1[0], cg1[1]); \
            if (!(FIRST)) PG8_WAIT_V(8); PG8_WAIT_L(0); PG8_BAR; PG8_MMA(0, 0, At, B0, FIRST); PG8_MMA(0, 1, At, B1, FIRST); PG8_BAR; PG8_SCHED; \
              \
            PG8_LDA(At, 0, 1); PG8_STB(PG8_SB(0, 0), b2); PG8_STB(PG8_SB(0, 1), b2 + hstep); if (!(ARES && sn)) PG8_STA(PG8_SA(0, 0), a2, ko2, g20, g21); \
            if (!(FIRST)) PG8_WAIT_V(8); PG8_WAIT_L(0); PG8_BAR; PG8_MMA(1, 0, At, B0, FIRST); PG8_MMA(1, 1, At, B1, FIRST); PG8_BAR; PG8_SCHED; \
              \
            PG8_LDB(B0, 1, 0); PG8_LDB(B1, 1, 1); PG8_SCHED; PG8_LDA(At, 1, 0); if (!(ARES && sn)) PG8_STA(PG8_SA(0, 1), a2 + hstep, ko2, h20, h21); \
            if (ARES && sn) PG8_WAIT_V(4); else PG8_WAIT_V(8); PG8_WAIT_L(0); PG8_BAR; PG8_MMA(0, 0, At, B0, 0); PG8_MMA(0, 1, At, B1, 0); PG8_BAR; PG8_SCHED; \
              \
            PG8_LDA(At, 1, 1); PG8_STB(PG8_SB(1, 0), b3); PG8_STB(PG8_SB(1, 1), b3 + hstep); if (!(ARES && sn)) PG8_STA(PG8_SA(1, 0), a3, ko3, g20, g21); \
            if (ARES && sn) PG8_WAIT_V(4); else PG8_WAIT_V(8); PG8_WAIT_L(0); PG8_BAR; PG8_MMA(1, 0, At, B0, 0); PG8_MMA(1, 1, At, B1, 0); PG8_BAR; PG8_SCHED; \
        } while (0)
        { const int t = 0; PG8_ITER(1); }
#pragma unroll 1
        for (int t = 2; t < nt; t += 2) PG8_ITER(0);
        if constexpr (FP8) {
#pragma unroll
            for (int a_ = 0; a_ < 2; ++a_)
#pragma unroll
                for (int b_ = 0; b_ < 2; ++b_)
                    asm volatile("s_nop 15\n\ts_nop 7" : "+v"(acc[a_][b_][0][0]), "+v"(acc[a_][b_][0][1]), "+v"(acc[a_][b_][1][0]), "+v"(acc[a_][b_][1][1]), "+v"(acc[a_][b_][2][0]), "+v"(acc[a_][b_][2][1]), "+v"(acc[a_][b_][3][0]), "+v"(acc[a_][b_][3][1]));
        }
        PG8_WAIT_V(0);
        if (wr == 0) PG8_BAR;
        { int fr_e = fr, fq_e = fq; asm volatile("" : "+v"(fr_e), "+v"(fq_e));
          E(acc, cur, wr, wc, fr_e, fq_e, (const LAS unsigned*)(sideR + (ui & 1) * 256)); }
        if (!has_next) break;
        cur = nxt; cA = nA; cB = nB; ++ui; sc = sn;
        cg0[0] = ng0[0]; cg0[1] = ng0[1]; cg1[0] = ng1[0]; cg1[1] = ng1[1];
        if (wr == 1) PG8_BAR;
    }
    PG8_WAIT_V(0);
    PG8_BAR;
#undef PG8_SA
#undef PG8_SB
#undef PG8_STB
#undef PG8_STA
#undef PG8_LDA
#undef PG8_LDB
#undef PG8_MMA
#undef PG8_ITER
#undef PG8_SIDE_NEXT
#undef PG8_WAIT_V
#undef PG8_WAIT_L
#undef PG8_BAR
#undef PG8_SCHED
}

DEV void swap16(unsigned& a, unsigned& b) { const auto r = __builtin_amdgcn_permlane16_swap(a, b, false, false); a = r[0]; b = r[1]; }
DEV void swap32(unsigned& a, unsigned& b) { const auto r = __builtin_amdgcn_permlane32_swap(a, b, false, false); a = r[0]; b = r[1]; }
typedef _Float16 f16x2v __attribute__((ext_vector_type(2)));
DEV unsigned pkh(float a, float b) { f16x2v t; t.x = (f16)a; t.y = (f16)b; return __builtin_bit_cast(unsigned, t); }
DEV unsigned pkb(float a, float b) { typedef __bf16 bfx2 __attribute__((ext_vector_type(2))); typedef float fx2 __attribute__((ext_vector_type(2))); const fx2 v = {a, b}; return __builtin_bit_cast(unsigned, __builtin_convertvector(v, bfx2)); }
DEV void store_pair16b(f16* rowbase, const f32x4 v0, const f32x4 v1, int fq) {
    unsigned al = pkb(v0.x, v0.y), ah = pkb(v0.z, v0.w), bl = pkb(v1.x, v1.y), bh = pkb(v1.z, v1.w);
    swap16(al, bl); swap16(ah, bh);
    const int co = (fq & 1) ? 16 + 4 * (fq - 1) : 4 * fq;
    *(uint4*)(rowbase + co) = make_uint4(al, ah, bl, bh);
}
DEV void store_pair16(f16* rowbase, const f32x4 v0, const f32x4 v1, int fq) {
    unsigned al = pkh(v0.x, v0.y), ah = pkh(v0.z, v0.w), bl = pkh(v1.x, v1.y), bh = pkh(v1.z, v1.w);
    swap16(al, bl); swap16(ah, bh);
    const int co = (fq & 1) ? 16 + 4 * (fq - 1) : 4 * fq;
    *(uint4*)(rowbase + co) = make_uint4(al, ah, bl, bh);
}
struct EpiPlain {
    f16* O; int ldc;
    DEV void operator()(const f32x4 (&acc)[2][2][4][2], const GUnit& u, int wr, int wc, int fr, int fq, const LAS unsigned* side) const {
#pragma unroll
        for (int ai = 0; ai < 2; ++ai)
#pragma unroll
            for (int m = 0; m < 4; ++m) { f16* rowp = O + (size_t)(u.pm * BM + ai * HALF + wr * 64 + m * 16 + fr) * ldc + u.pn * BM + wc * 32;
#pragma unroll
                for (int bj = 0; bj < 2; ++bj) store_pair16(rowp + bj * HALF, acc[ai][bj][m][0], acc[ai][bj][m][1], fq); }
    }
};
struct EpiInProj {
    f16* O; const LAS float* qg; const LAS float* kg; const LAS float* rope;
    DEV void operator()(f32x4 (&acc)[2][2][4][2], const GUnit& u, int wr, int wc, int fr, int fq, const LAS unsigned* side) const {
        const int pn = u.pn, seg = u.pm % 9; const bool latent = seg > 0;
        const bool isq = (pn < 2) || (pn == 6) || (pn == 7);
        const bool isk = (pn == 2) || (pn == 3) || (pn == 8 && wc < 2);
        const bool norm = (pn == 6) || (pn == 7) || (pn == 8 && wc < 2);
        const bool isv = (pn == 4) || (pn == 5) || (pn == 8 && wc >= 2);
        if (norm) {
            const LAS float* g = isq ? qg : kg;
            f32x4 gv[2][2];
#pragma unroll
            for (int bj = 0; bj < 2; ++bj)
#pragma unroll
                for (int n = 0; n < 2; ++n) gv[bj][n] = *(const LAS f32x4*)(g + 32 * bj + 16 * n + 4 * fq);
#pragma unroll
            for (int ai = 0; ai < 2; ++ai)
#pragma unroll
                for (int m = 0; m < 4; ++m) {
                    float ss = 0.f;
#pragma unroll
                    for (int bj = 0; bj < 2; ++bj)
#pragma unroll
                        for (int n = 0; n < 2; ++n) { const f32x4 v = acc[ai][bj][m][n]; ss += v.x * v.x + v.y * v.y + v.z * v.z + v.w * v.w; }
                    ss += __shfl_xor(ss, 16); ss += __shfl_xor(ss, 32);
                    const float rstd = rsqrtf(ss * (1.f / 64.f) + EPS);
#pragma unroll
                    for (int bj = 0; bj < 2; ++bj)
#pragma unroll
                        for (int n = 0; n < 2; ++n) acc[ai][bj][m][n] = acc[ai][bj][m][n] * rstd * gv[bj][n];
                }
        }
        if ((isq || isk) && latent) {
            const int s0 = (seg - 1) * 256;
#pragma unroll
            for (int ai = 0; ai < 2; ++ai) {
                const int prow = (s0 + ai * HALF + wr * 64) >> 6;
                const f32x4 r0 = *(const LAS f32x4*)(rope + (prow * 16 + 4 * fq) * 2), r1 = *(const LAS f32x4*)(rope + (prow * 16 + 4 * fq) * 2 + 4);
                const float rc[4] = {r0.x, r0.z, r1.x, r1.z}, rs[4] = {r0.y, r0.w, r1.y, r1.w};
#pragma unroll
                for (int m = 0; m < 4; ++m) {
                    const int pcol = m * 16 + fr;
                    const f32x4 c0 = *(const LAS f32x4*)(rope + (pcol * 16 + 4 * fq) * 2), c1 = *(const LAS f32x4*)(rope + (pcol * 16 + 4 * fq) * 2 + 4);
                    const float cc[4] = {c0.x, c0.z, c1.x, c1.z}, cs[4] = {c0.y, c0.w, c1.y, c1.w};
#pragma unroll
                    for (int q = 0; q < 4; ++q) {
                        const float a = acc[ai][0][m][0][q], b = acc[ai][0][m][1][q]; acc[ai][0][m][0][q] = a * rc[q] - b * rs[q]; acc[ai][0][m][1][q] = a * rs[q] + b * rc[q];
                        const float a2 = acc[ai][1][m][0][q], b2 = acc[ai][1][m][1][q]; acc[ai][1][m][0][q] = a2 * cc[q] - b2 * cs[q]; acc[ai][1][m][1][q] = a2 * cs[q] + b2 * cc[q];
                    }
                }
            }
        }
        const float sc = isq ? QSCALE : 1.f;
#pragma unroll
        for (int ai = 0; ai < 2; ++ai)
#pragma unroll
            for (int m = 0; m < 4; ++m) { f16* rowp = O + (size_t)(u.pm * BM + ai * HALF + wr * 64 + m * 16 + fr) * NIN + pn * BM + wc * 64;
#pragma unroll
                for (int bj = 0; bj < 2; ++bj) { if (isv) store_pair16b(rowp + bj * 32, acc[ai][bj][m][0], acc[ai][bj][m][1], fq); else store_pair16(rowp + bj * 32, acc[ai][bj][m][0] * sc, acc[ai][bj][m][1] * sc, fq); } }
    }
};
struct EpiGU {
    unsigned char* H; const float* wsl;
    DEV void operator()(const f32x4 (&acc)[2][2][4][2], const GUnit& u, int wr, int wc, int fr, int fq, const LAS unsigned* side) const {
#pragma unroll
        for (int ai = 0; ai < 2; ++ai)
#pragma unroll
            for (int m = 0; m < 4; ++m) { const int rl = ai * HALF + wr * 64 + m * 16 + fr, row = u.pm * BM + rl; const float w = __builtin_bit_cast(float, side[rl]) * 4.0f; unsigned char* rowp = H + (size_t)row * EH + u.pn * 128 + wc * 32;
                unsigned d[2];
#pragma unroll
                for (int n = 0; n < 2; ++n) { const f32x4 g = acc[ai][0][m][n], up = acc[ai][1][m][n];
                    int q = __builtin_amdgcn_cvt_pk_fp8_f32(c8(silu_f(g.x) * up.x * w), c8(silu_f(g.y) * up.y * w), 0, false); q = __builtin_amdgcn_cvt_pk_fp8_f32(c8(silu_f(g.z) * up.z * w), c8(silu_f(g.w) * up.w * w), q, true); d[n] = (unsigned)q; }
                swap16(d[0], d[1]);
                const int co = (fq & 1) ? 16 + 4 * (fq - 1) : 4 * fq;
                *(uint2*)(rowp + co) = make_uint2(d[0], d[1]); }
    }
};
struct EpiDown {
    unsigned char* Y; const int* pair;
    DEV void operator()(const f32x4 (&acc)[2][2][4][2], const GUnit& u, int wr, int wc, int fr, int fq, const LAS unsigned* side) const {
#pragma unroll
        for (int ai = 0; ai < 2; ++ai)
#pragma unroll
            for (int m = 0; m < 4; ++m) { const int pr = (int)side[ai * HALF + wr * 64 + m * 16 + fr];
                unsigned d[4];
#pragma unroll
                for (int bj = 0; bj < 2; ++bj)
#pragma unroll
                    for (int n = 0; n < 2; ++n) { const f32x4 v = acc[ai][bj][m][n]; int w = __builtin_amdgcn_cvt_pk_fp8_f32(c8(v.x), c8(v.y), 0, false); w = __builtin_amdgcn_cvt_pk_fp8_f32(c8(v.z), c8(v.w), w, true); d[bj * 2 + n] = (unsigned)w; }
                swap32(d[0], d[2]); swap32(d[1], d[3]); swap16(d[0], d[1]); swap16(d[2], d[3]);
                if (pr >= 0) *(uint4*)(Y + (size_t)pr * DM + u.pn * BM + wc * 64 + 16 * fq) = make_uint4(d[0], d[1], d[2], d[3]); }
    }
};
struct SchedInProj {
    const char* A; const char* B; int v, G;
    static constexpr bool HAS_E = false;
    DEV bool next(int i, GUnit& u) const {
        const int L = i * G + v; if (L >= 2304 + 160) return false;
        if (L < 2304) { const int pl = L / 9; u.pn = L % 9; u.pm = (pl >> 3) * 9 + 1 + (pl & 7); }
        else { const int Lc = L - 2304, q = Lc % 5; u.pm = (Lc / 5) * 9; u.pn = q < 4 ? 2 + q : 8; }
        u.A = A + (size_t)u.pm * 256 * DM * 2; u.B = B + (size_t)u.pn * 256 * DM * 2; u.aux = 0; return true;
    }
    DEV const int* eptr(const GUnit&) const { return nullptr; }
    DEV const char* bptr(const GUnit& u, int) const { return u.B; }
};
struct SchedDense {
    const char* A; const char* B; int v, G, nunits, ntn, K;
    static constexpr bool HAS_E = false;
    DEV bool next(int i, GUnit& u) const {
        const int L = i * G + v; if (L >= nunits) return false;
        u.pm = L / ntn; u.pn = L % ntn; u.A = A + (size_t)u.pm * 256 * K * 2; u.B = B + (size_t)u.pn * 256 * K * 2; u.aux = 0; return true;
    }
    DEV const int* eptr(const GUnit&) const { return nullptr; }
    DEV const char* bptr(const GUnit& u, int) const { return u.B; }
};
struct SchedGrouped {
    const char* A; const char* B; const int* blke; int v, G, nunits, ntn, K; size_t estride; int seq;
    static constexpr bool HAS_E = true;
    DEV bool next(int i, GUnit& u) const {
        if (seq) {
            const int nb = nunits / ntn, rf = nb / G, nf = rf * ntn;
            if (i < nf) { u.pm = (i / ntn) * G + v; u.pn = i % ntn; }
            else { const int L = (i - nf) * G + v; if (L >= (nb - rf * G) * ntn) return false; u.pm = rf * G + L / ntn; u.pn = L % ntn; }
        } else { const int L = i * G + v; if (L >= nunits) return false; u.pm = L / ntn; u.pn = L % ntn; }
        u.aux = 0; u.A = A + (size_t)u.pm * 256 * K * 2; u.B = nullptr; return true;
    }
    DEV const int* eptr(const GUnit& u) const { return blke + u.pm; }
    DEV const char* bptr(const GUnit& u, int e) const { return B + (size_t)e * estride + (size_t)u.pn * 256 * K * 2; }
};
}

namespace attn_body {
using bf16=_Float16;
using bf16x8=__attribute__((ext_vector_type(8)))short;
using s16x4=__attribute__((ext_vector_type(4)))short;
using f32x16=__attribute__((ext_vector_type(16)))float;
using u32x4=__attribute__((ext_vector_type(4)))unsigned;
using h16x8=__attribute__((ext_vector_type(8)))_Float16;
__device__ __forceinline__ f32x16 mf16(bf16x8 a,bf16x8 b,f32x16 c,int,int,int){return __builtin_amdgcn_mfma_f32_32x32x16_f16(__builtin_bit_cast(h16x8,a),__builtin_bit_cast(h16x8,b),c,0,0,0);}
constexpr int D=64,DM=2304;
constexpr int NW=8,QBLK=32,QB=QBLK*NW,KVBLK=64;
__device__ __forceinline__ int crow(int r,int hi){return (r&3)+8*(r>>2)+4*hi;}
#define SBAR() __builtin_amdgcn_sched_barrier(0)
__device__ __forceinline__ void cmask(f32x16&p0,f32x16&p1,int jb,int qrel,int hi){
  const float NEG=-INFINITY; int kb=64*jb+4*hi;
  #pragma unroll
  for(int r=0;r<16;++r){int kv=kb+(r&3)+8*(r>>2); if(kv>qrel)p0[r]=NEG; if(kv+32>qrel)p1[r]=NEG;}
}

constexpr int NSLOT=3, SLOTB=8192;
constexpr int LDS_K=0, LDS_V=NSLOT*SLOTB, LDS_WS=2*NSLOT*SLOTB, LDS_OST=LDS_WS+NW*64*4, LDS_BYTES=LDS_OST+NW*4096;
constexpr float C2=0.125f*1.4426950408889634f;
__device__ __forceinline__ void glds16(const void*gsrc,unsigned lds_dst){unsigned keep;
  asm volatile("s_mov_b32 %0, m0\n\ts_mov_b32 m0, %2\n\ts_nop 0\n\tglobal_load_lds_dwordx4 %1, off\n\ts_mov_b32 m0, %0":"=&s"(keep):"v"(gsrc),"s"(lds_dst):"memory");}
__device__ __forceinline__ float max3f(float a,float b,float c){float r;asm("v_max3_f32 %0, %1, %2, %3":"=v"(r):"v"(a),"v"(b),"v"(c));return r;}
__device__ __forceinline__ float max2f(float a,float b){float r;asm("v_max_f32_e32 %0, %1, %2":"=v"(r):"v"(a),"v"(b));return r;}
__device__ __forceinline__ float fadd_s(float a,float b){float r;asm("v_add_f32_e32 %0, %1, %2":"=v"(r):"v"(a),"v"(b));return r;}
__device__ __forceinline__ float fsub_s(float a,float b){float r;asm("v_sub_f32_e32 %0, %1, %2":"=v"(r):"v"(a),"v"(b));return r;}
typedef float f32x2_t __attribute__((ext_vector_type(2))); typedef _Float16 bf16x2_t __attribute__((ext_vector_type(2)));
__device__ __forceinline__ unsigned cvtpk_s(float lo,float hi){f32x2_t v={lo,hi};bf16x2_t b=__builtin_convertvector(v,bf16x2_t);return __builtin_bit_cast(unsigned,b);}
typedef __bf16 rbf16x2_t __attribute__((ext_vector_type(2))); typedef __bf16 rbf16x8_t __attribute__((ext_vector_type(8)));
__device__ __forceinline__ unsigned cvtpk_b(float lo,float hi){f32x2_t v={lo,hi};rbf16x2_t b=__builtin_convertvector(v,rbf16x2_t);return __builtin_bit_cast(unsigned,b);}
__device__ __forceinline__ f32x16 mfb16(bf16x8 a,bf16x8 b,f32x16 c,int,int,int){return __builtin_amdgcn_mfma_f32_32x32x16_bf16(__builtin_bit_cast(rbf16x8_t,a),__builtin_bit_cast(rbf16x8_t,b),c,0,0,0);}
#define WAIT_BAR(N) asm volatile("s_waitcnt vmcnt(" #N ") lgkmcnt(0)\n\ts_barrier":::"memory")

__device__ __forceinline__ void qkt(f32x16&p0,f32x16&p1,const char*Kslot,const bf16x8*qr,const f32x16&negm,int r32,int hi){
  const char*kb=Kslot+hi*1024+r32*16;
  #pragma unroll
  for(int d0=0;d0<4;++d0){
    const bf16x8 b0=*reinterpret_cast<const bf16x8*>(kb+d0*2048);
    const bf16x8 b1=*reinterpret_cast<const bf16x8*>(kb+d0*2048+512);
    if(d0==0){p0=mf16(b0,qr[0],negm,0,0,0);p1=mf16(b1,qr[0],negm,0,0,0);}
    else{p0=mf16(b0,qr[d0],p0,0,0,0);p1=mf16(b1,qr[d0],p1,0,0,0);}}
}
typedef __attribute__((address_space(3))) const char* lds_cptr;
typedef short v4i16_t __attribute__((ext_vector_type(4)));
__device__ __forceinline__ void kload8(bf16x8*kf,lds_cptr kp){
  kf[0]=*(const __attribute__((address_space(3))) bf16x8*)(kp);      kf[1]=*(const __attribute__((address_space(3))) bf16x8*)(kp+512);
  kf[2]=*(const __attribute__((address_space(3))) bf16x8*)(kp+2048); kf[3]=*(const __attribute__((address_space(3))) bf16x8*)(kp+2560);
  kf[4]=*(const __attribute__((address_space(3))) bf16x8*)(kp+4096); kf[5]=*(const __attribute__((address_space(3))) bf16x8*)(kp+4608);
  kf[6]=*(const __attribute__((address_space(3))) bf16x8*)(kp+6144); kf[7]=*(const __attribute__((address_space(3))) bf16x8*)(kp+6656);
}
__device__ __forceinline__ void kload2(bf16x8*kf,lds_cptr kp,int j){ kf[2*j]=*(const __attribute__((address_space(3))) bf16x8*)(kp+j*2048); kf[2*j+1]=*(const __attribute__((address_space(3))) bf16x8*)(kp+j*2048+512); }
__device__ __forceinline__ s16x4 vtr(lds_cptr p){ return __builtin_bit_cast(s16x4,__builtin_amdgcn_ds_read_tr16_b64_v4i16((__attribute__((address_space(3))) v4i16_t*)p)); }
__device__ __forceinline__ float rowmax(const f32x16&p0,const f32x16&p1){
  float a=max3f(p0[0],p0[1],p1[0]),b=max3f(p0[2],p0[3],p1[1]);a=max3f(a,p1[2],p1[3]);
  #pragma unroll
  for(int r=4;r<16;r+=4){a=max3f(a,p0[r],p0[r+1]);b=max3f(b,p0[r+2],p0[r+3]);a=max3f(a,p1[r],p1[r+1]);b=max3f(b,p1[r+2],p1[r+3]);}
  const float m=max2f(a,b);
  auto rr=__builtin_amdgcn_permlane32_swap(__float_as_uint(m),__float_as_uint(m),false,false);
  return max2f(__uint_as_float(rr[0]),__uint_as_float(rr[1]));
}
__device__ __forceinline__ void pv(f32x16*o,int vb,bf16x8 pa0,bf16x8 pa1,bf16x8 pa2,bf16x8 pa3){
  #pragma unroll
  for(int d0=0;d0<2;++d0){s16x4 lo[4],hi[4];
    #pragma unroll
    for(int ks=0;ks<4;++ks){
      asm volatile("ds_read_b64_tr_b16 %0,%1 offset:%c2":"=&v"(lo[ks]):"v"(vb),"i"(d0*4096+ks*1024):"memory");
      asm volatile("ds_read_b64_tr_b16 %0,%1 offset:%c2":"=&v"(hi[ks]):"v"(vb),"i"(d0*4096+ks*1024+512):"memory");}
    asm volatile("s_waitcnt lgkmcnt(0)":::"memory");SBAR();
    #define PK(k) (bf16x8){lo[k][0],lo[k][1],lo[k][2],lo[k][3],hi[k][0],hi[k][1],hi[k][2],hi[k][3]}
    o[d0]=mfb16(pa0,PK(0),o[d0],0,0,0);
    o[d0]=mfb16(pa1,PK(1),o[d0],0,0,0);
    o[d0]=mfb16(pa2,PK(2),o[d0],0,0,0);
    o[d0]=mfb16(pa3,PK(3),o[d0],0,0,0);
    #undef PK
  }
}

#ifndef ATTN_STORE16
#define ATTN_STORE16(p,v) (*(u32x4*)(p)=(v))
#endif
template<int THRL> __device__ __forceinline__ void attn_unit(const bf16*Qu,const bf16*__restrict__ Kh,const bf16*__restrict__ Vh,bf16*Ou,int opitch,char*shm){
  const int tid=threadIdx.x,lane=tid&63,r32=lane&31,hi=lane>>5; const int wid=__builtin_amdgcn_readfirstlane(tid>>6);
  const bf16*Qw=Qu+(long)(wid*QBLK)*DM;
  const unsigned lds0=(unsigned)(uintptr_t)shm;
  float*wsf=(float*)(shm+LDS_WS)+wid*64;
  const bf16*ksrc=Kh+(long)lane*DM+wid*8;
  const bf16*vsrc=Vh+(long)(16*(wid&3)+(lane>>2))*DM+(wid>>2)*32+(lane&3)*8;
  const unsigned kdst=lds0+LDS_K+wid*1024, vdst=lds0+LDS_V+wid*1024;
  #define DMA_K(t,slot) glds16(ksrc+(long)(t)*KVBLK*DM,(unsigned)__builtin_amdgcn_readfirstlane(kdst+(slot)))
  #define DMA_V(t,slot) glds16(vsrc+(long)(t)*KVBLK*DM,(unsigned)__builtin_amdgcn_readfirstlane(vdst+(slot)))
  const int vb0=(int)(lds0+LDS_V)+((lane>>4)&1)*32+(lane&3)*8+(4*hi+((lane&15)>>2))*64;
  const char*Kbase=shm+LDS_K; bf16x8 kf[8];
  const lds_cptr shm3=(lds_cptr)shm; const lds_cptr kp0=shm3+LDS_K+hi*1024+r32*16; const lds_cptr vp0=shm3+LDS_V+((lane>>4)&1)*32+(lane&3)*8+(4*hi+((lane&15)>>2))*64;
  constexpr int NT=36;
  DMA_K(0,0);DMA_V(0,0);DMA_K(1,SLOTB);
  bf16x8 qr[4];
  #pragma unroll
  for(int d0=0;d0<4;++d0)qr[d0]=*reinterpret_cast<const bf16x8*>(&Qw[(long)r32*DM+d0*16+hi*8]);
  float l_reg=0.f;f32x16 o[2];o[0]=f32x16{};o[1]=f32x16{};
  #define CMASK(P0,P1,t) do{}while(0)
  #define START(P0,P1) do{ _Pragma("unroll") for(int r=0;r<16;++r)P0[r]=__builtin_amdgcn_exp2f(P0[r]); }while(0)
  #define RESC() do{}while(0)
  f32x16 pA0,pA1,pB0,pB1;
  int sl_prev=0,sl_cur=0,sl_next=SLOTB;
  #define ROT() do{sl_prev=sl_cur;sl_cur=sl_next;sl_next=(sl_next==(NSLOT-1)*SLOTB)?0:sl_next+SLOTB;}while(0)
  DMA_K(2,2*SLOTB);
  WAIT_BAR(3);
  qkt(pA0,pA1,Kbase,qr,f32x16{},r32,hi);asm volatile("s_nop 15\n\ts_nop 7":"+v"(pA0),"+v"(pA1));CMASK(pA0,pA1,0);
  START(pA0,pA1);
  _Pragma("unroll") for(int r=0;r<16;++r)pA1[r]=__builtin_amdgcn_exp2f(pA1[r]);
  WAIT_BAR(0);
  DMA_K(3,0);DMA_V(1,SLOTB);
  ROT();
  kload8(kf,kp0+sl_cur);
  WAIT_BAR(2);
  s16x4 vlo[8],vhi[8]; u32x4 pw0,pw1,pw2,pw3;
  #define PKW(P,B) cvtpk_b(P[B],P[B+1])
  #define PAF(k) __builtin_bit_cast(bf16x8,pw##k)
  #define VFR(i) (bf16x8){vlo[i][0],vlo[i][1],vlo[i][2],vlo[i][3],vhi[i][0],vhi[i][1],vhi[i][2],vhi[i][3]}
  #define PIN(x) asm volatile("":"+v"(x))
  #define MX3(a,b,c) __builtin_fmaxf(__builtin_fmaxf((a),(b)),(c))
  #define GAPA(MF,A0,A1,A2,A3,W0,W1,PW) do{ MF; sacc+=A0; sacc+=A1; sacc+=A2; sacc+=A3; PIN(sacc); W0; W1; PIN(PW); SBAR(); }while(0)
  #define EX(v) __builtin_amdgcn_exp2f(v)
  #define GAPB(MF,X,B) do{ MF; X[B]=EX(X[B]); X[B+1]=EX(X[B+1]); X[B+2]=EX(X[B+2]); X[B+3]=EX(X[B+3]); PIN(X); SBAR(); }while(0)
  #define VRD(i) do{ vlo[i]=vtr(vp_+(((i)>>2)*4096+((i)&3)*1024)); vhi[i]=vtr(vp_+(((i)>>2)*4096+((i)&3)*1024+512)); }while(0)
  #define KRD(G,j) do{ if(G){ kload2(kf,kp0+sl_next,j); SBAR(); } }while(0)
  #define STEP(C0,C1,P0,P1,t,GK,GV,GL) do{ SBAR(); \
    const lds_cptr vp_=vp0+sl_prev; \
    VRD(0); SBAR(); float sacc=(P0[0]+P0[1]); \
    GAPA(C0=mf16(kf[0],qr[0],f32x16{},0,0,0), P0[2],P0[3],P0[4],P0[5],     pw0[0]=PKW(P0,0), pw0[1]=PKW(P0,2), pw0); \
    VRD(4); SBAR(); GAPA(C1=mf16(kf[1],qr[0],f32x16{},0,0,0), P0[6],P0[7],P0[8],P0[9],     pw0[2]=PKW(P0,4), pw0[3]=PKW(P0,6), pw0); \
    VRD(1); SBAR(); GAPA(C0=mf16(kf[2],qr[1],C0,0,0,0),   P0[10],P0[11],P0[12],P0[13], pw1[0]=PKW(P0,8), pw1[1]=PKW(P0,10), pw1); \
    VRD(5); SBAR(); GAPA(C1=mf16(kf[3],qr[1],C1,0,0,0),   P0[14],P0[15],P1[0],P1[1],   pw1[2]=PKW(P0,12),pw1[3]=PKW(P0,14), pw1); \
    VRD(2); SBAR(); GAPA(C0=mf16(kf[4],qr[2],C0,0,0,0),   P1[2],P1[3],P1[4],P1[5],     pw2[0]=PKW(P1,0), pw2[1]=PKW(P1,2), pw2); \
    VRD(6); SBAR(); GAPA(C1=mf16(kf[5],qr[2],C1,0,0,0),   P1[6],P1[7],P1[8],P1[9],     pw2[2]=PKW(P1,4), pw2[3]=PKW(P1,6), pw2); \
    VRD(3); SBAR(); GAPA(C0=mf16(kf[6],qr[3],C0,0,0,0),   P1[10],P1[11],P1[12],P1[13], pw3[0]=PKW(P1,8), pw3[1]=PKW(P1,10), pw3); \
    VRD(7); SBAR(); GAPA(C1=mf16(kf[7],qr[3],C1,0,0,0),   P1[14],P1[15],0.f,0.f,       pw3[2]=PKW(P1,12),pw3[3]=PKW(P1,14), pw3); \
    l_reg+=sacc; \
    if(GK){DMA_K((t)+3,sl_cur);} if(GV){DMA_V((t)+1,sl_next);} \
    SBAR(); \
    GAPB(o[0]=mfb16(PAF(0),VFR(0),o[0],0,0,0), C0,0); \
    GAPB(o[1]=mfb16(PAF(0),VFR(4),o[1],0,0,0), C0,4); \
    KRD(GL,0); GAPB(o[0]=mfb16(PAF(1),VFR(1),o[0],0,0,0), C0,8); \
    KRD(GL,1); GAPB(o[1]=mfb16(PAF(1),VFR(5),o[1],0,0,0), C0,12); \
    KRD(GL,2); GAPB(o[0]=mfb16(PAF(2),VFR(2),o[0],0,0,0), C1,0); \
    KRD(GL,3); GAPB(o[1]=mfb16(PAF(2),VFR(6),o[1],0,0,0), C1,4); \
    GAPB(o[0]=mfb16(PAF(3),VFR(3),o[0],0,0,0), C1,8); \
    GAPB(o[1]=mfb16(PAF(3),VFR(7),o[1],0,0,0), C1,12); \
    }while(0)
  int t=1;
  #undef CMASK
  #define CMASK(P0,P1,t) do{}while(0)
  for(;t+5<NT;t+=2){
    STEP(pB0,pB1,pA0,pA1,t,true,true,true);     WAIT_BAR(2); RESC(); ROT();
    STEP(pA0,pA1,pB0,pB1,t+1,true,true,true);   WAIT_BAR(2); RESC(); ROT();
  }
  #undef CMASK
  #define CMASK(P0,P1,t) do{}while(0)
  #define ENDW(tt) do{ if((tt)+3<NT){WAIT_BAR(2);} else if((tt)+2<NT){WAIT_BAR(1);} else {WAIT_BAR(0);} }while(0)
  for(;t+1<NT;t+=2){
    STEP(pB0,pB1,pA0,pA1,t,(t+3<NT),(t+1<NT),(t+1<NT));       ENDW(t);   RESC(); ROT();
    STEP(pA0,pA1,pB0,pB1,t+1,(t+4<NT),(t+2<NT),(t+2<NT));     ENDW(t+1); RESC(); ROT();
  }
  STEP(pB0,pB1,pA0,pA1,NT-1,false,false,false); RESC();
  { float sacc=pB0[0]+pB0[1]; _Pragma("unroll") for(int r=2;r<16;++r)sacc+=pB0[r]; _Pragma("unroll") for(int r=0;r<16;++r)sacc+=pB1[r]; l_reg+=sacc;
    pw0=(u32x4){PKW(pB0,0),PKW(pB0,2),PKW(pB0,4),PKW(pB0,6)};pw1=(u32x4){PKW(pB0,8),PKW(pB0,10),PKW(pB0,12),PKW(pB0,14)};pw2=(u32x4){PKW(pB1,0),PKW(pB1,2),PKW(pB1,4),PKW(pB1,6)};pw3=(u32x4){PKW(pB1,8),PKW(pB1,10),PKW(pB1,12),PKW(pB1,14)};
    SBAR(); pv(o,vb0+sl_cur,PAF(0),PAF(1),PAF(2),PAF(3)); }
  #undef PKW
  #undef PAF
  #undef VFR
  #undef PIN
  #undef MX3
  #undef GAPA
  #undef GAPB
  #undef EX
  #undef VRD
  #undef KRD
  #undef STEP
  #undef ENDW
  {auto rr=__builtin_amdgcn_permlane32_swap(__float_as_uint(l_reg),__float_as_uint(l_reg),false,false);l_reg=__uint_as_float(rr[0])+__uint_as_float(rr[1]);}
  if(hi==0)wsf[32+r32]=l_reg;asm volatile("s_waitcnt lgkmcnt(0)":::"memory");
  float rli[16];
  #pragma unroll
  for(int r=0;r<16;++r)rli[r]=__builtin_amdgcn_rcpf(wsf[32+crow(r,hi)]);
  bf16*Ow=Ou+(long)(wid*QBLK)*opitch;
  { bf16*stg=(bf16*)(shm+LDS_OST)+wid*2048;
    #pragma unroll
    for(int r=0;r<16;++r){const int orow=crow(r,hi);
      #pragma unroll
      for(int d0=0;d0<2;++d0)stg[orow*64+d0*32+r32]=(bf16)(o[d0][r]*rli[r]);}
    asm volatile("s_waitcnt lgkmcnt(0)":::"memory");
    #pragma unroll
    for(int i=0;i<4;++i){const int row=i*8+(lane>>3),ch=lane&7; const u32x4 v=*(const u32x4*)(stg+row*64+ch*8); ATTN_STORE16(Ow+(long)row*opitch+ch*8,v);} }
  asm volatile("s_waitcnt lgkmcnt(0)\n\ts_barrier":::"memory");
  #undef DMA_K
  #undef DMA_V
  #undef CMASK
  #undef START
  #undef RESC
  #undef ROT
}

constexpr int U_SLOTK=8192,U_LDS_K=0,U_LDS_V=3*U_SLOTK,U_LDS_WS=U_LDS_V+3*16384,U_LDS_OST=U_LDS_WS+2048,U_LDS_Q=U_LDS_OST+NW*4096,U_LDS_BYTES=U_LDS_Q+NW*4096;
template<int THRL> __device__ __forceinline__ void attn_unit128(const bf16*Qu,const bf16*__restrict__ Kh,const bf16*__restrict__ Vh,bf16*Ou,int opitch,char*shm){
  const int tid=threadIdx.x,lane=tid&63,r32=lane&31,hi=lane>>5; const int wid=__builtin_amdgcn_readfirstlane(tid>>6);
  const bf16*Qw=Qu+(long)(wid*QBLK)*DM;
  const unsigned lds0=(unsigned)(uintptr_t)shm;
  float*wsf=(float*)(shm+U_LDS_WS)+wid*64;
  const bf16*ksrc=Kh+(long)lane*DM+wid*8;
  const bf16*vsrc=Vh+(long)(16*(wid&3)+(lane>>2))*DM+(wid>>2)*32+(lane&3)*8;
  const unsigned kdst=lds0+U_LDS_K+wid*1024, vdst=lds0+U_LDS_V+wid*1024;
  #define DMA_K(t,slot) glds16(ksrc+(long)(t)*KVBLK*DM,(unsigned)__builtin_amdgcn_readfirstlane(kdst+(slot)))
  #define DMA_V(t,slot) do{ glds16(vsrc+(long)(t)*KVBLK*DM,(unsigned)__builtin_amdgcn_readfirstlane(vdst+2*(slot))); glds16(vsrc+(long)(t)*KVBLK*DM+64,(unsigned)__builtin_amdgcn_readfirstlane(vdst+2*(slot)+8192)); }while(0)
  const int vb0=(int)(lds0+U_LDS_V)+((lane>>4)&1)*32+(lane&3)*8+(4*hi+((lane&15)>>2))*64;
  bf16x8 kf[8];
  const lds_cptr shm3=(lds_cptr)shm; const lds_cptr kp0=shm3+U_LDS_K+hi*1024+r32*16; const lds_cptr vp0=shm3+U_LDS_V+((lane>>4)&1)*32+(lane&3)*8+(4*hi+((lane&15)>>2))*64;
  constexpr int NT=36;
  DMA_K(0,0);DMA_V(0,0);DMA_K(1,U_SLOTK);
  const lds_cptr qp0=shm3+U_LDS_Q+tid*16;
  { bf16x8 qr[4];
    #pragma unroll
    for(int d0=0;d0<4;++d0)qr[d0]=*reinterpret_cast<const bf16x8*>(&Qw[(long)r32*DM+d0*16+hi*8]);
    #pragma unroll
    for(int d0=0;d0<4;++d0)*(__attribute__((address_space(3))) bf16x8*)(qp0+d0*8192)=qr[d0]; }
  #define QF(d0) (*(const __attribute__((address_space(3))) bf16x8*)(qp0+(d0)*8192))
  float l_reg=0.f;f32x16 o[4];o[0]=f32x16{};o[1]=f32x16{};o[2]=f32x16{};o[3]=f32x16{};
  #define RESC() do{}while(0)
  f32x16 pA0,pA1,pB0,pB1;
  int sl_prev=0,sl_cur=0,sl_next=U_SLOTK;
  #define ROT() do{sl_prev=sl_cur;sl_cur=sl_next;sl_next=(sl_next==2*U_SLOTK)?0:sl_next+U_SLOTK;}while(0)
  DMA_K(2,2*U_SLOTK);
  WAIT_BAR(4);
  { kload8(kf,kp0);
    { const bf16x8 q0=QF(0),q1=QF(1),q2=QF(2),q3=QF(3);
    pA0=mf16(kf[0],q0,f32x16{},0,0,0);pA1=mf16(kf[1],q0,f32x16{},0,0,0);pA0=mf16(kf[2],q1,pA0,0,0,0);pA1=mf16(kf[3],q1,pA1,0,0,0);
    pA0=mf16(kf[4],q2,pA0,0,0,0);pA1=mf16(kf[5],q2,pA1,0,0,0);pA0=mf16(kf[6],q3,pA0,0,0,0);pA1=mf16(kf[7],q3,pA1,0,0,0); }
    asm volatile("s_nop 15\n\ts_nop 7":"+v"(pA0),"+v"(pA1));
    _Pragma("unroll") for(int r=0;r<16;++r){pA0[r]=__builtin_amdgcn_exp2f(pA0[r]);pA1[r]=__builtin_amdgcn_exp2f(pA1[r]);} }
  WAIT_BAR(0);
  DMA_K(3,0);DMA_V(1,U_SLOTK);
  ROT();
  kload8(kf,kp0+sl_cur);
  WAIT_BAR(3);
  s16x4 vrl[4],vrh[4]; u32x4 pw0,pw1,pw2,pw3;
  #define PKW(P,B) cvtpk_b(P[B],P[B+1])
  #define PAF(k) __builtin_bit_cast(bf16x8,pw##k)
  #define FID(g) ((((g)&3)<<2)+((g)>>2))
  #define VF(g) (bf16x8){vrl[(g)&3][0],vrl[(g)&3][1],vrl[(g)&3][2],vrl[(g)&3][3],vrh[(g)&3][0],vrh[(g)&3][1],vrh[(g)&3][2],vrh[(g)&3][3]}
  #define VRDR(g) do{ vrl[(g)&3]=vtr(vp_+((FID(g)>>2)*4096+(FID(g)&3)*1024)); vrh[(g)&3]=vtr(vp_+((FID(g)>>2)*4096+(FID(g)&3)*1024+512)); }while(0)
  #define PIN(x) asm volatile("":"+v"(x))
  #define MX3(a,b,c) __builtin_fmaxf(__builtin_fmaxf((a),(b)),(c))
  #define EX(v) __builtin_amdgcn_exp2f(v)
  { float s0=pA0[0]+pA0[1]; _Pragma("unroll") for(int r=2;r<16;++r)s0+=pA0[r]; _Pragma("unroll") for(int r=0;r<16;++r)s0+=pA1[r]; l_reg+=s0;
    pw0=(u32x4){PKW(pA0,0),PKW(pA0,2),PKW(pA0,4),PKW(pA0,6)};pw1=(u32x4){PKW(pA0,8),PKW(pA0,10),PKW(pA0,12),PKW(pA0,14)};pw2=(u32x4){PKW(pA1,0),PKW(pA1,2),PKW(pA1,4),PKW(pA1,6)}; pw3=(u32x4){0u,0u,0u,0u}; }
  #define GAPA(MF,W) do{ MF; W; SBAR(); }while(0)
  #define GAPB(g,KS,X,B,PKSTMT) do{ o[(g)&3]=mfb16(PAF(KS),VF(g),o[(g)&3],0,0,0); if((g)+4<16){VRDR((g)+4);} X[B]=EX(X[B]); X[B+1]=EX(X[B+1]); sacc+=X[B]; sacc+=X[B+1]; PIN(sacc); PKSTMT; PIN(X); SBAR(); }while(0)
  #define KRD(G,j) do{ if(G){ kload2(kf,kp0+sl_next,j); SBAR(); } }while(0)
  #define STEP(C0,C1,P0,P1,t,GK,GV,GL) do{ SBAR(); \
    const lds_cptr vp_=vp0+2*sl_prev; \
    bf16x8 qa=QF(0),qb=QF(1); SBAR(); \
    GAPA(C0=mf16(kf[0],qa,f32x16{},0,0,0), pw3[0]=PKW(P1,8)); \
    GAPA(C1=mf16(kf[1],qa,f32x16{},0,0,0), pw3[1]=PKW(P1,10)); \
    qa=QF(2); SBAR(); \
    GAPA(C0=mf16(kf[2],qb,C0,0,0,0),       pw3[2]=PKW(P1,12)); \
    GAPA(C1=mf16(kf[3],qb,C1,0,0,0),       pw3[3]=PKW(P1,14); PIN(pw3)); \
    qb=QF(3); SBAR(); \
    VRDR(0); SBAR(); GAPA(C0=mf16(kf[4],qa,C0,0,0,0), (void)0); \
    VRDR(1); SBAR(); GAPA(C1=mf16(kf[5],qa,C1,0,0,0), (void)0); \
    VRDR(2); SBAR(); GAPA(C0=mf16(kf[6],qb,C0,0,0,0), (void)0); \
    VRDR(3); SBAR(); GAPA(C1=mf16(kf[7],qb,C1,0,0,0), (void)0); \
    if(GK){DMA_K((t)+3,sl_cur);} if(GV){DMA_V((t)+1,sl_next);} \
    float sacc=0.f; \
    SBAR(); \
    GAPB(0,0,C0,0,(void)0);  GAPB(1,0,C0,2,(void)0);  GAPB(2,0,C0,4,(void)0);  GAPB(3,0,C0,6,(void)0); \
    KRD(GL,0); GAPB(4,1,C0,8,pw0[0]=PKW(C0,0));  KRD(GL,1); GAPB(5,1,C0,10,pw0[1]=PKW(C0,2)); KRD(GL,2); GAPB(6,1,C0,12,pw0[2]=PKW(C0,4)); KRD(GL,3); GAPB(7,1,C0,14,pw0[3]=PKW(C0,6); PIN(pw0)); \
    GAPB(8,2,C1,0,pw1[0]=PKW(C0,8));  GAPB(9,2,C1,2,pw1[1]=PKW(C0,10)); GAPB(10,2,C1,4,pw1[2]=PKW(C0,12)); GAPB(11,2,C1,6,pw1[3]=PKW(C0,14); PIN(pw1)); \
    GAPB(12,3,C1,8,pw2[0]=PKW(C1,0)); GAPB(13,3,C1,10,pw2[1]=PKW(C1,2));GAPB(14,3,C1,12,pw2[2]=PKW(C1,4));GAPB(15,3,C1,14,pw2[3]=PKW(C1,6); PIN(pw2)); \
    l_reg+=sacc; \
    }while(0)
  int t=1;
  for(;t+5<NT;t+=2){
    STEP(pB0,pB1,pA0,pA1,t,true,true,true);     WAIT_BAR(3); RESC(); ROT();
    STEP(pA0,pA1,pB0,pB1,t+1,true,true,true);   WAIT_BAR(3); RESC(); ROT();
  }
  #define ENDW(tt) do{ if((tt)+3<NT){WAIT_BAR(3);} else if((tt)+2<NT){WAIT_BAR(2);} else {WAIT_BAR(0);} }while(0)
  for(;t+1<NT;t+=2){
    STEP(pB0,pB1,pA0,pA1,t,(t+3<NT),(t+1<NT),(t+1<NT));       ENDW(t);   RESC(); ROT();
    STEP(pA0,pA1,pB0,pB1,t+1,(t+4<NT),(t+2<NT),(t+2<NT));     ENDW(t+1); RESC(); ROT();
  }
  STEP(pB0,pB1,pA0,pA1,NT-1,false,false,false); RESC();
  { pw3=(u32x4){PKW(pB1,8),PKW(pB1,10),PKW(pB1,12),PKW(pB1,14)};
    SBAR(); pv(o,vb0+2*sl_cur,PAF(0),PAF(1),PAF(2),PAF(3)); pv(o+2,vb0+2*sl_cur+8192,PAF(0),PAF(1),PAF(2),PAF(3)); }
  #undef PKW
  #undef PAF
  #undef FID
  #undef VF
  #undef VRDR
  #undef PIN
  #undef MX3
  #undef GAPA
  #undef GAPB
  #undef EX
  #undef KRD
  #undef STEP
  #undef ENDW
  {auto rr=__builtin_amdgcn_permlane32_swap(__float_as_uint(l_reg),__float_as_uint(l_reg),false,false);l_reg=__uint_as_float(rr[0])+__uint_as_float(rr[1]);}
  if(hi==0)wsf[32+r32]=l_reg;asm volatile("s_waitcnt lgkmcnt(0)":::"memory");
  float rli[16];
  #pragma unroll
  for(int r=0;r<16;++r)rli[r]=__builtin_amdgcn_rcpf(wsf[32+crow(r,hi)]);
  { bf16*stg=(bf16*)(shm+U_LDS_OST)+wid*2048;
    bf16*Ow=Ou+(long)(wid*QBLK)*opitch;
    #pragma unroll
    for(int hf=0;hf<2;++hf){
      #pragma unroll
      for(int r=0;r<16;++r){const int orow=crow(r,hi);
        #pragma unroll
        for(int d0=0;d0<2;++d0)stg[orow*64+d0*32+r32]=(bf16)(o[2*hf+d0][r]*rli[r]);}
      asm volatile("s_waitcnt lgkmcnt(0)":::"memory");
      #pragma unroll
      for(int i=0;i<4;++i){const int row=i*8+(lane>>3),ch=lane&7; const u32x4 v=*(const u32x4*)(stg+row*64+ch*8); *(u32x4*)(Ow+(long)row*opitch+hf*64+ch*8)=v;}
      asm volatile("s_waitcnt lgkmcnt(0)":::"memory"); } }
  asm volatile("s_waitcnt lgkmcnt(0)\n\ts_barrier":::"memory");
  #undef DMA_K
  #undef DMA_V
  #undef RESC
  #undef ROT
  #undef QF
}

__device__ __forceinline__ void diff_combine_unit(const bf16*O0u,const bf16*O1u,int opitch,float lam,const float*subg,bf16*Mx){
  const int tid=threadIdx.x,lane=tid&63; const int wid=__builtin_amdgcn_readfirstlane(tid>>6);
  asm volatile("s_waitcnt vmcnt(0)":::"memory");
  const bf16*O0w=O0u+(long)(wid*QBLK)*opitch; const bf16*O1w=O1u+(long)(wid*QBLK)*opitch; bf16*Mw=Mx+(long)(wid*QBLK)*1024;
  float sg[16];
  #pragma unroll
  for(int j=0;j<16;++j)sg[j]=subg[(j>>3)*64+(lane&7)*8+(j&7)];
  #pragma unroll
  for(int i=0;i<4;++i){const int row=i*8+(lane>>3),ch=lane&7;
    float d[16]; float ss=0.f;
    #pragma unroll
    for(int hf=0;hf<2;++hf){ const h16x8 v0=*(const h16x8*)(O0w+(long)row*opitch+hf*64+ch*8); const h16x8 v1=*(const h16x8*)(O1w+(long)row*opitch+hf*64+ch*8);
      #pragma unroll
      for(int j=0;j<8;++j){d[hf*8+j]=(float)v0[j]-lam*(float)v1[j];ss+=d[hf*8+j]*d[hf*8+j];} }
    ss+=__shfl_xor(ss,1);ss+=__shfl_xor(ss,2);ss+=__shfl_xor(ss,4);
    const float rs=__builtin_amdgcn_rsqf(ss*(1.f/128.f)+1e-6f)*0.8f;
    #pragma unroll
    for(int hf=0;hf<2;++hf){ h16x8 ov;
      #pragma unroll
      for(int j=0;j<8;++j)ov[j]=(_Float16)(d[hf*8+j]*rs*sg[hf*8+j]);
      *(h16x8*)(Mw+(long)row*1024+hf*64+ch*8)=ov; } }
}
constexpr int ATTN_LDS_BYTES=LDS_BYTES;
#undef SBAR
#undef WAIT_BAR
}

DEV void ph_attn(const Frame& F, int vcu) {
    const f16* qkv = WSP(f16, WS_QKV); f16* sdiff = WSP(f16, WS_SDIFF); f16* mixed = WSP(f16, WS_MIXED);
    const int spr = F.G >> 3, qb = vcu & 7;
#pragma unroll 1
    for (int i = 0;; ++i) {
        const int L = i * spr + (vcu >> 3); if (L >= NB * 4) break;
        const int b = L >> 2, h = L & 3;
        const size_t trow = (size_t)b * SEQ + qb * 256;
        const f16* base = qkv + (size_t)b * RB * NIN;
        const f16* qrow = base + (size_t)(CL + qb * 256) * NIN;
        f16* o0 = sdiff + trow * 512 + h * 128;
#pragma unroll 1
        for (int mp = 0; mp < 2; ++mp)
            attn_body::attn_unit128<8>(qrow + h * 128 + mp * 64, base + 512 + h * 128 + mp * 64, base + 1024 + h * 128, o0 + (size_t)mp * NT * 512, 512, (char*)F.lds);
        attn_body::diff_combine_unit(o0, o0 + (size_t)NT * 512, 512, WSP(float, WS_MISC)[0], F.in[15], mixed + trow * DM + h * 128);
    }
#pragma unroll 1
    for (int i = 0;; ++i) {
        const int L = i * spr + (vcu >> 3); if (L >= NB * 8) break;
        const int b = L >> 3, g = L & 7;
        const size_t trow = (size_t)b * SEQ + qb * 256;
        const f16* base = qkv + (size_t)b * RB * NIN;
        attn_body::attn_unit<8>(base + (size_t)(CL + qb * 256) * NIN + 1536 + g * 64, base + 2048 + (g >> 2) * 64, base + 2176 + (g >> 2) * 64, mixed + trow * DM + 512 + g * 64, DM, (char*)F.lds);
    }
}

DEV void ph_rowpass(const Frame& F) {
    const float* x = F.in[0]; const f16* y1 = WSP(f16, WS_Y1); const float* mod = WSP(float, WS_MOD); const float* gpost = F.in[7]; const float* gpre = F.in[17];
    const float* wr = F.in[19]; const float* rbias = F.in[20]; float* x1out = F.out; unsigned char* h2 = F.ws + WS_H2;
    int* idx = WSP(int, WS_IDX); int* rank = WSP(int, WS_RANK); float* gw = WSP(float, WS_GW); int* cnt = WSP(int, WS_CNT);
    constexpr int AROW = 2064;
    LAS unsigned char* Ahi = (LAS unsigned char*)F.lds; LAS unsigned char* Alo = Ahi + 16 * AROW; LAS float* part = (LAS float*)(Ahi + 32 * AROW);
    LAS int* lcnt = (LAS int*)(Ahi + 32 * AROW + 32768);
    if (F.tid < 64) lcnt[F.tid] = 0;
    const int wave = F.wave, lane = F.lane, fr = lane & 15, fq = lane >> 4;
    f16x8 Bh[4][4];
#pragma unroll
    for (int ks = 0; ks < 4; ++ks)
#pragma unroll
        for (int n = 0; n < 4; ++n) { const int k0 = wave * 128 + ks * 32 + fq * 8, e = n * 16 + fr;
#pragma unroll
            for (int j = 0; j < 8; ++j) Bh[ks][n][j] = (f16)wr[(k0 + j) * NE + e]; }
    const float rb = rbias[lane];
    f32x4 X[2][4]; f16x4 Y[2][4];
#define RP_LOAD(T0) do { _Pragma("unroll") for (int u = 0; u < 2; ++u) { const size_t t_ = (size_t)(T0) + wave * 2 + u; \
        _Pragma("unroll") for (int j = 0; j < 4; ++j) { const int c0 = j * 256 + lane * 4; X[u][j] = *(const f32x4*)(x + t_ * DM + c0); Y[u][j] = *(const f16x4*)(y1 + t_ * DM + c0); } } } while (0)
    constexpr int NBLK = NT / 256;
    if (F.bid < NBLK) RP_LOAD(F.bid * 256);
#pragma unroll 1
    for (int blk = F.bid; blk < NBLK; blk += F.G) {
      f32x4 A1[4], G2[4]; const float* const mb = mod + (size_t)(blk / (SEQ / 256)) * NMOD;
      { const float* m = mb;
#pragma unroll
        for (int j = 0; j < 4; ++j) { const int c0 = j * 256 + lane * 4; A1[j] = *(const f32x4*)(m + 2048 + c0) * *(const f32x4*)(gpost + c0); G2[j] = *(const f32x4*)(gpre + c0) * (*(const f32x4*)(m + 4096 + c0) + 1.f); } }
#pragma unroll 1
      for (int st = 0; st < 16; ++st) {
        const int t0 = blk * 256 + st * 16;
#pragma unroll
        for (int u = 0; u < 2; ++u) {
            const int r = wave * 2 + u; const size_t t = (size_t)t0 + r;
            float ss = 0.f;
#pragma unroll
            for (int j = 0; j < 4; ++j)
#pragma unroll
                for (int i = 0; i < 4; ++i) { const float yv = (float)Y[u][j][i]; ss += yv * yv; }
            const float rstd1 = rsqrtf(wave_sum(ss) * (1.f / DM) + EPS);
            float s2 = 0.f;
#pragma unroll
            for (int j = 0; j < 4; ++j) { const int c0 = j * 256 + lane * 4; f16x4 oh;
#pragma unroll
                for (int i = 0; i < 4; ++i) { const float v = X[u][j][i] + A1[j][i] * ((float)Y[u][j][i] * rstd1); X[u][j][i] = v; oh[i] = (f16)v; s2 += v * v; }
                *(f16x4*)((f16*)(x1out + t * DM) + c0) = oh; }
            const float rstd2 = rsqrtf(wave_sum(s2) * (1.f / DM) + EPS);
#pragma unroll
            for (int j = 0; j < 4; ++j) { const int c0 = j * 256 + lane * 4; const f32x4 sh = *(const f32x4*)(mb + 3072 + c0); f16x4 o, ol;
#pragma unroll
                for (int i = 0; i < 4; ++i) { const float v = X[u][j][i] * rstd2 * G2[j][i] + sh[i]; o[i] = (f16)v; ol[i] = (f16)(v - (float)o[i]); }
                { int q8 = __builtin_amdgcn_cvt_pk_fp8_f32(c8((float)o.x + (float)ol.x), c8((float)o.y + (float)ol.y), 0, false); q8 = __builtin_amdgcn_cvt_pk_fp8_f32(c8((float)o.z + (float)ol.z), c8((float)o.w + (float)ol.w), q8, true); *(int*)(h2 + t * DM + c0) = q8; }
                *(LAS f16x4*)(Ahi + r * AROW + c0 * 2) = o; *(LAS f16x4*)(Alo + r * AROW + c0 * 2) = ol; }
        }
        if (st < 15) RP_LOAD(t0 + 16); else if (blk + F.G < NBLK) RP_LOAD((blk + F.G) * 256);
        __syncthreads();
        { f32x4 acc[4];
#pragma unroll
          for (int n = 0; n < 4; ++n) acc[n] = (f32x4){0.f, 0.f, 0.f, 0.f};
#pragma unroll
          for (int ks = 0; ks < 4; ++ks) { const int off = fr * AROW + (wave * 128 + ks * 32 + fq * 8) * 2;
              const f16x8 ah = *(const LAS f16x8*)(Ahi + off), al = *(const LAS f16x8*)(Alo + off);
#pragma unroll
              for (int n = 0; n < 4; ++n) { acc[n] = __builtin_amdgcn_mfma_f32_16x16x32_f16(ah, Bh[ks][n], acc[n], 0, 0, 0); acc[n] = __builtin_amdgcn_mfma_f32_16x16x32_f16(al, Bh[ks][n], acc[n], 0, 0, 0); } }
#pragma unroll
          for (int n = 0; n < 4; ++n)
#pragma unroll
              for (int q = 0; q < 4; ++q) part[(wave * 16 + 4 * fq + q) * 64 + n * 16 + fr] = acc[n][q]; }
        __syncthreads();
#pragma unroll 1
        for (int rr = 0; rr < 2; ++rr) {
            const int r = wave * 2 + rr; const size_t t = (size_t)t0 + r; const int e = lane;
            float lgt = 0.f;
#pragma unroll
            for (int p = 0; p < 8; ++p) lgt += part[(p * 16 + r) * 64 + e];
            const float s = 1.f / (1.f + expf(-lgt)); const float sel = s + rb;
            int rk = 0;
#pragma unroll
            for (int d = 1; d < 8; ++d) { const float o = __shfl_xor(sel, d); rk += (o > sel || (o == sel && (e ^ d) < e)) ? 1 : 0; }
            float gs = rk < 2 ? sel : 0.f; gs += __shfl_xor(gs, 1); gs += __shfl_xor(gs, 2); gs += __shfl_xor(gs, 4);
            int grk = 0; const int g = e >> 3;
#pragma unroll
            for (int d = 1; d < 8; ++d) { const float o = __shfl_xor(gs, d * 8); grk += (o > gs || (o == gs && (g ^ d) < g)) ? 1 : 0; }
            const bool gsel = grk < 4;
            const float v = gsel ? sel : -INFINITY;
            int r8 = 0;
#pragma unroll
            for (int j = 0; j < 64; ++j) { const float o = __builtin_bit_cast(float, __builtin_amdgcn_readlane(__builtin_bit_cast(int, v), j)); r8 += (o > v || (o == v && j < e)) ? 1 : 0; }
            const bool chosen = gsel && r8 < 8;
            const float tot = wave_sum(chosen ? s : 0.f);
            if (chosen) { idx[t * 8 + r8] = e; gw[t * 8 + r8] = s / tot * 2.5f; rank[t * 8 + r8] = __hip_atomic_fetch_add(&lcnt[e], 1, __ATOMIC_RELAXED, __HIP_MEMORY_SCOPE_WORKGROUP); }
        }
      }
    }
#undef RP_LOAD
    __syncthreads();
    if (F.tid < 64) WSP(int, WS_WGB)[F.bid * 64 + F.tid] = atomicAdd(&cnt[F.tid * 64], lcnt[F.tid]);
    __syncthreads();
}

DEV void ph_dispatch(const Frame& F) {
    const int* idx = WSP(int, WS_IDX); const int* rank = WSP(int, WS_RANK); const float* gw = WSP(float, WS_GW); const int* cnt = WSP(int, WS_CNT); const int* wgb = WSP(int, WS_WGB);
    int* tok = WSP(int, WS_TOK); int* pair = WSP(int, WS_PAIR); float* wsl = WSP(float, WS_WSL); int* blke = WSP(int, WS_BLKE); int* nblk = WSP(int, WS_CTL) + 64;
    int* pst = (int*)F.lds;
    const int tid = F.tid;
    if (tid < 64) { const int pc = ((cnt[tid * 64] + 255) >> 8) << 8; int incl = pc;
#pragma unroll
        for (int o = 1; o < 64; o <<= 1) { const int n = __shfl_up(incl, o); if (tid >= o) incl += n; }
        pst[tid] = incl - pc; if (tid == 63) pst[64] = incl; }
    __syncthreads();
    for (int gid = F.bid * NTHR + tid; gid < NT * 8; gid += F.G * NTHR) {
        const int e = idx[gid]; const int t = gid >> 3, k = gid & 7; const int slot = NT + pst[e] + wgb[((t >> 8) % F.G) * 64 + e] + rank[gid]; tok[slot] = t; pair[slot] = t * NSLOTK + k; wsl[slot] = gw[gid];
        if (gid < NT) { tok[gid] = gid; pair[gid] = gid * NSLOTK + 8; wsl[gid] = 1.f; }
    }
    for (int e = F.bid; e < 64; e += F.G) {
        for (int s = NT + pst[e] + cnt[e * 64] + tid; s < NT + pst[e + 1]; s += NTHR) { tok[s] = 0; pair[s] = -1; wsl[s] = 0.f; }
    }
    if (F.bid == 0) {
        const int nb = SH_BLKS + (pst[64] >> 8);
        if (tid == 0) *nblk = nb;
        for (int bk = tid; bk < MAX_BLKS; bk += NTHR) {
            int e = 64;
            if (bk >= SH_BLKS) { const int off = (bk - SH_BLKS) << 8; e = 0; for (int q = 0; q < 64; ++q) if (off >= pst[q] && off < pst[q + 1]) e = q; }
            blke[bk] = e;
        }
    }
    __syncthreads();
}

DEV void ph_combine(const Frame& F, float* dst) {
    const unsigned char* yp = F.ws + WS_YP; const float* mod = WSP(float, WS_MOD); const float* gpf = F.in[18]; float* out = F.out;
    const int lane = F.lane;
    for (int blk = F.bid; blk < NT / 256; blk += F.G) {
      float A2[16];
      { const float* m = mod + (size_t)(blk / (SEQ / 256)) * NMOD + 5120;
#pragma unroll
        for (int i = 0; i < 4; ++i) { const int c0 = lane * 16 + i * 4; const f32x4 g = *(const f32x4*)(gpf + c0), gt = *(const f32x4*)(m + c0);
#pragma unroll
            for (int j = 0; j < 4; ++j) A2[i * 4 + j] = g[j] * gt[j]; } }
#pragma unroll 1
      for (int st = 0; st < 16; ++st) { const size_t t0 = (size_t)blk * 256 + st * 16 + F.wave * 2;
        f16x8 xa[2], xb[2]; uint4 w[2][NSLOTK];
#pragma unroll
        for (int u = 0; u < 2; ++u) { const size_t t = t0 + u;
            xa[u] = *(const f16x8*)((const f16*)(out + t * DM) + lane * 16); xb[u] = *(const f16x8*)((const f16*)(out + t * DM) + lane * 16 + 8);
#pragma unroll
            for (int k = 0; k < NSLOTK; ++k) w[u][k] = *(const uint4*)(yp + (t * NSLOTK + k) * DM + lane * 16); }
#pragma unroll
        for (int u = 0; u < 2; ++u) { const size_t t = t0 + u;
            float acc[16];
#pragma unroll
            for (int i = 0; i < 16; ++i) acc[i] = 0.f;
#pragma unroll
            for (int k = 0; k < NSLOTK; ++k) {
                const unsigned ww[4] = {w[u][k].x, w[u][k].y, w[u][k].z, w[u][k].w};
#pragma unroll
                for (int i = 0; i < 4; ++i) { const f32x2 lo = __builtin_amdgcn_cvt_pk_f32_fp8((int)ww[i], false), hi = __builtin_amdgcn_cvt_pk_f32_fp8((int)ww[i], true);
                    acc[i * 4] += lo.x; acc[i * 4 + 1] += lo.y; acc[i * 4 + 2] += hi.x; acc[i * 4 + 3] += hi.y; }
            }
            float ss = 0.f;
#pragma unroll
            for (int i = 0; i < 16; ++i) { acc[i] *= (1.f / YSCALE); ss += acc[i] * acc[i]; }
            const float rstd = rsqrtf(wave_sum(ss) * (1.f / DM) + EPS);
#pragma unroll
            for (int i = 0; i < 4; ++i) { const int c0 = lane * 16 + i * 4; f32x4 o;
#pragma unroll
                for (int j = 0; j < 4; ++j) { const int q = i * 4 + j; const float x1 = (float)(q < 8 ? xa[u][q & 7] : xb[u][q & 7]); o[j] = x1 + A2[q] * (acc[q] * rstd); }
                *(f32x4*)(dst + t * DM + c0) = o; }
        }
      }
    }
}

#define XB_TMO      128
#define XB_XCNT(j)  (256  + 64 * (j))
#define XB_XSUB(j)  (1280 + 64 * (j))
#define XB_XGEN(j)  (2304 + 64 * (j))
#define XB_TOP      3328
#define XB_TOPGEN   3392
#define XCD_BAR_WORDS 3456
#define XB_SPIN_CAP (1u << 20)
DEV unsigned xb_ld(unsigned* p)              { return __hip_atomic_load(p, __ATOMIC_RELAXED, __HIP_MEMORY_SCOPE_AGENT); }
DEV unsigned xb_add(unsigned* p, unsigned v) { return __hip_atomic_fetch_add(p, v, __ATOMIC_RELAXED, __HIP_MEMORY_SCOPE_AGENT); }
DEV unsigned xb_xcc_id() { return (unsigned)__builtin_amdgcn_s_getreg((3 << 11) | 20) & 0xFu; }
#define XB_SPIN(cond, bar) do { unsigned _sp = 0; while (cond) { __builtin_amdgcn_s_sleep(1); \
    if ((++_sp & 255u) == 0u) { if (xb_ld(&(bar)[XB_TMO])) break; if (_sp > XB_SPIN_CAP) { atomicAdd(&(bar)[XB_TMO], 1u); break; } } } } while (0)
struct XcdBarrier { unsigned* bar; unsigned x; volatile LAS unsigned* st; };
DEV XcdBarrier xcd_barrier_post(unsigned* bar, volatile LAS unsigned* st) {
    XcdBarrier b; b.bar = bar; b.x = xb_xcc_id(); b.st = st;
    if (threadIdx.x == 0) (void)xb_add(&bar[XB_XCNT(b.x)], 1u);
    return b;
}
DEV void xcd_barrier_complete(unsigned* bar, unsigned x, unsigned& nloc, unsigned& nx) {
    const unsigned G = gridDim.x * gridDim.y * gridDim.z;
    unsigned sum, cnt, mine, sp = 0u;
    for (;;) {
        sum = 0u; cnt = 0u; mine = 0u;
#pragma unroll
        for (unsigned j = 0; j < 16; ++j) { const unsigned c = xb_ld(&bar[XB_XCNT(j)]); sum += c; cnt += (c > 0u) ? 1u : 0u; mine = (j == x) ? c : mine; }
        if (sum == G) break;
        __builtin_amdgcn_s_sleep(1);
        if ((++sp & 255u) == 0u) { if (xb_ld(&bar[XB_TMO])) break; if (sp > XB_SPIN_CAP) { atomicAdd(&bar[XB_TMO], 1u); break; } }
    }
    nloc = mine > 0u ? mine : 1u; nx = cnt > 0u ? cnt : 1u;
}
DEV void xcd_barrier(const XcdBarrier& b) {
    asm volatile("s_waitcnt vmcnt(0)" ::: "memory");
    __syncthreads();
    if (threadIdx.x == 0) {
        unsigned* bar = b.bar;
        __builtin_amdgcn_s_waitcnt(0);
        unsigned nloc = b.st[0], nx = b.st[1];
        if (nloc == 0u) { xcd_barrier_complete(bar, b.x, nloc, nx); b.st[0] = nloc; b.st[1] = nx; }
        const unsigned old = xb_add(&bar[XB_XSUB(b.x)], 1u);
        const unsigned gen = old / nloc;
        if (old + 1u == (gen + 1u) * nloc) {
            __builtin_amdgcn_fence(__ATOMIC_RELEASE, "agent");
            asm volatile("s_waitcnt vmcnt(0)" ::: "memory");
            const unsigned og = xb_add(&bar[XB_TOP], 1u);
            const unsigned tg = og / nx;
            if (og + 1u == (tg + 1u) * nx) xb_add(&bar[XB_TOPGEN], 1u);
            else XB_SPIN(xb_ld(&bar[XB_TOPGEN]) == tg, bar);
            __builtin_amdgcn_fence(__ATOMIC_ACQUIRE, "agent");
            xb_add(&bar[XB_XGEN(b.x)], 1u);
            asm volatile("s_waitcnt vmcnt(0)" ::: "memory");
        } else {
            XB_SPIN(xb_ld(&bar[XB_XGEN(b.x)]) == gen, bar);
            __builtin_amdgcn_fence(__ATOMIC_ACQUIRE, "agent");
            asm volatile("s_waitcnt vmcnt(0)" ::: "memory");
        }
    }
    __syncthreads();
}

#ifndef PROBE_DUP
#define PROBE_DUP -1
#endif
constexpr int NPHASE = 11;
__global__ void __launch_bounds__(NTHR, 2) mega(Args a) {
    extern __shared__ __attribute__((aligned(16))) unsigned char lds[];
    cg::grid_group grid = cg::this_grid();
    Frame F;
    F.lds = lds; F.tid = threadIdx.x; F.lane = F.tid & 63; F.wave = __builtin_amdgcn_readfirstlane(F.tid >> 6); F.bid = blockIdx.x; F.G = gridDim.x;
    F.gw = F.bid * NWAVE + F.wave; F.NGW = F.G * NWAVE; F.in = a.in; F.out = a.out; F.ws = a.ws;
    const int lo = a.ph_lo, hi = a.ph_hi;
#ifndef ONLY_PHASE
#define ONLY_PHASE -1
#endif
#define IN(k) (lo <= (k) && (k) < hi && (ONLY_PHASE < 0 || (k) == ONLY_PHASE))
    volatile LAS unsigned* xst = (volatile LAS unsigned*)((LAS unsigned char*)lds + LDS_BYTES - 128);
    if (F.tid < 2) xst[F.tid] = 0u;
    __syncthreads();
    const XcdBarrier xbar = xcd_barrier_post((unsigned*)(a.ws + WS_BAR), xst);
#define SEAM(k) do { if (IN(k) && IN((k) + 1)) { if (hi > 64) grid.sync(); else xcd_barrier(xbar); } } while (0)
#define RUN(k, ...) do { if (IN(k)) { __VA_ARGS__; if (PROBE_DUP == (k) && (k) != 10) { xcd_barrier(xbar); __VA_ARGS__; } } } while (0)
    const int vcu = (F.G % 8 == 0) ? (F.bid % 8) * (F.G / 8) + F.bid / 8 : F.bid;
    LAS unsigned char* lds3 = (LAS unsigned char*)lds;
    RUN(0, { ph_mod(F); ph_wconv(F); }); SEAM(0);
    RUN(1, ph_prenorm(F)); SEAM(1);
    RUN(2, { pg8::SchedInProj S{(const char*)WSP(f16, WS_HALL), (const char*)WSP(f16, WS_WIN), vcu, F.G};
        LAS float* tabs = (LAS float*)(lds3 + pg8::STAGE_BYTES + 4608);
        for (int i = F.tid; i < 2048; i += NTHR) tabs[i] = WSP(float, WS_ROPE)[i];
        if (F.tid < 64) { tabs[2048 + F.tid] = F.in[9][F.tid]; tabs[2112 + F.tid] = F.in[10][F.tid]; }
        __syncthreads();
        pg8::EpiInProj E{WSP(f16, WS_QKV), tabs + 2048, tabs + 2112, tabs};
        pg8::gemm_phase<pg8::EpiInProj, pg8::SchedInProj, false>(lds3, DM * 2, S, E, nullptr, nullptr, nullptr); }); SEAM(2);
    RUN(3, ph_attn(F, vcu)); if (IN(3) && IN(5)) xcd_barrier(xbar);
    RUN(5, { pg8::SchedDense S{(const char*)WSP(f16, WS_MIXED), (const char*)WSP(f16, WS_WOUT), vcu, F.G, (NT / 256) * 4, 4, DM};
        pg8::EpiPlain E{WSP(f16, WS_Y1), DM};
        pg8::gemm_phase<pg8::EpiPlain, pg8::SchedDense, false>(lds3, DM * 2, S, E, nullptr, nullptr, nullptr); }); SEAM(5);
    RUN(6, ph_rowpass(F)); SEAM(6);
    RUN(7, ph_dispatch(F)); SEAM(7);
    RUN(8, { const int nb = *(WSP(int, WS_CTL) + 64);
        pg8::SchedGrouped S{nullptr, (const char*)(F.ws + WS_WGU), WSP(int, WS_BLKE), vcu, F.G, nb * 2, 2, DM / 2, (size_t)512 * DM, 1};
        pg8::EpiGU E{F.ws + WS_H, WSP(float, WS_WSL)};
        pg8::gemm_phase<pg8::EpiGU, pg8::SchedGrouped, true, true>(lds3, DM, S, E, WSP(int, WS_TOK), (const char*)(F.ws + WS_H2), WSP(unsigned, WS_WSL), 0x79797979, 0x7F7F7F7F); }); SEAM(8);
    RUN(9, { const int nb = *(WSP(int, WS_CTL) + 64);
        pg8::SchedGrouped S{(const char*)(F.ws + WS_H), (const char*)(F.ws + WS_WD), WSP(int, WS_BLKE), vcu, F.G, nb * 4, 4, EH / 2, (size_t)DM * EH, 1};
        pg8::EpiDown E{F.ws + WS_YP, WSP(int, WS_PAIR)};
        pg8::gemm_phase<pg8::EpiDown, pg8::SchedGrouped, false, true, true>(lds3, EH, S, E, nullptr, nullptr, WSP(unsigned, WS_PAIR), 0x79797979, 0x80808080  ); }); SEAM(9);
    RUN(10, ph_combine(F, F.out));
}

extern "C" void kernel_launch(void* const* d_in, const int* in_sizes, int n_in, void* d_out, int out_size, void* d_ws, size_t ws_size, hipStream_t stream) {
    (void)in_sizes; (void)out_size;
    static int grid = 0;
    if (grid == 0) {
        if (n_in != 27 || ws_size < WS_END) { fprintf(stderr, "kernel_launch: unexpected n_in %d / ws_size %zu (need %zu)\n", n_in, ws_size, (size_t)WS_END); grid = -1; return; }
        int dev = 0, cus = 0, per_cu = 0;
        (void)hipGetDevice(&dev); (void)hipDeviceGetAttribute(&cus, hipDeviceAttributeMultiprocessorCount, dev);
        if (hipFuncSetAttribute((const void*)mega, hipFuncAttributeMaxDynamicSharedMemorySize, LDS_BYTES) != hipSuccess) { fprintf(stderr, "kernel_launch: hipFuncSetAttribute failed\n"); grid = -1; return; }
        if (hipOccupancyMaxActiveBlocksPerMultiprocessor(&per_cu, (const void*)mega, NTHR, LDS_BYTES) != hipSuccess || per_cu < 1) { fprintf(stderr, "kernel_launch: occupancy query failed (%d)\n", per_cu); (void)hipGetLastError(); per_cu = 1; }
        grid = cus * (per_cu > 1 ? 1 : per_cu);
        if (grid <= 0) grid = 256;
    }
    if (grid < 0) return;
    (void)hipMemsetAsync((unsigned char*)d_ws + WS_CTL, 0, 64 * 1024, stream);
    Args a{};
    for (int i = 0; i < 27; ++i) a.in[i] = (const float*)d_in[i];
    a.out = (float*)d_out; a.ws = (unsigned char*)d_ws; a.ph_lo = 0; a.ph_hi = NPHASE;
    void* args[] = {&a};
    hipError_t e = hipLaunchCooperativeKernel((const void*)mega, dim3(grid), dim3(NTHR), args, LDS_BYTES, stream);
    if (e != hipSuccess) fprintf(stderr, "kernel_launch: cooperative launch failed: %s (grid %d)\n", hipGetErrorString(e), grid);
}
```

```cpp
#include <hip/hip_runtime.h>
#include <hip/hip_cooperative_groups.h>
#include <stdint.h>
#include <math.h>
#include <cstdio>
namespace cg = cooperative_groups;

typedef _Float16 f16;
typedef _Float16 f16x8 __attribute__((ext_vector_type(8)));
typedef _Float16 f16x4 __attribute__((ext_vector_type(4)));
typedef float f32x4 __attribute__((ext_vector_type(4)));
typedef float f32x2 __attribute__((ext_vector_type(2)));
#define DEV __device__ __forceinline__
#define LAS __attribute__((address_space(3)))

constexpr int NB = 32, SEQ = 2048, DM = 1024, NT = NB * SEQ, CL = 256, RB = SEQ + CL, RALL = NB * RB;
constexpr int NIN = 2304, NMOD = 6144, NE = 64, EH = 256, TOPK = 8, NSLOTK = 9;
constexpr int SH_BLKS = NT / 256;
constexpr int MAX_BLKS = SH_BLKS + (NT * TOPK) / 256 + NE;
constexpr int MAX_SLOTS = MAX_BLKS * 256;
constexpr float EPS = 1e-6f;
constexpr float QSCALE = 0.125f * 1.4426950408889634f;
constexpr float YSCALE = 8.0f;
constexpr int NTHR = 512, NWAVE = 8;
constexpr int LDS_BYTES = 147456;

constexpr size_t MiB = 1ull << 20;
constexpr size_t WS_CTL = 0;
constexpr size_t WS_CNT = 32768;
constexpr size_t WS_BAR = 4096;
constexpr size_t WS_MOD = 64 * 1024;
constexpr size_t WS_ROPE = 1 * MiB;
constexpr size_t WS_MISC = 1 * MiB + 64 * 1024;
constexpr size_t WS_BLKE = 1 * MiB + 128 * 1024;
constexpr size_t WS_WIN = 4 * MiB;
constexpr size_t WS_WOUT = WS_WIN + (size_t)NIN * DM * 2;
constexpr size_t WS_WGU = WS_WOUT + (size_t)DM * DM * 2;
constexpr size_t WS_WD = WS_WGU + (size_t)65 * 512 * DM * 2;
constexpr size_t WS_WEND = WS_WD + (size_t)65 * DM * EH * 2;
static_assert(WS_WEND <= 108 * MiB, "weights");
constexpr size_t WS_HALL = 108 * MiB;
constexpr size_t WS_MIXED = 108 * MiB;
constexpr size_t WS_QKV = 252 * MiB;
constexpr size_t WS_SDIFF = 576 * MiB;
constexpr size_t WS_Y1 = 704 * MiB;
constexpr size_t WS_H = 108 * MiB;
constexpr size_t WS_YP = 404 * MiB;
constexpr size_t WS_H2 = 404 * MiB;
constexpr size_t WS_TAB = 980 * MiB;
constexpr size_t WS_IDX = WS_TAB;
constexpr size_t WS_RANK = WS_IDX + (size_t)NT * 8 * 4;
constexpr size_t WS_GW = WS_RANK + (size_t)NT * 8 * 4;
constexpr size_t WS_TOK = WS_GW + (size_t)NT * 8 * 4;
constexpr size_t WS_PAIR = WS_TOK + (size_t)MAX_SLOTS * 4;
constexpr size_t WS_WSL = WS_PAIR + (size_t)MAX_SLOTS * 4;
constexpr size_t WS_WGB = WS_WSL + (size_t)MAX_SLOTS * 4;
constexpr size_t WS_END = WS_WGB + (size_t)1024 * 64 * 4;
static_assert(WS_END <= 1024 * MiB, "ws");

DEV float wave_sum(float v) {
#pragma unroll
    for (int o = 32; o > 0; o >>= 1) v += __shfl_xor(v, o);
    return v;
}
DEV float silu(float v) { return v / (1.f + __expf(-v)); }
DEV float silu_f(float v) { return v * __builtin_amdgcn_rcpf(1.f + __builtin_amdgcn_exp2f(v * -1.44269504f)); }
DEV float c8(float v) { return __builtin_amdgcn_fmed3f(v, -448.f, 448.f); }
DEV unsigned char f2fp8(float v) { const int r = __builtin_amdgcn_cvt_pk_fp8_f32(v, v, 0, false); return (unsigned char)(r & 0xff); }

struct Args { const float* in[27]; float* out; unsigned char* ws; int ph_lo, ph_hi; };
struct Frame {
    unsigned char* lds; int tid, lane, wave, bid, G, gw, NGW;
    const float* const* in; float* out; unsigned char* ws;
};
#define WSP(T, off) ((T*)(F.ws + (off)))

DEV void ph_mod(const Frame& F) {
    const float* c = F.in[1]; const float* c_ctx = F.in[3]; const float* w_mod = F.in[4]; const float* b_mod = F.in[5];
    float* mod = WSP(float, WS_MOD);
    if (F.bid == 0) {
        if (F.tid < 64) { float a = F.in[11][F.tid] * F.in[12][F.tid], b = F.in[13][F.tid] * F.in[14][F.tid]; a = wave_sum(a); b = wave_sum(b); if (F.tid == 0) WSP(float, WS_MISC)[0] = expf(a) - expf(b) + 0.2f; }
        float* rope = WSP(float, WS_ROPE);
        for (int i = F.tid; i < 64 * 16; i += NTHR) { const int pos = i >> 4, j = i & 15; const float ang = (float)pos * powf(10000.0f, -(float)j / 16.0f); rope[i * 2] = cosf(ang); rope[i * 2 + 1] = sinf(ang); }
    }
    constexpr int MC = 24;
    if (F.bid >= NMOD / MC) return;
    float* sc = (float*)F.lds;
    const int c0 = F.bid * MC, kh = F.lane / MC, col = F.lane - kh * MC;
    const float* wp = w_mod + (size_t)(F.wave * 128 + kh) * NMOD + c0 + col;
    float wa[8], wb[8];
#define MOD_LOAD(W, IT0) do { if (kh < 2) { _Pragma("unroll") for (int u = 0; u < 8; ++u) W[u] = wp[(size_t)((IT0) + u) * 2 * NMOD]; } } while (0)
#define MOD_FMA(W, IT0) do { if (kh < 2) { _Pragma("unroll") for (int u = 0; u < 8; ++u) { const int k = F.wave * 128 + ((IT0) + u) * 2 + kh; _Pragma("unroll") for (int r = 0; r < 33; ++r) acc[r] += sc[r * DM + k] * W[u]; } } } while (0)
    MOD_LOAD(wa, 0);
    for (int i = F.tid; i < 33 * DM; i += NTHR) { const int r = i >> 10, k = i & 1023; sc[i] = silu_f(r < 32 ? c[r * DM + k] : c_ctx[k]); }
    __syncthreads();
    float acc[33];
#pragma unroll
    for (int r = 0; r < 33; ++r) acc[r] = 0.f;
#pragma unroll 1
    for (int it0 = 0; it0 < 64; it0 += 16) {
        MOD_LOAD(wb, it0 + 8); MOD_FMA(wa, it0);
        if (it0 + 16 < 64) MOD_LOAD(wa, it0 + 16);
        MOD_FMA(wb, it0 + 8);
    }
#undef MOD_LOAD
#undef MOD_FMA
#pragma unroll
    for (int r = 0; r < 33; ++r) acc[r] += __shfl_down(acc[r], MC);
    __syncthreads();
    float* red = (float*)F.lds;
    if (F.lane < MC) {
#pragma unroll
        for (int r = 0; r < 33; ++r) red[(F.wave * 33 + r) * MC + col] = acc[r];
    }
    __syncthreads();
    for (int i = F.tid; i < 33 * MC; i += NTHR) { const int r = i / MC, cc = i - r * MC; float s = b_mod[c0 + cc];
#pragma unroll
        for (int w = 0; w < 8; ++w) s += red[(w * 33 + r) * MC + cc];
        mod[(size_t)r * NMOD + c0 + cc] = s; }
    __syncthreads();
}

struct WItem { const float* W; unsigned char* WT; int K, N, rowmode, f8, item; };
DEV void wconv_load(const WItem& d, int lane, f32x4 (&t)[8]) {
    const int nblk = d.N / 32, kb = d.item / nblk, nb = d.item % nblk, k0 = 64 * kb, n0 = 32 * nb;
#pragma unroll
    for (int i = 0; i < 8; ++i) t[i] = *(const f32x4*)(d.W + (size_t)(k0 + i * 8 + (lane >> 3)) * d.N + n0 + (lane & 7) * 4);
}
DEV void wconv_put(const WItem& d, int lane, const f32x4 (&t)[8], float* scr) {
    const int K = d.K, nblk = d.N / 32, kb = d.item / nblk, nb = d.item % nblk, k0 = 64 * kb, n0 = 32 * nb;
#pragma unroll
    for (int i = 0; i < 8; ++i) { float* q = scr + (i * 8 + (lane >> 3)) * 33 + (lane & 7) * 4; q[0] = t[i].x; q[1] = t[i].y; q[2] = t[i].z; q[3] = t[i].w; }
    __builtin_amdgcn_s_waitcnt(0xC07F); asm volatile("" ::: "memory");
    const int c = lane & 7;
#pragma unroll
    for (int j = 0; j < 4; ++j) {
        const int n = (lane >> 3) + 8 * j; const float* sp = scr + (8 * c) * 33 + n;
        const int nn = n0 + n;
        int row;
        if (d.rowmode == 0) row = nn;
        else if (d.rowmode == 3) { const int cc = nn & 255; row = (nn & ~255) + ((cc >> 5) & 1) * 128 + (cc >> 6) * 32 + (cc & 31); }
        else row = (nn >> 7) * 256 + (nn & 127) + (d.rowmode == 2 ? 128 : 0);
        if (d.f8) {
            int lo = __builtin_amdgcn_cvt_pk_fp8_f32(c8(sp[0] * 64.f), c8(sp[33] * 64.f), 0, false); lo = __builtin_amdgcn_cvt_pk_fp8_f32(c8(sp[66] * 64.f), c8(sp[99] * 64.f), lo, true);
            int hi = __builtin_amdgcn_cvt_pk_fp8_f32(c8(sp[132] * 64.f), c8(sp[165] * 64.f), 0, false); hi = __builtin_amdgcn_cvt_pk_fp8_f32(c8(sp[198] * 64.f), c8(sp[231] * 64.f), hi, true);
            *(uint2*)(d.WT + (size_t)row * K + k0 + 8 * c) = make_uint2((unsigned)lo, (unsigned)hi);
        } else {
            f16x8 o;
#pragma unroll
            for (int q = 0; q < 8; ++q) o[q] = (f16)sp[q * 33];
            *(f16x8*)(d.WT + ((size_t)row * K + k0 + 8 * c) * 2) = o;
        }
    }
    __builtin_amdgcn_s_waitcnt(0xC07F); asm volatile("" ::: "memory");
}
DEV void ph_wconv(const Frame& F) {
    float* scr = (float*)(F.lds + F.wave * 16384);
    constexpr int I_IN = (DM / 64) * (NIN / 32), I_OUT = (DM / 64) * (DM / 32), I_E = (DM / 64) * (EH / 32);
    constexpr int NITEMS = I_IN + I_OUT + 65 * 3 * I_E;
    auto decode = [&](int it, WItem& d) {
        int r = it;
        if (r < I_IN) { d = WItem{F.in[8], F.ws + WS_WIN, DM, NIN, 3, 0, r}; return; } r -= I_IN;
        if (r < I_OUT) { d = WItem{F.in[16], F.ws + WS_WOUT, DM, DM, 0, 0, r}; return; } r -= I_OUT;
        const int e = r / (3 * I_E), q = (r % (3 * I_E)) / I_E, ii = r % I_E;
        if (q == 0) d = WItem{e < 64 ? F.in[21] + (size_t)e * DM * EH : F.in[24], F.ws + WS_WGU + (size_t)e * 512 * DM, DM, EH, 1, 1, ii};
        else if (q == 1) d = WItem{e < 64 ? F.in[22] + (size_t)e * DM * EH : F.in[25], F.ws + WS_WGU + (size_t)e * 512 * DM, DM, EH, 2, 1, ii};
        else d = WItem{e < 64 ? F.in[23] + (size_t)e * DM * EH : F.in[26], F.ws + WS_WD + (size_t)e * DM * EH, EH, DM, 3, 1, ii};
    };
    int it = F.gw; if (it >= NITEMS) return;
    WItem cur, nxt; f32x4 ta[8], tb[8];
    decode(it, cur); wconv_load(cur, F.lane, ta);
#pragma unroll 1
    for (;;) {
        const int i1 = it + F.NGW; const bool h1 = i1 < NITEMS;
        if (h1) { decode(i1, nxt); wconv_load(nxt, F.lane, tb); }
        wconv_put(cur, F.lane, ta, scr);
        if (!h1) break;
        const int i2 = i1 + F.NGW; const bool h2 = i2 < NITEMS;
        if (h2) { decode(i2, cur); wconv_load(cur, F.lane, ta); }
        wconv_put(nxt, F.lane, tb, scr);
        if (!h2) break;
        it = i2;
    }
}

DEV void ph_prenorm(const Frame& F) {
    const float* x = F.in[0]; const float* ctx = F.in[2]; const float* g = F.in[6]; const float* mod = WSP(float, WS_MOD); f16* hall = WSP(f16, WS_HALL);
    const int lane = F.lane;
    constexpr int PBLK = 288; static_assert(RB % PBLK == 0 && RALL % PBLK == 0 && PBLK % 48 == 0, "prenorm block");
    f32x4 gg[4];
#pragma unroll
    for (int j = 0; j < 4; ++j) gg[j] = *(const f32x4*)(g + j * 256 + lane * 4);
    for (int blk = F.bid; blk < RALL / PBLK; blk += F.G) {
        int curm = -1; f32x4 G2[4], SH[4];
#pragma unroll 1
        for (int i = F.wave * 6; i < PBLK; i += 48) {
            const int row0 = blk * PBLK + i;
            f32x4 v[6][4]; int mr[6];
#pragma unroll
            for (int u = 0; u < 6; ++u) { const int row = row0 + u; const int b = row / RB, p = row % RB;
                const float* src = p < CL ? ctx + ((size_t)b * CL + p) * DM : x + ((size_t)b * SEQ + (p - CL)) * DM;
                mr[u] = p < CL ? 32 : b;
#pragma unroll
                for (int j = 0; j < 4; ++j) v[u][j] = *(const f32x4*)(src + j * 256 + lane * 4); }
#pragma unroll
            for (int u = 0; u < 6; ++u) {
                if (mr[u] != curm) { curm = mr[u]; const float* mp = mod + (size_t)curm * NMOD;
#pragma unroll
                    for (int j = 0; j < 4; ++j) { const int c0 = j * 256 + lane * 4; const f32x4 sc = *(const f32x4*)(mp + 1024 + c0); SH[j] = *(const f32x4*)(mp + c0); G2[j] = gg[j] * (sc + 1.f); } }
                float ss = 0.f;
#pragma unroll
                for (int j = 0; j < 4; ++j) ss += v[u][j].x * v[u][j].x + v[u][j].y * v[u][j].y + v[u][j].z * v[u][j].z + v[u][j].w * v[u][j].w;
                const float rstd = rsqrtf(wave_sum(ss) * (1.f / DM) + EPS);
#pragma unroll
                for (int j = 0; j < 4; ++j) {
                    const int c0 = j * 256 + lane * 4;
                    f16x4 o;
                    o.x = (f16)(v[u][j].x * rstd * G2[j].x + SH[j].x); o.y = (f16)(v[u][j].y * rstd * G2[j].y + SH[j].y);
                    o.z = (f16)(v[u][j].z * rstd * G2[j].z + SH[j].z); o.w = (f16)(v[u][j].w * rstd * G2[j].w + SH[j].w);
                    *(f16x4*)(hall + (size_t)(row0 + u) * DM + c0) = o;
                }
            }
        }
    }
}


namespace pg8 {
typedef int v8i __attribute__((ext_vector_type(8)));
typedef unsigned u32x4v __attribute__((ext_vector_type(4)));
constexpr int BM = 256, BK = 64, HALF = 128, HTB = HALF * BK * 2  , STAGE_BYTES = 8 * HTB;
DEV int lds_byte(int r, int c) { const int st = (r >> 4) * 2 + (c >> 5), rr = r & 15, cc = c & 31, ob = rr * 64 + cc * 2; return st * 1024 + (ob ^ (((ob >> 9) & 1) << 5)); }
DEV void stage_rc(int b, int& R, int& C) { const int st = b / 1024, sb = b % 1024, swz = sb ^ (((sb >> 9) & 1) << 5); R = (st >> 1) * 16 + swz / 64; C = (st & 1) * 32 + (swz % 64) / 2; }
struct GUnit { const char* A; const char* B; int pm, pn, aux; };
DEV void glds16s(const char* sbase, unsigned voff, unsigned lds_dst) { unsigned keep;
    asm volatile("s_mov_b32 %0, m0\n\ts_mov_b32 m0, %3\n\ts_nop 0\n\tglobal_load_lds_dwordx4 %1, %2\n\ts_mov_b32 m0, %0" : "=&s"(keep) : "v"(voff), "s"(sbase), "s"(lds_dst) : "memory"); }
DEV void stage2(LAS unsigned char* lds, unsigned bufoff, const char* base, unsigned o0, unsigned o1) {
    const unsigned d = (unsigned)__builtin_amdgcn_readfirstlane((int)((unsigned)(uintptr_t)lds + bufoff));
    glds16s(base, o0, d); glds16s(base, o1, d + 8192u);
}
template <class Epi, class Sched, bool GATHER, bool FP8 = false, bool ARES = false>
DEV void gemm_phase(LAS unsigned char* lds, const int PB, const Sched& S, const Epi& E, const int* tok, const char* Ag, const unsigned* rowarg, const int scaleW = 0x7F7F7F7F, const int scaleA = 0x7F7F7F7F) {
    const int tid = threadIdx.x, wid = __builtin_amdgcn_readfirstlane(tid >> 6), lane = tid & 63, wr = wid >> 2, wc = wid & 3, fr = lane & 15, fq = lane >> 4;
    const int nt = PB / 128;
    unsigned voff[2]; int sR[2]; unsigned sC2[2];
#pragma unroll
    for (int i = 0; i < 2; ++i) { int R, C; stage_rc(tid * 16 + i * 8192, R, C); sR[i] = R; sC2[i] = (unsigned)C * 2u; voff[i] = (unsigned)(R * PB) + (unsigned)C * 2u; }
    const size_t kstep = (size_t)(BK * 2), hstep = (size_t)HALF * PB;
    const unsigned ldsw = (unsigned)wid * 1024u;
    const int aoff = FP8 ? lds_byte(wr * 64 + fr, fq * 16) : lds_byte(wr * 64 + fr, fq * 8), boff = FP8 ? lds_byte(wc * 32 + fr, fq * 16) : lds_byte(wc * 32 + fr, fq * 8);
#define PG8_SA(b, h) (((b) * 2 + (h)) * HTB)
#define PG8_SB(b, h) ((4 + (b) * 2 + (h)) * HTB)
#define PG8_STB(bufoff, gbase) stage2(lds, (bufoff) + ldsw, (gbase), voff[0], voff[1])
#define PG8_STA(bufoff, dbase, gko, g0, g1) do { if (GATHER) stage2(lds, (bufoff) + ldsw, Ag + (gko), (g0), (g1)); else stage2(lds, (bufoff) + ldsw, (dbase), voff[0], voff[1]); } while (0)
#define PG8_LDA(dst, b, h) do { if constexpr (FP8) { _Pragma("unroll") for (int m = 0; m < 4; ++m) { const u32x4v lo_ = *(const LAS u32x4v*)(lds + PG8_SA(b, h) + aoff + m * 2048), hi_ = *(const LAS u32x4v*)(lds + PG8_SA(b, h) + aoff + m * 2048 + 16); \
            dst##8[m] = (v8i){(int)lo_.x, (int)lo_.y, (int)lo_.z, (int)lo_.w, (int)hi_.x, (int)hi_.y, (int)hi_.z, (int)hi_.w}; } } \
        else { _Pragma("unroll") for (int m = 0; m < 4; ++m) _Pragma("unroll") for (int k = 0; k < 2; ++k) dst[m][k] = *(const LAS f16x8*)(lds + PG8_SA(b, h) + aoff + m * 2048 + k * 1024); } } while (0)
#define PG8_LDB(dst, b, h) do { if constexpr (FP8) { _Pragma("unroll") for (int n = 0; n < 2; ++n) { const u32x4v lo_ = *(const LAS u32x4v*)(lds + PG8_SB(b, h) + boff + n * 2048), hi_ = *(const LAS u32x4v*)(lds + PG8_SB(b, h) + boff + n * 2048 + 16); \
            dst##8[n] = (v8i){(int)lo_.x, (int)lo_.y, (int)lo_.z, (int)lo_.w, (int)hi_.x, (int)hi_.y, (int)hi_.z, (int)hi_.w}; } } \
        else { _Pragma("unroll") for (int n = 0; n < 2; ++n) _Pragma("unroll") for (int k = 0; k < 2; ++k) dst[n][k] = *(const LAS f16x8*)(lds + PG8_SB(b, h) + boff + n * 2048 + k * 1024); } } while (0)
#define PG8_MMA(ai, bj, At, Bt, Z) do { __builtin_amdgcn_s_setprio(1); if constexpr (FP8) { _Pragma("unroll") for (int m = 0; m < 4; ++m) _Pragma("unroll") for (int n = 0; n < 2; ++n) { \
            if (Z) asm volatile("v_mfma_scale_f32_16x16x128_f8f6f4 %0, %1, %2, 0, %3, %4 op_sel_hi:[0,0,0]" : "=&v"(acc[ai][bj][m][n]) : "v"(Bt##8[n]), "v"(At##8[m]), "v"(scaleW), "v"(scaleA)); \
            else asm volatile("v_mfma_scale_f32_16x16x128_f8f6f4 %0, %1, %2, %0, %3, %4 op_sel_hi:[0,0,0]" : "+v"(acc[ai][bj][m][n]) : "v"(Bt##8[n]), "v"(At##8[m]), "v"(scaleW), "v"(scaleA)); } } \
        else { _Pragma("unroll") for (int m = 0; m < 4; ++m) _Pragma("unroll") for (int n = 0; n < 2; ++n) { \
            acc[ai][bj][m][n] = __builtin_amdgcn_mfma_f32_16x16x32_f16(Bt[n][0], At[m][0], (Z) ? (f32x4){0.f, 0.f, 0.f, 0.f} : acc[ai][bj][m][n], 0, 0, 0); \
            acc[ai][bj][m][n] = __builtin_amdgcn_mfma_f32_16x16x32_f16(Bt[n][1], At[m][1], acc[ai][bj][m][n], 0, 0, 0); } } __builtin_amdgcn_s_setprio(0); } while (0)
#define PG8_WAIT_V(n) asm volatile("s_waitcnt vmcnt(" #n ")" ::: "memory")
#define PG8_WAIT_L(n) asm volatile("s_waitcnt lgkmcnt(" #n ")" ::: "memory")
#define PG8_BAR __builtin_amdgcn_s_barrier()
#define PG8_SCHED __builtin_amdgcn_sched_barrier(0)
    LAS unsigned* const sideR = (LAS unsigned*)(lds + STAGE_BYTES), * const sideE = (LAS unsigned*)(lds + STAGE_BYTES + 2048), * const sideT = (LAS unsigned*)(lds + STAGE_BYTES + 2560);
    GUnit cur, nxt, nn; int ui = 0; bool sc = false;
    if (!S.next(0, cur)) return;
    if constexpr (Sched::HAS_E) cur.B = S.bptr(cur, __builtin_amdgcn_readfirstlane(*S.eptr(cur)));
    unsigned cg0[2] = {0, 0}, cg1[2] = {0, 0}, ng0[2] = {0, 0}, ng1[2] = {0, 0};
    if (GATHER) {
#pragma unroll
        for (int i = 0; i < 2; ++i) { cg0[i] = (unsigned)tok[cur.pm * 256 + sR[i]] * (unsigned)PB + sC2[i]; cg1[i] = (unsigned)tok[cur.pm * 256 + 128 + sR[i]] * (unsigned)PB + sC2[i]; }
    }
#define PG8_SIDE_NEXT(u_, slot_) do { \
        if (Sched::HAS_E && wid == 4) __builtin_amdgcn_global_load_lds((const unsigned*)S.eptr(u_), sideE + (slot_) * 64, 4, 0, 0); \
        if (GATHER && wid >= 4) __builtin_amdgcn_global_load_lds((const unsigned*)tok + (u_).pm * 256 + (wid - 4) * 64 + lane, sideT + (slot_) * 256 + (wid - 4) * 64, 4, 0, 0); } while (0)
    if ((Sched::HAS_E || GATHER) && S.next(1, nxt)) PG8_SIDE_NEXT(nxt, 1);
    f32x4 acc[2][2][4][2];
    f16x8 At[4][2], B0[2][2], B1[2][2]; v8i At8[4], B08[2], B18[2];
    const char* cA = cur.A; const char* cB = cur.B;
    PG8_STB(PG8_SB(0, 0), cB); PG8_STB(PG8_SB(0, 1), cB + hstep); PG8_STA(PG8_SA(0, 0), cA, 0, cg0[0], cg0[1]); PG8_STA(PG8_SA(0, 1), cA + hstep, 0, cg1[0], cg1[1]);
    if (wr == 1) PG8_BAR;
    PG8_WAIT_V(2); PG8_BAR;
    PG8_STB(PG8_SB(1, 0), cB + kstep); PG8_STA(PG8_SA(1, 0), cA + kstep, kstep, cg0[0], cg0[1]); PG8_STB(PG8_SB(1, 1), cB + hstep + kstep);
    PG8_WAIT_V(0); PG8_BAR;
    for (;;) {
        const bool has_next = S.next(ui + 1, nxt);
        if (has_next) {
            if constexpr (Sched::HAS_E) nxt.B = S.bptr(nxt, __builtin_amdgcn_readfirstlane((int)sideE[((ui + 1) & 1) * 64]));
            if (GATHER) {
#pragma unroll
                for (int i = 0; i < 2; ++i) { ng0[i] = sideT[((ui + 1) & 1) * 256 + sR[i]] * (unsigned)PB + sC2[i]; ng1[i] = sideT[((ui + 1) & 1) * 256 + 128 + sR[i]] * (unsigned)PB + sC2[i]; }
            }
        } else { ng0[0] = cg0[0]; ng0[1] = cg0[1]; ng1[0] = cg1[0]; ng1[1] = cg1[1]; }
        if (rowarg != nullptr && wid < 4) __builtin_amdgcn_global_load_lds(rowarg + cur.pm * 256 + wid * 64 + lane, sideR + (ui & 1) * 256 + wid * 64, 4, 0, 0);
        if ((Sched::HAS_E || GATHER) && has_next && S.next(ui + 2, nn)) PG8_SIDE_NEXT(nn, ui & 1);
        const char* nA = has_next ? nxt.A : cA; const char* nB = has_next ? nxt.B : cB;
        const bool sn = ARES && has_next && nxt.pm == cur.pm;
#define PG8_ITER(FIRST) do { \
            const bool last = (t == nt - 2); \
            const size_t ko1 = (size_t)(t + 1) * kstep, ko2 = last ? 0 : (size_t)(t + 2) * kstep, ko3 = ko2 + kstep; \
            const char* a1 = cA + ko1; \
            const char* a2 = (last ? nA : cA) + ko2; const char* b2 = (last ? nB : cB) + ko2; \
            const char* a3 = a2 + kstep; const char* b3 = b2 + kstep; \
            const unsigned g20 = last ? ng0[0] : cg0[0], g21 = last ? ng0[1] : cg0[1], h20 = last ? ng1[0] : cg1[0], h21 = last ? ng1[1] : cg1[1]; \
              \
            PG8_LDB(B0, 0, 0); PG8_LDB(B1, 0, 1); PG8_SCHED; PG8_LDA(At, 0, 0); if (!(ARES && sc)) PG8_STA(PG8_SA(1, 1), a1 + hstep, ko1, cg1[0], cg1[1]); \
            if (!(FIRST)) PG8_WAIT_V(8); PG8_WAIT_L(0); PG8_BAR; PG8_MMA(0, 0, At, B0, FIRST); PG8_MMA(0, 1, At, B1, FIRST); PG8_BAR; PG8_SCHED; \
              \
            PG8_LDA(At, 0, 1); PG8_STB(PG8_SB(0, 0), b2); PG8_STB(PG8_SB(0, 1), b2 + hstep); if (!(ARES && sn)) PG8_STA(PG8_SA(0, 0), a2, ko2, g20, g21); \
            if (!(FIRST)) PG8_WAIT_V(8); PG8_WAIT_L(0); PG8_BAR; PG8_MMA(1, 0, At, B0, FIRST); PG8_MMA(1, 1, At, B1, FIRST); PG8_BAR; PG8_SCHED; \
              \
            PG8_LDB(B0, 1, 0); PG8_LDB(B1, 1, 1); PG8_SCHED; PG8_LDA(At, 1, 0); if (!(ARES && sn)) PG8_STA(PG8_SA(0, 1), a2 + hstep, ko2, h20, h21); \
            if (ARES && sn) PG8_WAIT_V(4); else PG8_WAIT_V(8); PG8_WAIT_L(0); PG8_BAR; PG8_MMA(0, 0, At, B0, 0); PG8_MMA(0, 1, At, B1, 0); PG8_BAR; PG8_SCHED; \
              \
            PG8_LDA(At, 1, 1); PG8_STB(PG8_SB(1, 0), b3); PG8_STB(PG8_SB(1, 1), b3 + hstep); if (!(ARES && sn)) PG8_STA(PG8_SA(1, 0), a3, ko3, g20, g21); \
            if (ARES && sn) PG8_WAIT_V(4); else PG8_WAIT_V(8); PG8_WAIT_L(0); PG8_BAR; PG8_MMA(1, 0, At, B0, 0); PG8_MMA(1, 1, At, B1, 0); PG8_BAR; PG8_SCHED; \
        } while (0)
        { const int t = 0; PG8_ITER(1); }
#pragma unroll 1
        for (int t = 2; t < nt; t += 2) PG8_ITER(0);
        if constexpr (FP8) {
#pragma unroll
            for (int a_ = 0; a_ < 2; ++a_)
#pragma unroll
                for (int b_ = 0; b_ < 2; ++b_)
                    asm volatile("s_nop 15\n\ts_nop 7" : "+v"(acc[a_][b_][0][0]), "+v"(acc[a_][b_][0][1]), "+v"(acc[a_][b_][1][0]), "+v"(acc[a_][b_][1][1]), "+v"(acc[a_][b_][2][0]), "+v"(acc[a_][b_][2][1]), "+v"(acc[a_][b_][3][0]), "+v"(acc[a_][b_][3][1]));
        }
        PG8_WAIT_V(0);
        if (wr == 0) PG8_BAR;
        { int fr_e = fr, fq_e = fq; asm volatile("" : "+v"(fr_e), "+v"(fq_e));
          E(acc, cur, wr, wc, fr_e, fq_e, (const LAS unsigned*)(sideR + (ui & 1) * 256)); }
        if (!has_next) break;
        cur = nxt; cA = nA; cB = nB; ++ui; sc = sn;
        cg0[0] = ng0[0]; cg0[1] = ng0[1]; cg1[0] = ng1[0]; cg1[1] = ng1[1];
        if (wr == 1) PG8_BAR;
    }
    PG8_WAIT_V(0);
    PG8_BAR;
#undef PG8_SA
#undef PG8_SB
#undef PG8_STB
#undef PG8_STA
#undef PG8_LDA
#undef PG8_LDB
#undef PG8_MMA
#undef PG8_ITER
#undef PG8_SIDE_NEXT
#undef PG8_WAIT_V
#undef PG8_WAIT_L
#undef PG8_BAR
#undef PG8_SCHED
}

DEV void swap16(unsigned& a, unsigned& b) { const auto r = __builtin_amdgcn_permlane16_swap(a, b, false, false); a = r[0]; b = r[1]; }
DEV void swap32(unsigned& a, unsigned& b) { const auto r = __builtin_amdgcn_permlane32_swap(a, b, false, false); a = r[0]; b = r[1]; }
typedef _Float16 f16x2v __attribute__((ext_vector_type(2)));
DEV unsigned pkh(float a, float b) { f16x2v t; t.x = (f16)a; t.y = (f16)b; return __builtin_bit_cast(unsigned, t); }
DEV unsigned pkb(float a, float b) { typedef __bf16 bfx2 __attribute__((ext_vector_type(2))); typedef float fx2 __attribute__((ext_vector_type(2))); const fx2 v = {a, b}; return __builtin_bit_cast(unsigned, __builtin_convertvector(v, bfx2)); }
DEV void store_pair16b(f16* rowbase, const f32x4 v0, const f32x4 v1, int fq) {
    unsigned al = pkb(v0.x, v0.y), ah = pkb(v0.z, v0.w), bl = pkb(v1.x, v1.y), bh = pkb(v1.z, v1.w);
    swap16(al, bl); swap16(ah, bh);
    const int co = (fq & 1) ? 16 + 4 * (fq - 1) : 4 * fq;
    *(uint4*)(rowbase + co) = make_uint4(al, ah, bl, bh);
}
DEV void store_pair16(f16* rowbase, const f32x4 v0, const f32x4 v1, int fq) {
    unsigned al = pkh(v0.x, v0.y), ah = pkh(v0.z, v0.w), bl = pkh(v1.x, v1.y), bh = pkh(v1.z, v1.w);
    swap16(al, bl); swap16(ah, bh);
    const int co = (fq & 1) ? 16 + 4 * (fq - 1) : 4 * fq;
    *(uint4*)(rowbase + co) = make_uint4(al, ah, bl, bh);
}
struct EpiPlain {
    f16* O; int ldc;
    DEV void operator()(const f32x4 (&acc)[2][2][4][2], const GUnit& u, int wr, int wc, int fr, int fq, const LAS unsigned* side) const {
#pragma unroll
        for (int ai = 0; ai < 2; ++ai)
#pragma unroll
            for (int m = 0; m < 4; ++m) { f16* rowp = O + (size_t)(u.pm * BM + ai * HALF + wr * 64 + m * 16 + fr) * ldc + u.pn * BM + wc * 32;
#pragma unroll
                for (int bj = 0; bj < 2; ++bj) store_pair16(rowp + bj * HALF, acc[ai][bj][m][0], acc[ai][bj][m][1], fq); }
    }
};
struct EpiInProj {
    f16* O; const LAS float* qg; const LAS float* kg; const LAS float* rope;
    DEV void operator()(f32x4 (&acc)[2][2][4][2], const GUnit& u, int wr, int wc, int fr, int fq, const LAS unsigned* side) const {
        const int pn = u.pn, seg = u.pm % 9; const bool latent = seg > 0;
        const bool isq = (pn < 2) || (pn == 6) || (pn == 7);
        const bool isk = (pn == 2) || (pn == 3) || (pn == 8 && wc < 2);
        const bool norm = (pn == 6) || (pn == 7) || (pn == 8 && wc < 2);
        const bool isv = (pn == 4) || (pn == 5) || (pn == 8 && wc >= 2);
        if (norm) {
            const LAS float* g = isq ? qg : kg;
            f32x4 gv[2][2];
#pragma unroll
            for (int bj = 0; bj < 2; ++bj)
#pragma unroll
                for (int n = 0; n < 2; ++n) gv[bj][n] = *(const LAS f32x4*)(g + 32 * bj + 16 * n + 4 * fq);
#pragma unroll
            for (int ai = 0; ai < 2; ++ai)
#pragma unroll
                for (int m = 0; m < 4; ++m) {
                    float ss = 0.f;
#pragma unroll
                    for (int bj = 0; bj < 2; ++bj)
#pragma unroll
                        for (int n = 0; n < 2; ++n) { const f32x4 v = acc[ai][bj][m][n]; ss += v.x * v.x + v.y * v.y + v.z * v.z + v.w * v.w; }
                    ss += __shfl_xor(ss, 16); ss += __shfl_xor(ss, 32);
                    const float rstd = rsqrtf(ss * (1.f / 64.f) + EPS);
#pragma unroll
                    for (int bj = 0; bj < 2; ++bj)
#pragma unroll
                        for (int n = 0; n < 2; ++n) acc[ai][bj][m][n] = acc[ai][bj][m][n] * rstd * gv[bj][n];
                }
        }
        if ((isq || isk) && latent) {
            const int s0 = (seg - 1) * 256;
#pragma unroll
            for (int ai = 0; ai < 2; ++ai) {
                const int prow = (s0 + ai * HALF + wr * 64) >> 6;
                const f32x4 r0 = *(const LAS f32x4*)(rope + (prow * 16 + 4 * fq) * 2), r1 = *(const LAS f32x4*)(rope + (prow * 16 + 4 * fq) * 2 + 4);
                const float rc[4] = {r0.x, r0.z, r1.x, r1.z}, rs[4] = {r0.y, r0.w, r1.y, r1.w};
#pragma unroll
                for (int m = 0; m < 4; ++m) {
                    const int pcol = m * 16 + fr;
                    const f32x4 c0 = *(const LAS f32x4*)(rope + (pcol * 16 + 4 * fq) * 2), c1 = *(const LAS f32x4*)(rope + (pcol * 16 + 4 * fq) * 2 + 4);
                    const float cc[4] = {c0.x, c0.z, c1.x, c1.z}, cs[4] = {c0.y, c0.w, c1.y, c1.w};
#pragma unroll
                    for (int q = 0; q < 4; ++q) {
                        const float a = acc[ai][0][m][0][q], b = acc[ai][0][m][1][q]; acc[ai][0][m][0][q] = a * rc[q] - b * rs[q]; acc[ai][0][m][1][q] = a * rs[q] + b * rc[q];
                        const float a2 = acc[ai][1][m][0][q], b2 = acc[ai][1][m][1][q]; acc[ai][1][m][0][q] = a2 * cc[q] - b2 * cs[q]; acc[ai][1][m][1][q] = a2 * cs[q] + b2 * cc[q];
                    }
                }
            }
        }
        const float sc = isq ? QSCALE : 1.f;
#pragma unroll
        for (int ai = 0; ai < 2; ++ai)
#pragma unroll
            for (int m = 0; m < 4; ++m) { f16* rowp = O + (size_t)(u.pm * BM + ai * HALF + wr * 64 + m * 16 + fr) * NIN + pn * BM + wc * 64;
#pragma unroll
                for (int bj = 0; bj < 2; ++bj) { if (isv) store_pair16b(rowp + bj * 32, acc[ai][bj][m][0], acc[ai][bj][m][1], fq); else store_pair16(rowp + bj * 32, acc[ai][bj][m][0] * sc, acc[ai][bj][m][1] * sc, fq); } }
    }
};
struct EpiGU {
    unsigned char* H; const float* wsl;
    DEV void operator()(const f32x4 (&acc)[2][2][4][2], const GUnit& u, int wr, int wc, int fr, int fq, const LAS unsigned* side) const {
#pragma unroll
        for (int ai = 0; ai < 2; ++ai)
#pragma unroll
            for (int m = 0; m < 4; ++m) { const int rl = ai * HALF + wr * 64 + m * 16 + fr, row = u.pm * BM + rl; const float w = __builtin_bit_cast(float, side[rl]) * 4.0f; unsigned char* rowp = H + (size_t)row * EH + u.pn * 128 + wc * 32;
                unsigned d[2];
#pragma unroll
                for (int n = 0; n < 2; ++n) { const f32x4 g = acc[ai][0][m][n], up = acc[ai][1][m][n];
                    int q = __builtin_amdgcn_cvt_pk_fp8_f32(c8(silu_f(g.x) * up.x * w), c8(silu_f(g.y) * up.y * w), 0, false); q = __builtin_amdgcn_cvt_pk_fp8_f32(c8(silu_f(g.z) * up.z * w), c8(silu_f(g.w) * up.w * w), q, true); d[n] = (unsigned)q; }
                swap16(d[0], d[1]);
                const int co = (fq & 1) ? 16 + 4 * (fq - 1) : 4 * fq;
                *(uint2*)(rowp + co) = make_uint2(d[0], d[1]); }
    }
};
struct EpiDown {
    unsigned char* Y; const int* pair;
    DEV void operator()(const f32x4 (&acc)[2][2][4][2], const GUnit& u, int wr, int wc, int fr, int fq, const LAS unsigned* side) const {
#pragma unroll
        for (int ai = 0; ai < 2; ++ai)
#pragma unroll
            for (int m = 0; m < 4; ++m) { const int pr = (int)side[ai * HALF + wr * 64 + m * 16 + fr];
                unsigned d[4];
#pragma unroll
                for (int bj = 0; bj < 2; ++bj)
#pragma unroll
                    for (int n = 0; n < 2; ++n) { const f32x4 v = acc[ai][bj][m][n]; int w = __builtin_amdgcn_cvt_pk_fp8_f32(c8(v.x), c8(v.y), 0, false); w = __builtin_amdgcn_cvt_pk_fp8_f32(c8(v.z), c8(v.w), w, true); d[bj * 2 + n] = (unsigned)w; }
                swap32(d[0], d[2]); swap32(d[1], d[3]); swap16(d[0], d[1]); swap16(d[2], d[3]);
                if (pr >= 0) *(uint4*)(Y + (size_t)pr * DM + u.pn * BM + wc * 64 + 16 * fq) = make_uint4(d[0], d[1], d[2], d[3]); }
    }
};
struct SchedInProj {
    const char* A; const char* B; int v, G;
    static constexpr bool HAS_E = false;
    DEV bool next(int i, GUnit& u) const {
        const int L = i * G + v; if (L >= 2304 + 160) return false;
        if (L < 2304) { const int pl = L / 9; u.pn = L % 9; u.pm = (pl >> 3) * 9 + 1 + (pl & 7); }
        else { const int Lc = L - 2304, q = Lc % 5; u.pm = (Lc / 5) * 9; u.pn = q < 4 ? 2 + q : 8; }
        u.A = A + (size_t)u.pm * 256 * DM * 2; u.B = B + (size_t)u.pn * 256 * DM * 2; u.aux = 0; return true;
    }
    DEV const int* eptr(const GUnit&) const { return nullptr; }
    DEV const char* bptr(const GUnit& u, int) const { return u.B; }
};
struct SchedDense {
    const char* A; const char* B; int v, G, nunits, ntn, K;
    static constexpr bool HAS_E = false;
    DEV bool next(int i, GUnit& u) const {
        const int L = i * G + v; if (L >= nunits) return false;
        u.pm = L / ntn; u.pn = L % ntn; u.A = A + (size_t)u.pm * 256 * K * 2; u.B = B + (size_t)u.pn * 256 * K * 2; u.aux = 0; return true;
    }
    DEV const int* eptr(const GUnit&) const { return nullptr; }
    DEV const char* bptr(const GUnit& u, int) const { return u.B; }
};
struct SchedGrouped {
    const char* A; const char* B; const int* blke; int v, G, nunits, ntn, K; size_t estride; int seq;
    static constexpr bool HAS_E = true;
    DEV bool next(int i, GUnit& u) const {
        if (seq) {
            const int nb = nunits / ntn, rf = nb / G, nf = rf * ntn;
            if (i < nf) { u.pm = (i / ntn) * G + v; u.pn = i % ntn; }
            else { const int L = (i - nf) * G + v; if (L >= (nb - rf * G) * ntn) return false; u.pm = rf * G + L / ntn; u.pn = L % ntn; }
        } else { const int L = i * G + v; if (L >= nunits) return false; u.pm = L / ntn; u.pn = L % ntn; }
        u.aux = 0; u.A = A + (size_t)u.pm * 256 * K * 2; u.B = nullptr; return true;
    }
    DEV const int* eptr(const GUnit& u) const { return blke + u.pm; }
    DEV const char* bptr(const GUnit& u, int e) const { return B + (size_t)e * estride + (size_t)u.pn * 256 * K * 2; }
};
}

namespace attn_body {
using bf16=_Float16;
using bf16x8=__attribute__((ext_vector_type(8)))short;
using s16x4=__attribute__((ext_vector_type(4)))short;
using f32x16=__attribute__((ext_vector_type(16)))float;
using u32x4=__attribute__((ext_vector_type(4)))unsigned;
using h16x8=__attribute__((ext_vector_type(8)))_Float16;
__device__ __forceinline__ f32x16 mf16(bf16x8 a,bf16x8 b,f32x16 c,int,int,int){return __builtin_amdgcn_mfma_f32_32x32x16_f16(__builtin_bit_cast(h16x8,a),__builtin_bit_cast(h16x8,b),c,0,0,0);}
constexpr int D=64,DM=2304;
constexpr int NW=8,QBLK=32,QB=QBLK*NW,KVBLK=64;
__device__ __forceinline__ int crow(int r,int hi){return (r&3)+8*(r>>2)+4*hi;}
#define SBAR() __builtin_amdgcn_sched_barrier(0)
__device__ __forceinline__ void cmask(f32x16&p0,f32x16&p1,int jb,int qrel,int hi){
  const float NEG=-INFINITY; int kb=64*jb+4*hi;
  #pragma unroll
  for(int r=0;r<16;++r){int kv=kb+(r&3)+8*(r>>2); if(kv>qrel)p0[r]=NEG; if(kv+32>qrel)p1[r]=NEG;}
}

constexpr int NSLOT=3, SLOTB=8192;
constexpr int LDS_K=0, LDS_V=NSLOT*SLOTB, LDS_WS=2*NSLOT*SLOTB, LDS_OST=LDS_WS+NW*64*4, LDS_BYTES=LDS_OST+NW*4096;
constexpr float C2=0.125f*1.4426950408889634f;
__device__ __forceinline__ void glds16(const void*gsrc,unsigned lds_dst){unsigned keep;
  asm volatile("s_mov_b32 %0, m0\n\ts_mov_b32 m0, %2\n\ts_nop 0\n\tglobal_load_lds_dwordx4 %1, off\n\ts_mov_b32 m0, %0":"=&s"(keep):"v"(gsrc),"s"(lds_dst):"memory");}
__device__ __forceinline__ float max3f(float a,float b,float c){float r;asm("v_max3_f32 %0, %1, %2, %3":"=v"(r):"v"(a),"v"(b),"v"(c));return r;}
__device__ __forceinline__ float max2f(float a,float b){float r;asm("v_max_f32_e32 %0, %1, %2":"=v"(r):"v"(a),"v"(b));return r;}
__device__ __forceinline__ float fadd_s(float a,float b){float r;asm("v_add_f32_e32 %0, %1, %2":"=v"(r):"v"(a),"v"(b));return r;}
__device__ __forceinline__ float fsub_s(float a,float b){float r;asm("v_sub_f32_e32 %0, %1, %2":"=v"(r):"v"(a),"v"(b));return r;}
typedef float f32x2_t __attribute__((ext_vector_type(2))); typedef _Float16 bf16x2_t __attribute__((ext_vector_type(2)));
__device__ __forceinline__ unsigned cvtpk_s(float lo,float hi){f32x2_t v={lo,hi};bf16x2_t b=__builtin_convertvector(v,bf16x2_t);return __builtin_bit_cast(unsigned,b);}
typedef __bf16 rbf16x2_t __attribute__((ext_vector_type(2))); typedef __bf16 rbf16x8_t __attribute__((ext_vector_type(8)));
__device__ __forceinline__ unsigned cvtpk_b(float lo,float hi){f32x2_t v={lo,hi};rbf16x2_t b=__builtin_convertvector(v,rbf16x2_t);return __builtin_bit_cast(unsigned,b);}
__device__ __forceinline__ f32x16 mfb16(bf16x8 a,bf16x8 b,f32x16 c,int,int,int){return __builtin_amdgcn_mfma_f32_32x32x16_bf16(__builtin_bit_cast(rbf16x8_t,a),__builtin_bit_cast(rbf16x8_t,b),c,0,0,0);}
#define WAIT_BAR(N) asm volatile("s_waitcnt vmcnt(" #N ") lgkmcnt(0)\n\ts_barrier":::"memory")

__device__ __forceinline__ void qkt(f32x16&p0,f32x16&p1,const char*Kslot,const bf16x8*qr,const f32x16&negm,int r32,int hi){
  const char*kb=Kslot+hi*1024+r32*16;
  #pragma unroll
  for(int d0=0;d0<4;++d0){
    const bf16x8 b0=*reinterpret_cast<const bf16x8*>(kb+d0*2048);
    const bf16x8 b1=*reinterpret_cast<const bf16x8*>(kb+d0*2048+512);
    if(d0==0){p0=mf16(b0,qr[0],negm,0,0,0);p1=mf16(b1,qr[0],negm,0,0,0);}
    else{p0=mf16(b0,qr[d0],p0,0,0,0);p1=mf16(b1,qr[d0],p1,0,0,0);}}
}
typedef __attribute__((address_space(3))) const char* lds_cptr;
typedef short v4i16_t __attribute__((ext_vector_type(4)));
__device__ __forceinline__ void kload8(bf16x8*kf,lds_cptr kp){
  kf[0]=*(const __attribute__((address_space(3))) bf16x8*)(kp);      kf[1]=*(const __attribute__((address_space(3))) bf16x8*)(kp+512);
  kf[2]=*(const __attribute__((address_space(3))) bf16x8*)(kp+2048); kf[3]=*(const __attribute__((address_space(3))) bf16x8*)(kp+2560);
  kf[4]=*(const __attribute__((address_space(3))) bf16x8*)(kp+4096); kf[5]=*(const __attribute__((address_space(3))) bf16x8*)(kp+4608);
  kf[6]=*(const __attribute__((address_space(3))) bf16x8*)(kp+6144); kf[7]=*(const __attribute__((address_space(3))) bf16x8*)(kp+6656);
}
__device__ __forceinline__ void kload2(bf16x8*kf,lds_cptr kp,int j){ kf[2*j]=*(const __attribute__((address_space(3))) bf16x8*)(kp+j*2048); kf[2*j+1]=*(const __attribute__((address_space(3))) bf16x8*)(kp+j*2048+512); }
__device__ __forceinline__ s16x4 vtr(lds_cptr p){ return __builtin_bit_cast(s16x4,__builtin_amdgcn_ds_read_tr16_b64_v4i16((__attribute__((address_space(3))) v4i16_t*)p)); }
__device__ __forceinline__ float rowmax(const f32x16&p0,const f32x16&p1){
  float a=max3f(p0[0],p0[1],p1[0]),b=max3f(p0[2],p0[3],p1[1]);a=max3f(a,p1[2],p1[3]);
  #pragma unroll
  for(int r=4;r<16;r+=4){a=max3f(a,p0[r],p0[r+1]);b=max3f(b,p0[r+2],p0[r+3]);a=max3f(a,p1[r],p1[r+1]);b=max3f(b,p1[r+2],p1[r+3]);}
  const float m=max2f(a,b);
  auto rr=__builtin_amdgcn_permlane32_swap(__float_as_uint(m),__float_as_uint(m),false,false);
  return max2f(__uint_as_float(rr[0]),__uint_as_float(rr[1]));
}
__device__ __forceinline__ void pv(f32x16*o,int vb,bf16x8 pa0,bf16x8 pa1,bf16x8 pa2,bf16x8 pa3){
  #pragma unroll
  for(int d0=0;d0<2;++d0){s16x4 lo[4],hi[4];
    #pragma unroll
    for(int ks=0;ks<4;++ks){
      asm volatile("ds_read_b64_tr_b16 %0,%1 offset:%c2":"=&v"(lo[ks]):"v"(vb),"i"(d0*4096+ks*1024):"memory");
      asm volatile("ds_read_b64_tr_b16 %0,%1 offset:%c2":"=&v"(hi[ks]):"v"(vb),"i"(d0*4096+ks*1024+512):"memory");}
    asm volatile("s_waitcnt lgkmcnt(0)":::"memory");SBAR();
    #define PK(k) (bf16x8){lo[k][0],lo[k][1],lo[k][2],lo[k][3],hi[k][0],hi[k][1],hi[k][2],hi[k][3]}
    o[d0]=mfb16(pa0,PK(0),o[d0],0,0,0);
    o[d0]=mfb16(pa1,PK(1),o[d0],0,0,0);
    o[d0]=mfb16(pa2,PK(2),o[d0],0,0,0);
    o[d0]=mfb16(pa3,PK(3),o[d0],0,0,0);
    #undef PK
  }
}

#ifndef ATTN_STORE16
#define ATTN_STORE16(p,v) (*(u32x4*)(p)=(v))
#endif
template<int THRL> __device__ __forceinline__ void attn_unit(const bf16*Qu,const bf16*__restrict__ Kh,const bf16*__restrict__ Vh,bf16*Ou,int opitch,char*shm){
  const int tid=threadIdx.x,lane=tid&63,r32=lane&31,hi=lane>>5; const int wid=__builtin_amdgcn_readfirstlane(tid>>6);
  const bf16*Qw=Qu+(long)(wid*QBLK)*DM;
  const unsigned lds0=(unsigned)(uintptr_t)shm;
  float*wsf=(float*)(shm+LDS_WS)+wid*64;
  const bf16*ksrc=Kh+(long)lane*DM+wid*8;
  const bf16*vsrc=Vh+(long)(16*(wid&3)+(lane>>2))*DM+(wid>>2)*32+(lane&3)*8;
  const unsigned kdst=lds0+LDS_K+wid*1024, vdst=lds0+LDS_V+wid*1024;
  #define DMA_K(t,slot) glds16(ksrc+(long)(t)*KVBLK*DM,(unsigned)__builtin_amdgcn_readfirstlane(kdst+(slot)))
  #define DMA_V(t,slot) glds16(vsrc+(long)(t)*KVBLK*DM,(unsigned)__builtin_amdgcn_readfirstlane(vdst+(slot)))
  const int vb0=(int)(lds0+LDS_V)+((lane>>4)&1)*32+(lane&3)*8+(4*hi+((lane&15)>>2))*64;
  const char*Kbase=shm+LDS_K; bf16x8 kf[8];
  const lds_cptr shm3=(lds_cptr)shm; const lds_cptr kp0=shm3+LDS_K+hi*1024+r32*16; const lds_cptr vp0=shm3+LDS_V+((lane>>4)&1)*32+(lane&3)*8+(4*hi+((lane&15)>>2))*64;
  constexpr int NT=36;
  DMA_K(0,0);DMA_V(0,0);DMA_K(1,SLOTB);
  bf16x8 qr[4];
  #pragma unroll
  for(int d0=0;d0<4;++d0)qr[d0]=*reinterpret_cast<const bf16x8*>(&Qw[(long)r32*DM+d0*16+hi*8]);
  float l_reg=0.f;f32x16 o[2];o[0]=f32x16{};o[1]=f32x16{};
  #define CMASK(P0,P1,t) do{}while(0)
  #define START(P0,P1) do{ _Pragma("unroll") for(int r=0;r<16;++r)P0[r]=__builtin_amdgcn_exp2f(P0[r]); }while(0)
  #define RESC() do{}while(0)
  f32x16 pA0,pA1,pB0,pB1;
  int sl_prev=0,sl_cur=0,sl_next=SLOTB;
  #define ROT() do{sl_prev=sl_cur;sl_cur=sl_next;sl_next=(sl_next==(NSLOT-1)*SLOTB)?0:sl_next+SLOTB;}while(0)
  DMA_K(2,2*SLOTB);
  WAIT_BAR(3);
  qkt(pA0,pA1,Kbase,qr,f32x16{},r32,hi);asm volatile("s_nop 15\n\ts_nop 7":"+v"(pA0),"+v"(pA1));CMASK(pA0,pA1,0);
  START(pA0,pA1);
  _Pragma("unroll") for(int r=0;r<16;++r)pA1[r]=__builtin_amdgcn_exp2f(pA1[r]);
  WAIT_BAR(0);
  DMA_K(3,0);DMA_V(1,SLOTB);
  ROT();
  kload8(kf,kp0+sl_cur);
  WAIT_BAR(2);
  s16x4 vlo[8],vhi[8]; u32x4 pw0,pw1,pw2,pw3;
  #define PKW(P,B) cvtpk_b(P[B],P[B+1])
  #define PAF(k) __builtin_bit_cast(bf16x8,pw##k)
  #define VFR(i) (bf16x8){vlo[i][0],vlo[i][1],vlo[i][2],vlo[i][3],vhi[i][0],vhi[i][1],vhi[i][2],vhi[i][3]}
  #define PIN(x) asm volatile("":"+v"(x))
  #define MX3(a,b,c) __builtin_fmaxf(__builtin_fmaxf((a),(b)),(c))
  #define GAPA(MF,A0,A1,A2,A3,W0,W1,PW) do{ MF; sacc+=A0; sacc+=A1; sacc+=A2; sacc+=A3; PIN(sacc); W0; W1; PIN(PW); SBAR(); }while(0)
  #define EX(v) __builtin_amdgcn_exp2f(v)
  #define GAPB(MF,X,B) do{ MF; X[B]=EX(X[B]); X[B+1]=EX(X[B+1]); X[B+2]=EX(X[B+2]); X[B+3]=EX(X[B+3]); PIN(X); SBAR(); }while(0)
  #define VRD(i) do{ vlo[i]=vtr(vp_+(((i)>>2)*4096+((i)&3)*1024)); vhi[i]=vtr(vp_+(((i)>>2)*4096+((i)&3)*1024+512)); }while(0)
  #define KRD(G,j) do{ if(G){ kload2(kf,kp0+sl_next,j); SBAR(); } }while(0)
  #define STEP(C0,C1,P0,P1,t,GK,GV,GL) do{ SBAR(); \
    const lds_cptr vp_=vp0+sl_prev; \
    VRD(0); SBAR(); float sacc=(P0[0]+P0[1]); \
    GAPA(C0=mf16(kf[0],qr[0],f32x16{},0,0,0), P0[2],P0[3],P0[4],P0[5],     pw0[0]=PKW(P0,0), pw0[1]=PKW(P0,2), pw0); \
    VRD(4); SBAR(); GAPA(C1=mf16(kf[1],qr[0],f32x16{},0,0,0), P0[6],P0[7],P0[8],P0[9],     pw0[2]=PKW(P0,4), pw0[3]=PKW(P0,6), pw0); \
    VRD(1); SBAR(); GAPA(C0=mf16(kf[2],qr[1],C0,0,0,0),   P0[10],P0[11],P0[12],P0[13], pw1[0]=PKW(P0,8), pw1[1]=PKW(P0,10), pw1); \
    VRD(5); SBAR(); GAPA(C1=mf16(kf[3],qr[1],C1,0,0,0),   P0[14],P0[15],P1[0],P1[1],   pw1[2]=PKW(P0,12),pw1[3]=PKW(P0,14), pw1); \
    VRD(2); SBAR(); GAPA(C0=mf16(kf[4],qr[2],C0,0,0,0),   P1[2],P1[3],P1[4],P1[5],     pw2[0]=PKW(P1,0), pw2[1]=PKW(P1,2), pw2); \
    VRD(6); SBAR(); GAPA(C1=mf16(kf[5],qr[2],C1,0,0,0),   P1[6],P1[7],P1[8],P1[9],     pw2[2]=PKW(P1,4), pw2[3]=PKW(P1,6), pw2); \
    VRD(3); SBAR(); GAPA(C0=mf16(kf[6],qr[3],C0,0,0,0),   P1[10],P1[11],P1[12],P1[13], pw3[0]=PKW(P1,8), pw3[1]=PKW(P1,10), pw3); \
    VRD(7); SBAR(); GAPA(C1=mf16(kf[7],qr[3],C1,0,0,0),   P1[14],P1[15],0.f,0.f,       pw3[2]=PKW(P1,12),pw3[3]=PKW(P1,14), pw3); \
    l_reg+=sacc; \
    if(GK){DMA_K((t)+3,sl_cur);} if(GV){DMA_V((t)+1,sl_next);} \
    SBAR(); \
    GAPB(o[0]=mfb16(PAF(0),VFR(0),o[0],0,0,0), C0,0); \
    GAPB(o[1]=mfb16(PAF(0),VFR(4),o[1],0,0,0), C0,4); \
    KRD(GL,0); GAPB(o[0]=mfb16(PAF(1),VFR(1),o[0],0,0,0), C0,8); \
    KRD(GL,1); GAPB(o[1]=mfb16(PAF(1),VFR(5),o[1],0,0,0), C0,12); \
    KRD(GL,2); GAPB(o[0]=mfb16(PAF(2),VFR(2),o[0],0,0,0), C1,0); \
    KRD(GL,3); GAPB(o[1]=mfb16(PAF(2),VFR(6),o[1],0,0,0), C1,4); \
    GAPB(o[0]=mfb16(PAF(3),VFR(3),o[0],0,0,0), C1,8); \
    GAPB(o[1]=mfb16(PAF(3),VFR(7),o[1],0,0,0), C1,12); \
    }while(0)
  int t=1;
  #undef CMASK
  #define CMASK(P0,P1,t) do{}while(0)
  for(;t+5<NT;t+=2){
    STEP(pB0,pB1,pA0,pA1,t,true,true,true);     WAIT_BAR(2); RESC(); ROT();
    STEP(pA0,pA1,pB0,pB1,t+1,true,true,true);   WAIT_BAR(2); RESC(); ROT();
  }
  #undef CMASK
  #define CMASK(P0,P1,t) do{}while(0)
  #define ENDW(tt) do{ if((tt)+3<NT){WAIT_BAR(2);} else if((tt)+2<NT){WAIT_BAR(1);} else {WAIT_BAR(0);} }while(0)
  for(;t+1<NT;t+=2){
    STEP(pB0,pB1,pA0,pA1,t,(t+3<NT),(t+1<NT),(t+1<NT));       ENDW(t);   RESC(); ROT();
    STEP(pA0,pA1,pB0,pB1,t+1,(t+4<NT),(t+2<NT),(t+2<NT));     ENDW(t+1); RESC(); ROT();
  }
  STEP(pB0,pB1,pA0,pA1,NT-1,false,false,false); RESC();
  { float sacc=pB0[0]+pB0[1]; _Pragma("unroll") for(int r=2;r<16;++r)sacc+=pB0[r]; _Pragma("unroll") for(int r=0;r<16;++r)sacc+=pB1[r]; l_reg+=sacc;
    pw0=(u32x4){PKW(pB0,0),PKW(pB0,2),PKW(pB0,4),PKW(pB0,6)};pw1=(u32x4){PKW(pB0,8),PKW(pB0,10),PKW(pB0,12),PKW(pB0,14)};pw2=(u32x4){PKW(pB1,0),PKW(pB1,2),PKW(pB1,4),PKW(pB1,6)};pw3=(u32x4){PKW(pB1,8),PKW(pB1,10),PKW(pB1,12),PKW(pB1,14)};
    SBAR(); pv(o,vb0+sl_cur,PAF(0),PAF(1),PAF(2),PAF(3)); }
  #undef PKW
  #undef PAF
  #undef VFR
  #undef PIN
  #undef MX3
  #undef GAPA
  #undef GAPB
  #undef EX
  #undef VRD
  #undef KRD
  #undef STEP
  #undef ENDW
  {auto rr=__builtin_amdgcn_permlane32_swap(__float_as_uint(l_reg),__float_as_uint(l_reg),false,false);l_reg=__uint_as_float(rr[0])+__uint_as_float(rr[1]);}
  if(hi==0)wsf[32+r32]=l_reg;asm volatile("s_waitcnt lgkmcnt(0)":::"memory");
  float rli[16];
  #pragma unroll
  for(int r=0;r<16;++r)rli[r]=__builtin_amdgcn_rcpf(wsf[32+crow(r,hi)]);
  bf16*Ow=Ou+(long)(wid*QBLK)*opitch;
  { bf16*stg=(bf16*)(shm+LDS_OST)+wid*2048;
    #pragma unroll
    for(int r=0;r<16;++r){const int orow=crow(r,hi);
      #pragma unroll
      for(int d0=0;d0<2;++d0)stg[orow*64+d0*32+r32]=(bf16)(o[d0][r]*rli[r]);}
    asm volatile("s_waitcnt lgkmcnt(0)":::"memory");
    #pragma unroll
    for(int i=0;i<4;++i){const int row=i*8+(lane>>3),ch=lane&7; const u32x4 v=*(const u32x4*)(stg+row*64+ch*8); ATTN_STORE16(Ow+(long)row*opitch+ch*8,v);} }
  asm volatile("s_waitcnt lgkmcnt(0)\n\ts_barrier":::"memory");
  #undef DMA_K
  #undef DMA_V
  #undef CMASK
  #undef START
  #undef RESC
  #undef ROT
}

constexpr int U_SLOTK=8192,U_LDS_K=0,U_LDS_V=3*U_SLOTK,U_LDS_WS=U_LDS_V+3*16384,U_LDS_OST=U_LDS_WS+2048,U_LDS_Q=U_LDS_OST+NW*4096,U_LDS_BYTES=U_LDS_Q+NW*4096;
template<int THRL> __device__ __forceinline__ void attn_unit128(const bf16*Qu,const bf16*__restrict__ Kh,const bf16*__restrict__ Vh,bf16*Ou,int opitch,char*shm){
  const int tid=threadIdx.x,lane=tid&63,r32=lane&31,hi=lane>>5; const int wid=__builtin_amdgcn_readfirstlane(tid>>6);
  const bf16*Qw=Qu+(long)(wid*QBLK)*DM;
  const unsigned lds0=(unsigned)(uintptr_t)shm;
  float*wsf=(float*)(shm+U_LDS_WS)+wid*64;
  const bf16*ksrc=Kh+(long)lane*DM+wid*8;
  const bf16*vsrc=Vh+(long)(16*(wid&3)+(lane>>2))*DM+(wid>>2)*32+(lane&3)*8;
  const unsigned kdst=lds0+U_LDS_K+wid*1024, vdst=lds0+U_LDS_V+wid*1024;
  #define DMA_K(t,slot) glds16(ksrc+(long)(t)*KVBLK*DM,(unsigned)__builtin_amdgcn_readfirstlane(kdst+(slot)))
  #define DMA_V(t,slot) do{ glds16(vsrc+(long)(t)*KVBLK*DM,(unsigned)__builtin_amdgcn_readfirstlane(vdst+2*(slot))); glds16(vsrc+(long)(t)*KVBLK*DM+64,(unsigned)__builtin_amdgcn_readfirstlane(vdst+2*(slot)+8192)); }while(0)
  const int vb0=(int)(lds0+U_LDS_V)+((lane>>4)&1)*32+(lane&3)*8+(4*hi+((lane&15)>>2))*64;
  bf16x8 kf[8];
  const lds_cptr shm3=(lds_cptr)shm; const lds_cptr kp0=shm3+U_LDS_K+hi*1024+r32*16; const lds_cptr vp0=shm3+U_LDS_V+((lane>>4)&1)*32+(lane&3)*8+(4*hi+((lane&15)>>2))*64;
  constexpr int NT=36;
  DMA_K(0,0);DMA_V(0,0);DMA_K(1,U_SLOTK);
  const lds_cptr qp0=shm3+U_LDS_Q+tid*16;
  { bf16x8 qr[4];
    #pragma unroll
    for(int d0=0;d0<4;++d0)qr[d0]=*reinterpret_cast<const bf16x8*>(&Qw[(long)r32*DM+d0*16+hi*8]);
    #pragma unroll
    for(int d0=0;d0<4;++d0)*(__attribute__((address_space(3))) bf16x8*)(qp0+d0*8192)=qr[d0]; }
  #define QF(d0) (*(const __attribute__((address_space(3))) bf16x8*)(qp0+(d0)*8192))
  float l_reg=0.f;f32x16 o[4];o[0]=f32x16{};o[1]=f32x16{};o[2]=f32x16{};o[3]=f32x16{};
  #define RESC() do{}while(0)
  f32x16 pA0,pA1,pB0,pB1;
  int sl_prev=0,sl_cur=0,sl_next=U_SLOTK;
  #define ROT() do{sl_prev=sl_cur;sl_cur=sl_next;sl_next=(sl_next==2*U_SLOTK)?0:sl_next+U_SLOTK;}while(0)
  DMA_K(2,2*U_SLOTK);
  WAIT_BAR(4);
  { kload8(kf,kp0);
    { const bf16x8 q0=QF(0),q1=QF(1),q2=QF(2),q3=QF(3);
    pA0=mf16(kf[0],q0,f32x16{},0,0,0);pA1=mf16(kf[1],q0,f32x16{},0,0,0);pA0=mf16(kf[2],q1,pA0,0,0,0);pA1=mf16(kf[3],q1,pA1,0,0,0);
    pA0=mf16(kf[4],q2,pA0,0,0,0);pA1=mf16(kf[5],q2,pA1,0,0,0);pA0=mf16(kf[6],q3,pA0,0,0,0);pA1=mf16(kf[7],q3,pA1,0,0,0); }
    asm volatile("s_nop 15\n\ts_nop 7":"+v"(pA0),"+v"(pA1));
    _Pragma("unroll") for(int r=0;r<16;++r){pA0[r]=__builtin_amdgcn_exp2f(pA0[r]);pA1[r]=__builtin_amdgcn_exp2f(pA1[r]);} }
  WAIT_BAR(0);
  DMA_K(3,0);DMA_V(1,U_SLOTK);
  ROT();
  kload8(kf,kp0+sl_cur);
  WAIT_BAR(3);
  s16x4 vrl[4],vrh[4]; u32x4 pw0,pw1,pw2,pw3;
  #define PKW(P,B) cvtpk_b(P[B],P[B+1])
  #define PAF(k) __builtin_bit_cast(bf16x8,pw##k)
  #define FID(g) ((((g)&3)<<2)+((g)>>2))
  #define VF(g) (bf16x8){vrl[(g)&3][0],vrl[(g)&3][1],vrl[(g)&3][2],vrl[(g)&3][3],vrh[(g)&3][0],vrh[(g)&3][1],vrh[(g)&3][2],vrh[(g)&3][3]}
  #define VRDR(g) do{ vrl[(g)&3]=vtr(vp_+((FID(g)>>2)*4096+(FID(g)&3)*1024)); vrh[(g)&3]=vtr(vp_+((FID(g)>>2)*4096+(FID(g)&3)*1024+512)); }while(0)
  #define PIN(x) asm volatile("":"+v"(x))
  #define MX3(a,b,c) __builtin_fmaxf(__builtin_fmaxf((a),(b)),(c))
  #define EX(v) __builtin_amdgcn_exp2f(v)
  { float s0=pA0[0]+pA0[1]; _Pragma("unroll") for(int r=2;r<16;++r)s0+=pA0[r]; _Pragma("unroll") for(int r=0;r<16;++r)s0+=pA1[r]; l_reg+=s0;
    pw0=(u32x4){PKW(pA0,0),PKW(pA0,2),PKW(pA0,4),PKW(pA0,6)};pw1=(u32x4){PKW(pA0,8),PKW(pA0,10),PKW(pA0,12),PKW(pA0,14)};pw2=(u32x4){PKW(pA1,0),PKW(pA1,2),PKW(pA1,4),PKW(pA1,6)}; pw3=(u32x4){0u,0u,0u,0u}; }
  #define GAPA(MF,W) do{ MF; W; SBAR(); }while(0)
  #define GAPB(g,KS,X,B,PKSTMT) do{ o[(g)&3]=mfb16(PAF(KS),VF(g),o[(g)&3],0,0,0); if((g)+4<16){VRDR((g)+4);} X[B]=EX(X[B]); X[B+1]=EX(X[B+1]); sacc+=X[B]; sacc+=X[B+1]; PIN(sacc); PKSTMT; PIN(X); SBAR(); }while(0)
  #define KRD(G,j) do{ if(G){ kload2(kf,kp0+sl_next,j); SBAR(); } }while(0)
  #define STEP(C0,C1,P0,P1,t,GK,GV,GL) do{ SBAR(); \
    const lds_cptr vp_=vp0+2*sl_prev; \
    bf16x8 qa=QF(0),qb=QF(1); SBAR(); \
    GAPA(C0=mf16(kf[0],qa,f32x16{},0,0,0), pw3[0]=PKW(P1,8)); \
    GAPA(C1=mf16(kf[1],qa,f32x16{},0,0,0), pw3[1]=PKW(P1,10)); \
    qa=QF(2); SBAR(); \
    GAPA(C0=mf16(kf[2],qb,C0,0,0,0),       pw3[2]=PKW(P1,12)); \
    GAPA(C1=mf16(kf[3],qb,C1,0,0,0),       pw3[3]=PKW(P1,14); PIN(pw3)); \
    qb=QF(3); SBAR(); \
    VRDR(0); SBAR(); GAPA(C0=mf16(kf[4],qa,C0,0,0,0), (void)0); \
    VRDR(1); SBAR(); GAPA(C1=mf16(kf[5],qa,C1,0,0,0), (void)0); \
    VRDR(2); SBAR(); GAPA(C0=mf16(kf[6],qb,C0,0,0,0), (void)0); \
    VRDR(3); SBAR(); GAPA(C1=mf16(kf[7],qb,C1,0,0,0), (void)0); \
    if(GK){DMA_K((t)+3,sl_cur);} if(GV){DMA_V((t)+1,sl_next);} \
    float sacc=0.f; \
    SBAR(); \
    GAPB(0,0,C0,0,(void)0);  GAPB(1,0,C0,2,(void)0);  GAPB(2,0,C0,4,(void)0);  GAPB(3,0,C0,6,(void)0); \
    KRD(GL,0); GAPB(4,1,C0,8,pw0[0]=PKW(C0,0));  KRD(GL,1); GAPB(5,1,C0,10,pw0[1]=PKW(C0,2)); KRD(GL,2); GAPB(6,1,C0,12,pw0[2]=PKW(C0,4)); KRD(GL,3); GAPB(7,1,C0,14,pw0[3]=PKW(C0,6); PIN(pw0)); \
    GAPB(8,2,C1,0,pw1[0]=PKW(C0,8));  GAPB(9,2,C1,2,pw1[1]=PKW(C0,10)); GAPB(10,2,C1,4,pw1[2]=PKW(C0,12)); GAPB(11,2,C1,6,pw1[3]=PKW(C0,14); PIN(pw1)); \
    GAPB(12,3,C1,8,pw2[0]=PKW(C1,0)); GAPB(13,3,C1,10,pw2[1]=PKW(C1,2));GAPB(14,3,C1,12,pw2[2]=PKW(C1,4));GAPB(15,3,C1,14,pw2[3]=PKW(C1,6); PIN(pw2)); \
    l_reg+=sacc; \
    }while(0)
  int t=1;
  for(;t+5<NT;t+=2){
    STEP(pB0,pB1,pA0,pA1,t,true,true,true);     WAIT_BAR(3); RESC(); ROT();
    STEP(pA0,pA1,pB0,pB1,t+1,true,true,true);   WAIT_BAR(3); RESC(); ROT();
  }
  #define ENDW(tt) do{ if((tt)+3<NT){WAIT_BAR(3);} else if((tt)+2<NT){WAIT_BAR(2);} else {WAIT_BAR(0);} }while(0)
  for(;t+1<NT;t+=2){
    STEP(pB0,pB1,pA0,pA1,t,(t+3<NT),(t+1<NT),(t+1<NT));       ENDW(t);   RESC(); ROT();
    STEP(pA0,pA1,pB0,pB1,t+1,(t+4<NT),(t+2<NT),(t+2<NT));     ENDW(t+1); RESC(); ROT();
  }
  STEP(pB0,pB1,pA0,pA1,NT-1,false,false,false); RESC();
  { pw3=(u32x4){PKW(pB1,8),PKW(pB1,10),PKW(pB1,12),PKW(pB1,14)};
    SBAR(); pv(o,vb0+2*sl_cur,PAF(0),PAF(1),PAF(2),PAF(3)); pv(o+2,vb0+2*sl_cur+8192,PAF(0),PAF(1),PAF(2),PAF(3)); }
  #undef PKW
  #undef PAF
  #undef FID
  #undef VF
  #undef VRDR
  #undef PIN
  #undef MX3
  #undef GAPA
  #undef GAPB
  #undef EX
  #undef KRD
  #undef STEP
  #undef ENDW
  {auto rr=__builtin_amdgcn_permlane32_swap(__float_as_uint(l_reg),__float_as_uint(l_reg),false,false);l_reg=__uint_as_float(rr[0])+__uint_as_float(rr[1]);}
  if(hi==0)wsf[32+r32]=l_reg;asm volatile("s_waitcnt lgkmcnt(0)":::"memory");
  float rli[16];
  #pragma unroll
  for(int r=0;r<16;++r)rli[r]=__builtin_amdgcn_rcpf(wsf[32+crow(r,hi)]);
  { bf16*stg=(bf16*)(shm+U_LDS_OST)+wid*2048;
    bf16*Ow=Ou+(long)(wid*QBLK)*opitch;
    #pragma unroll
    for(int hf=0;hf<2;++hf){
      #pragma unroll
      for(int r=0;r<16;++r){const int orow=crow(r,hi);
        #pragma unroll
        for(int d0=0;d0<2;++d0)stg[orow*64+d0*32+r32]=(bf16)(o[2*hf+d0][r]*rli[r]);}
      asm volatile("s_waitcnt lgkmcnt(0)":::"memory");
      #pragma unroll
      for(int i=0;i<4;++i){const int row=i*8+(lane>>3),ch=lane&7; const u32x4 v=*(const u32x4*)(stg+row*64+ch*8); *(u32x4*)(Ow+(long)row*opitch+hf*64+ch*8)=v;}
      asm volatile("s_waitcnt lgkmcnt(0)":::"memory"); } }
  asm volatile("s_waitcnt lgkmcnt(0)\n\ts_barrier":::"memory");
  #undef DMA_K
  #undef DMA_V
  #undef RESC
  #undef ROT
  #undef QF
}

__device__ __forceinline__ void diff_combine_unit(const bf16*O0u,const bf16*O1u,int opitch,float lam,const float*subg,bf16*Mx){
  const int tid=threadIdx.x,lane=tid&63; const int wid=__builtin_amdgcn_readfirstlane(tid>>6);
  asm volatile("s_waitcnt vmcnt(0)":::"memory");
  const bf16*O0w=O0u+(long)(wid*QBLK)*opitch; const bf16*O1w=O1u+(long)(wid*QBLK)*opitch; bf16*Mw=Mx+(long)(wid*QBLK)*1024;
  float sg[16];
  #pragma unroll
  for(int j=0;j<16;++j)sg[j]=subg[(j>>3)*64+(lane&7)*8+(j&7)];
  #pragma unroll
  for(int i=0;i<4;++i){const int row=i*8+(lane>>3),ch=lane&7;
    float d[16]; float ss=0.f;
    #pragma unroll
    for(int hf=0;hf<2;++hf){ const h16x8 v0=*(const h16x8*)(O0w+(long)row*opitch+hf*64+ch*8); const h16x8 v1=*(const h16x8*)(O1w+(long)row*opitch+hf*64+ch*8);
      #pragma unroll
      for(int j=0;j<8;++j){d[hf*8+j]=(float)v0[j]-lam*(float)v1[j];ss+=d[hf*8+j]*d[hf*8+j];} }
    ss+=__shfl_xor(ss,1);ss+=__shfl_xor(ss,2);ss+=__shfl_xor(ss,4);
    const float rs=__builtin_amdgcn_rsqf(ss*(1.f/128.f)+1e-6f)*0.8f;
    #pragma unroll
    for(int hf=0;hf<2;++hf){ h16x8 ov;
      #pragma unroll
      for(int j=0;j<8;++j)ov[j]=(_Float16)(d[hf*8+j]*rs*sg[hf*8+j]);
      *(h16x8*)(Mw+(long)row*1024+hf*64+ch*8)=ov; } }
}
constexpr int ATTN_LDS_BYTES=LDS_BYTES;
#undef SBAR
#undef WAIT_BAR
}

DEV void ph_attn(const Frame& F, int vcu) {
    const f16* qkv = WSP(f16, WS_QKV); f16* sdiff = WSP(f16, WS_SDIFF); f16* mixed = WSP(f16, WS_MIXED);
    const int spr = F.G >> 3, qb = vcu & 7;
#pragma unroll 1
    for (int i = 0;; ++i) {
        const int L = i * spr + (vcu >> 3); if (L >= NB * 4) break;
        const int b = L >> 2, h = L & 3;
        const size_t trow = (size_t)b * SEQ + qb * 256;
        const f16* base = qkv + (size_t)b * RB * NIN;
        const f16* qrow = base + (size_t)(CL + qb * 256) * NIN;
        f16* o0 = sdiff + trow * 512 + h * 128;
#pragma unroll 1
        for (int mp = 0; mp < 2; ++mp)
            attn_body::attn_unit128<8>(qrow + h * 128 + mp * 64, base + 512 + h * 128 + mp * 64, base + 1024 + h * 128, o0 + (size_t)mp * NT * 512, 512, (char*)F.lds);
        attn_body::diff_combine_unit(o0, o0 + (size_t)NT * 512, 512, WSP(float, WS_MISC)[0], F.in[15], mixed + trow * DM + h * 128);
    }
#pragma unroll 1
    for (int i = 0;; ++i) {
        const int L = i * spr + (vcu >> 3); if (L >= NB * 8) break;
        const int b = L >> 3, g = L & 7;
        const size_t trow = (size_t)b * SEQ + qb * 256;
        const f16* base = qkv + (size_t)b * RB * NIN;
        attn_body::attn_unit<8>(base + (size_t)(CL + qb * 256) * NIN + 1536 + g * 64, base + 2048 + (g >> 2) * 64, base + 2176 + (g >> 2) * 64, mixed + trow * DM + 512 + g * 64, DM, (char*)F.lds);
    }
}

DEV void ph_rowpass(const Frame& F) {
    const float* x = F.in[0]; const f16* y1 = WSP(f16, WS_Y1); const float* mod = WSP(float, WS_MOD); const float* gpost = F.in[7]; const float* gpre = F.in[17];
    const float* wr = F.in[19]; const float* rbias = F.in[20]; float* x1out = F.out; unsigned char* h2 = F.ws + WS_H2;
    int* idx = WSP(int, WS_IDX); int* rank = WSP(int, WS_RANK); float* gw = WSP(float, WS_GW); int* cnt = WSP(int, WS_CNT);
    constexpr int AROW = 2064;
    LAS unsigned char* Ahi = (LAS unsigned char*)F.lds; LAS unsigned char* Alo = Ahi + 16 * AROW; LAS float* part = (LAS float*)(Ahi + 32 * AROW);
    LAS int* lcnt = (LAS int*)(Ahi + 32 * AROW + 32768);
    if (F.tid < 64) lcnt[F.tid] = 0;
    const int wave = F.wave, lane = F.lane, fr = lane & 15, fq = lane >> 4;
    f16x8 Bh[4][4];
#pragma unroll
    for (int ks = 0; ks < 4; ++ks)
#pragma unroll
        for (int n = 0; n < 4; ++n) { const int k0 = wave * 128 + ks * 32 + fq * 8, e = n * 16 + fr;
#pragma unroll
            for (int j = 0; j < 8; ++j) Bh[ks][n][j] = (f16)wr[(k0 + j) * NE + e]; }
    const float rb = rbias[lane];
    f32x4 X[2][4]; f16x4 Y[2][4];
#define RP_LOAD(T0) do { _Pragma("unroll") for (int u = 0; u < 2; ++u) { const size_t t_ = (size_t)(T0) + wave * 2 + u; \
        _Pragma("unroll") for (int j = 0; j < 4; ++j) { const int c0 = j * 256 + lane * 4; X[u][j] = *(const f32x4*)(x + t_ * DM + c0); Y[u][j] = *(const f16x4*)(y1 + t_ * DM + c0); } } } while (0)
    constexpr int NBLK = NT / 256;
    if (F.bid < NBLK) RP_LOAD(F.bid * 256);
#pragma unroll 1
    for (int blk = F.bid; blk < NBLK; blk += F.G) {
      f32x4 A1[4], G2[4]; const float* const mb = mod + (size_t)(blk / (SEQ / 256)) * NMOD;
      { const float* m = mb;
#pragma unroll
        for (int j = 0; j < 4; ++j) { const int c0 = j * 256 + lane * 4; A1[j] = *(const f32x4*)(m + 2048 + c0) * *(const f32x4*)(gpost + c0); G2[j] = *(const f32x4*)(gpre + c0) * (*(const f32x4*)(m + 4096 + c0) + 1.f); } }
#pragma unroll 1
      for (int st = 0; st < 16; ++st) {
        const int t0 = blk * 256 + st * 16;
#pragma unroll
        for (int u = 0; u < 2; ++u) {
            const int r = wave * 2 + u; const size_t t = (size_t)t0 + r;
            float ss = 0.f;
#pragma unroll
            for (int j = 0; j < 4; ++j)
#pragma unroll
                for (int i = 0; i < 4; ++i) { const float yv = (float)Y[u][j][i]; ss += yv * yv; }
            const float rstd1 = rsqrtf(wave_sum(ss) * (1.f / DM) + EPS);
            float s2 = 0.f;
#pragma unroll
            for (int j = 0; j < 4; ++j) { const int c0 = j * 256 + lane * 4; f16x4 oh;
#pragma unroll
                for (int i = 0; i < 4; ++i) { const float v = X[u][j][i] + A1[j][i] * ((float)Y[u][j][i] * rstd1); X[u][j][i] = v; oh[i] = (f16)v; s2 += v * v; }
                *(f16x4*)((f16*)(x1out + t * DM) + c0) = oh; }
            const float rstd2 = rsqrtf(wave_sum(s2) * (1.f / DM) + EPS);
#pragma unroll
            for (int j = 0; j < 4; ++j) { const int c0 = j * 256 + lane * 4; const f32x4 sh = *(const f32x4*)(mb + 3072 + c0); f16x4 o, ol;
#pragma unroll
                for (int i = 0; i < 4; ++i) { const float v = X[u][j][i] * rstd2 * G2[j][i] + sh[i]; o[i] = (f16)v; ol[i] = (f16)(v - (float)o[i]); }
                { int q8 = __builtin_amdgcn_cvt_pk_fp8_f32(c8((float)o.x + (float)ol.x), c8((float)o.y + (float)ol.y), 0, false); q8 = __builtin_amdgcn_cvt_pk_fp8_f32(c8((float)o.z + (float)ol.z), c8((float)o.w + (float)ol.w), q8, true); *(int*)(h2 + t * DM + c0) = q8; }
                *(LAS f16x4*)(Ahi + r * AROW + c0 * 2) = o; *(LAS f16x4*)(Alo + r * AROW + c0 * 2) = ol; }
        }
        if (st < 15) RP_LOAD(t0 + 16); else if (blk + F.G < NBLK) RP_LOAD((blk + F.G) * 256);
        __syncthreads();
        { f32x4 acc[4];
#pragma unroll
          for (int n = 0; n < 4; ++n) acc[n] = (f32x4){0.f, 0.f, 0.f, 0.f};
#pragma unroll
          for (int ks = 0; ks < 4; ++ks) { const int off = fr * AROW + (wave * 128 + ks * 32 + fq * 8) * 2;
              const f16x8 ah = *(const LAS f16x8*)(Ahi + off), al = *(const LAS f16x8*)(Alo + off);
#pragma unroll
              for (int n = 0; n < 4; ++n) { acc[n] = __builtin_amdgcn_mfma_f32_16x16x32_f16(ah, Bh[ks][n], acc[n], 0, 0, 0); acc[n] = __builtin_amdgcn_mfma_f32_16x16x32_f16(al, Bh[ks][n], acc[n], 0, 0, 0); } }
#pragma unroll
          for (int n = 0; n < 4; ++n)
#pragma unroll
              for (int q = 0; q < 4; ++q) part[(wave * 16 + 4 * fq + q) * 64 + n * 16 + fr] = acc[n][q]; }
        __syncthreads();
#pragma unroll 1
        for (int rr = 0; rr < 2; ++rr) {
            const int r = wave * 2 + rr; const size_t t = (size_t)t0 + r; const int e = lane;
            float lgt = 0.f;
#pragma unroll
            for (int p = 0; p < 8; ++p) lgt += part[(p * 16 + r) * 64 + e];
            const float s = 1.f / (1.f + expf(-lgt)); const float sel = s + rb;
            int rk = 0;
#pragma unroll
            for (int d = 1; d < 8; ++d) { const float o = __shfl_xor(sel, d); rk += (o > sel || (o == sel && (e ^ d) < e)) ? 1 : 0; }
            float gs = rk < 2 ? sel : 0.f; gs += __shfl_xor(gs, 1); gs += __shfl_xor(gs, 2); gs += __shfl_xor(gs, 4);
            int grk = 0; const int g = e >> 3;
#pragma unroll
            for (int d = 1; d < 8; ++d) { const float o = __shfl_xor(gs, d * 8); grk += (o > gs || (o == gs && (g ^ d) < g)) ? 1 : 0; }
            const bool gsel = grk < 4;
            const float v = gsel ? sel : -INFINITY;
            int r8 = 0;
#pragma unroll
            for (int j = 0; j < 64; ++j) { const float o = __builtin_bit_cast(float, __builtin_amdgcn_readlane(__builtin_bit_cast(int, v), j)); r8 += (o > v || (o == v && j < e)) ? 1 : 0; }
            const bool chosen = gsel && r8 < 8;
            const float tot = wave_sum(chosen ? s : 0.f);
            if (chosen) { idx[t * 8 + r8] = e; gw[t * 8 + r8] = s / tot * 2.5f; rank[t * 8 + r8] = __hip_atomic_fetch_add(&lcnt[e], 1, __ATOMIC_RELAXED, __HIP_MEMORY_SCOPE_WORKGROUP); }
        }
      }
    }
#undef RP_LOAD
    __syncthreads();
    if (F.tid < 64) WSP(int, WS_WGB)[F.bid * 64 + F.tid] = atomicAdd(&cnt[F.tid * 64], lcnt[F.tid]);
    __syncthreads();
}

DEV void ph_dispatch(const Frame& F) {
    const int* idx = WSP(int, WS_IDX); const int* rank = WSP(int, WS_RANK); const float* gw = WSP(float, WS_GW); const int* cnt = WSP(int, WS_CNT); const int* wgb = WSP(int, WS_WGB);
    int* tok = WSP(int, WS_TOK); int* pair = WSP(int, WS_PAIR); float* wsl = WSP(float, WS_WSL); int* blke = WSP(int, WS_BLKE); int* nblk = WSP(int, WS_CTL) + 64;
    int* pst = (int*)F.lds;
    const int tid = F.tid;
    if (tid < 64) { const int pc = ((cnt[tid * 64] + 255) >> 8) << 8; int incl = pc;
#pragma unroll
        for (int o = 1; o < 64; o <<= 1) { const int n = __shfl_up(incl, o); if (tid >= o) incl += n; }
        pst[tid] = incl - pc; if (tid == 63) pst[64] = incl; }
    __syncthreads();
    for (int gid = F.bid * NTHR + tid; gid < NT * 8; gid += F.G * NTHR) {
        const int e = idx[gid]; const int t = gid >> 3, k = gid & 7; const int slot = NT + pst[e] + wgb[((t >> 8) % F.G) * 64 + e] + rank[gid]; tok[slot] = t; pair[slot] = t * NSLOTK + k; wsl[slot] = gw[gid];
        if (gid < NT) { tok[gid] = gid; pair[gid] = gid * NSLOTK + 8; wsl[gid] = 1.f; }
    }
    for (int e = F.bid; e < 64; e += F.G) {
        for (int s = NT + pst[e] + cnt[e * 64] + tid; s < NT + pst[e + 1]; s += NTHR) { tok[s] = 0; pair[s] = -1; wsl[s] = 0.f; }
    }
    if (F.bid == 0) {
        const int nb = SH_BLKS + (pst[64] >> 8);
        if (tid == 0) *nblk = nb;
        for (int bk = tid; bk < MAX_BLKS; bk += NTHR) {
            int e = 64;
            if (bk >= SH_BLKS) { const int off = (bk - SH_BLKS) << 8; e = 0; for (int q = 0; q < 64; ++q) if (off >= pst[q] && off < pst[q + 1]) e = q; }
            blke[bk] = e;
        }
    }
    __syncthreads();
}

DEV void ph_combine(const Frame& F, float* dst) {
    const unsigned char* yp = F.ws + WS_YP; const float* mod = WSP(float, WS_MOD); const float* gpf = F.in[18]; float* out = F.out;
    const int lane = F.lane;
    for (int blk = F.bid; blk < NT / 256; blk += F.G) {
      float A2[16];
      { const float* m = mod + (size_t)(blk / (SEQ / 256)) * NMOD + 5120;
#pragma unroll
        for (int i = 0; i < 4; ++i) { const int c0 = lane * 16 + i * 4; const f32x4 g = *(const f32x4*)(gpf + c0), gt = *(const f32x4*)(m + c0);
#pragma unroll
            for (int j = 0; j < 4; ++j) A2[i * 4 + j] = g[j] * gt[j]; } }
#pragma unroll 1
      for (int st = 0; st < 16; ++st) { const size_t t0 = (size_t)blk * 256 + st * 16 + F.wave * 2;
        f16x8 xa[2], xb[2]; uint4 w[2][NSLOTK];
#pragma unroll
        for (int u = 0; u < 2; ++u) { const size_t t = t0 + u;
            xa[u] = *(const f16x8*)((const f16*)(out + t * DM) + lane * 16); xb[u] = *(const f16x8*)((const f16*)(out + t * DM) + lane * 16 + 8);
#pragma unroll
            for (int k = 0; k < NSLOTK; ++k) w[u][k] = *(const uint4*)(yp + (t * NSLOTK + k) * DM + lane * 16); }
#pragma unroll
        for (int u = 0; u < 2; ++u) { const size_t t = t0 + u;
            float acc[16];
#pragma unroll
            for (int i = 0; i < 16; ++i) acc[i] = 0.f;
#pragma unroll
            for (int k = 0; k < NSLOTK; ++k) {
                const unsigned ww[4] = {w[u][k].x, w[u][k].y, w[u][k].z, w[u][k].w};
#pragma unroll
                for (int i = 0; i < 4; ++i) { const f32x2 lo = __builtin_amdgcn_cvt_pk_f32_fp8((int)ww[i], false), hi = __builtin_amdgcn_cvt_pk_f32_fp8((int)ww[i], true);
                    acc[i * 4] += lo.x; acc[i * 4 + 1] += lo.y; acc[i * 4 + 2] += hi.x; acc[i * 4 + 3] += hi.y; }
            }
            float ss = 0.f;
#pragma unroll
            for (int i = 0; i < 16; ++i) { acc[i] *= (1.f / YSCALE); ss += acc[i] * acc[i]; }
            const float rstd = rsqrtf(wave_sum(ss) * (1.f / DM) + EPS);
#pragma unroll
            for (int i = 0; i < 4; ++i) { const int c0 = lane * 16 + i * 4; f32x4 o;
#pragma unroll
                for (int j = 0; j < 4; ++j) { const int q = i * 4 + j; const float x1 = (float)(q < 8 ? xa[u][q & 7] : xb[u][q & 7]); o[j] = x1 + A2[q] * (acc[q] * rstd); }
                *(f32x4*)(dst + t * DM + c0) = o; }
        }
      }
    }
}

#define XB_TMO      128
#define XB_XCNT(j)  (256  + 64 * (j))
#define XB_XSUB(j)  (1280 + 64 * (j))
#define XB_XGEN(j)  (2304 + 64 * (j))
#define XB_TOP      3328
#define XB_TOPGEN   3392
#define XCD_BAR_WORDS 3456
#define XB_SPIN_CAP (1u << 20)
DEV unsigned xb_ld(unsigned* p)              { return __hip_atomic_load(p, __ATOMIC_RELAXED, __HIP_MEMORY_SCOPE_AGENT); }
DEV unsigned xb_add(unsigned* p, unsigned v) { return __hip_atomic_fetch_add(p, v, __ATOMIC_RELAXED, __HIP_MEMORY_SCOPE_AGENT); }
DEV unsigned xb_xcc_id() { return (unsigned)__builtin_amdgcn_s_getreg((3 << 11) | 20) & 0xFu; }
#define XB_SPIN(cond, bar) do { unsigned _sp = 0; while (cond) { __builtin_amdgcn_s_sleep(1); \
    if ((++_sp & 255u) == 0u) { if (xb_ld(&(bar)[XB_TMO])) break; if (_sp > XB_SPIN_CAP) { atomicAdd(&(bar)[XB_TMO], 1u); break; } } } } while (0)
struct XcdBarrier { unsigned* bar; unsigned x; volatile LAS unsigned* st; };
DEV XcdBarrier xcd_barrier_post(unsigned* bar, volatile LAS unsigned* st) {
    XcdBarrier b; b.bar = bar; b.x = xb_xcc_id(); b.st = st;
    if (threadIdx.x == 0) (void)xb_add(&bar[XB_XCNT(b.x)], 1u);
    return b;
}
DEV void xcd_barrier_complete(unsigned* bar, unsigned x, unsigned& nloc, unsigned& nx) {
    const unsigned G = gridDim.x * gridDim.y * gridDim.z;
    unsigned sum, cnt, mine, sp = 0u;
    for (;;) {
        sum = 0u; cnt = 0u; mine = 0u;
#pragma unroll
        for (unsigned j = 0; j < 16; ++j) { const unsigned c = xb_ld(&bar[XB_XCNT(j)]); sum += c; cnt += (c > 0u) ? 1u : 0u; mine = (j == x) ? c : mine; }
        if (sum == G) break;
        __builtin_amdgcn_s_sleep(1);
        if ((++sp & 255u) == 0u) { if (xb_ld(&bar[XB_TMO])) break; if (sp > XB_SPIN_CAP) { atomicAdd(&bar[XB_TMO], 1u); break; } }
    }
    nloc = mine > 0u ? mine : 1u; nx = cnt > 0u ? cnt : 1u;
}
DEV void xcd_barrier(const XcdBarrier& b) {
    asm volatile("s_waitcnt vmcnt(0)" ::: "memory");
    __syncthreads();
    if (threadIdx.x == 0) {
        unsigned* bar = b.bar;
        __builtin_amdgcn_s_waitcnt(0);
        unsigned nloc = b.st[0], nx = b.st[1];
        if (nloc == 0u) { xcd_barrier_complete(bar, b.x, nloc, nx); b.st[0] = nloc; b.st[1] = nx; }
        const unsigned old = xb_add(&bar[XB_XSUB(b.x)], 1u);
        const unsigned gen = old / nloc;
        if (old + 1u == (gen + 1u) * nloc) {
            __builtin_amdgcn_fence(__ATOMIC_RELEASE, "agent");
            asm volatile("s_waitcnt vmcnt(0)" ::: "memory");
            const unsigned og = xb_add(&bar[XB_TOP], 1u);
            const unsigned tg = og / nx;
            if (og + 1u == (tg + 1u) * nx) xb_add(&bar[XB_TOPGEN], 1u);
            else XB_SPIN(xb_ld(&bar[XB_TOPGEN]) == tg, bar);
            __builtin_amdgcn_fence(__ATOMIC_ACQUIRE, "agent");
            xb_add(&bar[XB_XGEN(b.x)], 1u);
            asm volatile("s_waitcnt vmcnt(0)" ::: "memory");
        } else {
            XB_SPIN(xb_ld(&bar[XB_XGEN(b.x)]) == gen, bar);
            __builtin_amdgcn_fence(__ATOMIC_ACQUIRE, "agent");
            asm volatile("s_waitcnt vmcnt(0)" ::: "memory");
        }
    }
    __syncthreads();
}

#ifndef PROBE_DUP
#define PROBE_DUP -1
#endif
constexpr int NPHASE = 11;
__global__ void __launch_bounds__(NTHR, 2) mega(Args a) {
    extern __shared__ __attribute__((aligned(16))) unsigned char lds[];
    cg::grid_group grid = cg::this_grid();
    Frame F;
    F.lds = lds; F.tid = threadIdx.x; F.lane = F.tid & 63; F.wave = __builtin_amdgcn_readfirstlane(F.tid >> 6); F.bid = blockIdx.x; F.G = gridDim.x;
    F.gw = F.bid * NWAVE + F.wave; F.NGW = F.G * NWAVE; F.in = a.in; F.out = a.out; F.ws = a.ws;
    const int lo = a.ph_lo, hi = a.ph_hi;
#ifndef ONLY_PHASE
#define ONLY_PHASE -1
#endif
#define IN(k) (lo <= (k) && (k) < hi && (ONLY_PHASE < 0 || (k) == ONLY_PHASE))
    volatile LAS unsigned* xst = (volatile LAS unsigned*)((LAS unsigned char*)lds + LDS_BYTES - 128);
    if (F.tid < 2) xst[F.tid] = 0u;
    __syncthreads();
    const XcdBarrier xbar = xcd_barrier_post((unsigned*)(a.ws + WS_BAR), xst);
#define SEAM(k) do { if (IN(k) && IN((k) + 1)) { if (hi > 64) grid.sync(); else xcd_barrier(xbar); } } while (0)
#define RUN(k, ...) do { if (IN(k)) { __VA_ARGS__; if (PROBE_DUP == (k) && (k) != 10) { xcd_barrier(xbar); __VA_ARGS__; } } } while (0)
    const int vcu = (F.G % 8 == 0) ? (F.bid % 8) * (F.G / 8) + F.bid / 8 : F.bid;
    LAS unsigned char* lds3 = (LAS unsigned char*)lds;
    RUN(0, { ph_mod(F); ph_wconv(F); }); SEAM(0);
    RUN(1, ph_prenorm(F)); SEAM(1);
    RUN(2, { pg8::SchedInProj S{(const char*)WSP(f16, WS_HALL), (const char*)WSP(f16, WS_WIN), vcu, F.G};
        LAS float* tabs = (LAS float*)(lds3 + pg8::STAGE_BYTES + 4608);
        for (int i = F.tid; i < 2048; i += NTHR) tabs[i] = WSP(float, WS_ROPE)[i];
        if (F.tid < 64) { tabs[2048 + F.tid] = F.in[9][F.tid]; tabs[2112 + F.tid] = F.in[10][F.tid]; }
        __syncthreads();
        pg8::EpiInProj E{WSP(f16, WS_QKV), tabs + 2048, tabs + 2112, tabs};
        pg8::gemm_phase<pg8::EpiInProj, pg8::SchedInProj, false>(lds3, DM * 2, S, E, nullptr, nullptr, nullptr); }); SEAM(2);
    RUN(3, ph_attn(F, vcu)); if (IN(3) && IN(5)) xcd_barrier(xbar);
    RUN(5, { pg8::SchedDense S{(const char*)WSP(f16, WS_MIXED), (const char*)WSP(f16, WS_WOUT), vcu, F.G, (NT / 256) * 4, 4, DM};
        pg8::EpiPlain E{WSP(f16, WS_Y1), DM};
        pg8::gemm_phase<pg8::EpiPlain, pg8::SchedDense, false>(lds3, DM * 2, S, E, nullptr, nullptr, nullptr); }); SEAM(5);
    RUN(6, ph_rowpass(F)); SEAM(6);
    RUN(7, ph_dispatch(F)); SEAM(7);
    RUN(8, { const int nb = *(WSP(int, WS_CTL) + 64);
        pg8::SchedGrouped S{nullptr, (const char*)(F.ws + WS_WGU), WSP(int, WS_BLKE), vcu, F.G, nb * 2, 2, DM / 2, (size_t)512 * DM, 1};
        pg8::EpiGU E{F.ws + WS_H, WSP(float, WS_WSL)};
        pg8::gemm_phase<pg8::EpiGU, pg8::SchedGrouped, true, true>(lds3, DM, S, E, WSP(int, WS_TOK), (const char*)(F.ws + WS_H2), WSP(unsigned, WS_WSL), 0x79797979, 0x7F7F7F7F); }); SEAM(8);
    RUN(9, { const int nb = *(WSP(int, WS_CTL) + 64);
        pg8::SchedGrouped S{(const char*)(F.ws + WS_H), (const char*)(F.ws + WS_WD), WSP(int, WS_BLKE), vcu, F.G, nb * 4, 4, EH / 2, (size_t)DM * EH, 1};
        pg8::EpiDown E{F.ws + WS_YP, WSP(int, WS_PAIR)};
        pg8::gemm_phase<pg8::EpiDown, pg8::SchedGrouped, false, true, true>(lds3, EH, S, E, nullptr, nullptr, WSP(unsigned, WS_PAIR), 0x79797979, 0x80808080  ); }); SEAM(9);
    RUN(10, ph_combine(F, F.out));
}

extern "C" void kernel_launch(void* const* d_in, const int* in_sizes, int n_in, void* d_out, int out_size, void* d_ws, size_t ws_size, hipStream_t stream) {
    (void)in_sizes; (void)out_size;
    static int grid = 0;
    if (grid == 0) {
        if (n_in != 27 || ws_size < WS_END) { fprintf(stderr, "kernel_launch: unexpected n_in %d / ws_size %zu (need %zu)\n", n_in, ws_size, (size_t)WS_END); grid = -1; return; }
        int dev = 0, cus = 0, per_cu = 0;
        (void)hipGetDevice(&dev); (void)hipDeviceGetAttribute(&cus, hipDeviceAttributeMultiprocessorCount, dev);
        if (hipFuncSetAttribute((const void*)mega, hipFuncAttributeMaxDynamicSharedMemorySize, LDS_BYTES) != hipSuccess) { fprintf(stderr, "kernel_launch: hipFuncSetAttribute failed\n"); grid = -1; return; }
        if (hipOccupancyMaxActiveBlocksPerMultiprocessor(&per_cu, (const void*)mega, NTHR, LDS_BYTES) != hipSuccess || per_cu < 1) { fprintf(stderr, "kernel_launch: occupancy query failed (%d)\n", per_cu); (void)hipGetLastError(); per_cu = 1; }
        grid = cus * (per_cu > 1 ? 1 : per_cu);
        if (grid <= 0) grid = 256;
    }
    if (grid < 0) return;
    (void)hipMemsetAsync((unsigned char*)d_ws + WS_CTL, 0, 64 * 1024, stream);
    Args a{};
    for (int i = 0; i < 27; ++i) a.in[i] = (const float*)d_in[i];
    a.out = (float*)d_out; a.ws = (unsigned char*)d_ws; a.ph_lo = 0; a.ph_hi = NPHASE;
    void* args[] = {&a};
    hipError_t e = hipLaunchCooperativeKernel((const void*)mega, dim3(grid), dim3(NTHR), args, LDS_BYTES, stream);
    if (e != hipSuccess) fprintf(stderr, "kernel_launch: cooperative launch failed: %s (grid %d)\n", hipGetErrorString(e), grid);
}
```
